# Optimizing an MI355X kernel written in HIP

```python
import jax, jax.numpy as jnp
from jax import lax
import numpy as np

D_MODEL = 1024
BATCH = 1
SEQ = 16384
DEPTH = 1

CHUNK = 64
N_META = 16
CONV_CH = 512
CONV_WIDTH = 31
SB_HEADS = 8
SB_HEAD_DIM = 64
SB_WIDTH = SB_HEADS * SB_HEAD_DIM
Q_BLOCK = 128
IN_COLS = 2 * CONV_CH + 3 * SB_WIDTH
PEER_HEADS = 8
PEER_QDIM = 256
PEER_QHALF = PEER_QDIM // 2
N_KEYS = 128
N_EXPERTS = N_KEYS * N_KEYS
PEER_TOPK = 16
PEER_BLOCK = 128
EPS = 1e-6

kernel_name = "hybrid_conv_stickbreak_peer_block"


def rms_norm(x, g):
    xf = x.astype(jnp.float32)
    y = xf * lax.rsqrt(jnp.mean(xf * xf, axis=-1, keepdims=True) + EPS)
    return (y * g.astype(jnp.float32)).astype(x.dtype)


def layer_norm(x, g, b):
    xf = x.astype(jnp.float32)
    mu = jnp.mean(xf, axis=-1, keepdims=True)
    xc = xf - mu
    y = xc * lax.rsqrt(jnp.mean(xc * xc, axis=-1, keepdims=True) + EPS)
    return (y * g.astype(jnp.float32) + b.astype(jnp.float32)).astype(x.dtype)


def conv_module(a, gt, w_dw, b_dw, ln_g, ln_b, w_out):
    h = a * jax.nn.sigmoid(gt)
    h = lax.conv_general_dilated(
        h, w_dw[:, None, :], window_strides=(1,),
        padding=[(CONV_WIDTH - 1, 0)],
        dimension_numbers=('NWC', 'WIO', 'NWC'),
        feature_group_count=CONV_CH) + b_dw
    h = layer_norm(h, ln_g, ln_b)
    h = jax.nn.silu(h)
    return h @ w_out


def stick_breaking_attention(q, k, v):
    B, H, Lp, dh = q.shape
    nb = Lp // Q_BLOCK
    scale = dh ** -0.5
    kf = k.astype(jnp.float32)
    vf = v.astype(jnp.float32)
    key_pos = jnp.arange(Lp)
    q_blocks = q.reshape(B, H, nb, Q_BLOCK, dh).transpose(2, 0, 1, 3, 4)
    q_pos = jnp.arange(Lp).reshape(nb, Q_BLOCK)

    def block(args):
        q_blk, t = args
        z = jnp.einsum('bhqd,bhkd->bhqk', q_blk.astype(jnp.float32), kf) * scale
        before = key_pos[None, :] < t[:, None]
        log_keep = jnp.where(before, jax.nn.log_sigmoid(-z), 0.0)
        log_rest = lax.cumsum(log_keep, axis=3, reverse=True) - log_keep
        w = jnp.where(before, jnp.exp(jax.nn.log_sigmoid(z) + log_rest), 0.0)
        return jnp.einsum('bhqk,bhkd->bhqd', w, vf)

    o = lax.map(block, (q_blocks, q_pos))
    return o.transpose(1, 2, 0, 3, 4).reshape(B, H, Lp, dh).astype(v.dtype)


def peer_ffn(h, w_q, k1, k2, u, v):
    B, Lp, D = h.shape
    q = (h @ w_q).reshape(B, Lp, PEER_HEADS, 2, PEER_QHALF)
    s1 = jnp.einsum('blhd,hnd->blhn', q[..., 0, :], k1).astype(jnp.float32)
    s2 = jnp.einsum('blhd,hnd->blhn', q[..., 1, :], k2).astype(jnp.float32)
    v1, i1 = lax.top_k(s1, PEER_TOPK)
    v2, i2 = lax.top_k(s2, PEER_TOPK)
    cand = (v1[..., :, None] + v2[..., None, :]).reshape(B, Lp, PEER_HEADS, PEER_TOPK * PEER_TOPK)
    cand_idx = (i1[..., :, None] * N_KEYS + i2[..., None, :]).reshape(B, Lp, PEER_HEADS, PEER_TOPK * PEER_TOPK)
    best, pos = lax.top_k(cand, PEER_TOPK)
    idx = jnp.take_along_axis(cand_idx, pos, axis=-1)
    gate = jax.nn.softmax(best, axis=-1)

    nt = (B * Lp) // PEER_BLOCK
    xs = (h.reshape(nt, PEER_BLOCK, D),
          idx.reshape(nt, PEER_BLOCK, PEER_HEADS, PEER_TOPK),
          gate.reshape(nt, PEER_BLOCK, PEER_HEADS, PEER_TOPK))

    def block(args):
        x_blk, e_blk, g_blk = args
        act = jax.nn.gelu(jnp.einsum('td,thkd->thk', x_blk, u[e_blk]), approximate=False)
        coef = (g_blk * act.astype(jnp.float32)).astype(v.dtype)
        return jnp.einsum('thk,thkd->td', coef, v[e_blk])

    return lax.map(block, xs).reshape(B, Lp, D)


def setup_inputs(seed: int = 0) -> dict:
    key = jax.random.key(seed)
    ks = jax.random.split(key, 24)
    f = jnp.float32
    D = D_MODEL
    nrm = lambda k, shape, s: jax.random.normal(k, shape, f) * s
    return {
        "x": nrm(ks[0], (BATCH, SEQ, D), 1.0),
        "meta_tokens": nrm(ks[1], (N_META, D), 1.0),
        "norm1_g": 1.0 + nrm(ks[2], (DEPTH, D), 0.02),
        "w_in": nrm(ks[3], (DEPTH, D, IN_COLS), D ** -0.5),
        "conv_w": nrm(ks[4], (DEPTH, CONV_WIDTH, CONV_CH), CONV_WIDTH ** -0.5),
        "conv_b": nrm(ks[5], (DEPTH, CONV_CH), 0.02),
        "conv_ln_g": 1.0 + nrm(ks[6], (DEPTH, CONV_CH), 0.02),
        "conv_ln_b": nrm(ks[7], (DEPTH, CONV_CH), 0.02),
        "w_conv_out": nrm(ks[8], (DEPTH, CONV_CH, D), CONV_CH ** -0.5),
        "q_norm_g": 1.0 + nrm(ks[9], (DEPTH, SB_HEAD_DIM), 0.02),
        "k_norm_g": 1.0 + nrm(ks[10], (DEPTH, SB_HEAD_DIM), 0.02),
        "w_sb_out": nrm(ks[11], (DEPTH, SB_WIDTH, D), SB_WIDTH ** -0.5),
        "w_gate": nrm(ks[12], (DEPTH, D, 2 * D), D ** -0.5),
        "b_gate": nrm(ks[13], (DEPTH, 2 * D), 0.02),
        "w_o": nrm(ks[14], (DEPTH, D, D), D ** -0.5),
        "norm2_g": 1.0 + nrm(ks[15], (DEPTH, D), 0.02),
        "peer_wq": nrm(ks[16], (DEPTH, D, PEER_HEADS * PEER_QDIM), D ** -0.5),
        "peer_k1": nrm(ks[17], (DEPTH, PEER_HEADS, N_KEYS, PEER_QHALF), PEER_QHALF ** -0.5),
        "peer_k2": nrm(ks[18], (DEPTH, PEER_HEADS, N_KEYS, PEER_QHALF), PEER_QHALF ** -0.5),
        "peer_u": nrm(ks[19], (DEPTH, N_EXPERTS, D), D ** -0.5),
        "peer_v": nrm(ks[20], (DEPTH, N_EXPERTS, D), PEER_HEADS ** -0.5),
    }


def reference(x, meta_tokens, norm1_g, w_in, conv_w, conv_b, conv_ln_g, conv_ln_b, w_conv_out,
              q_norm_g, k_norm_g, w_sb_out, w_gate, b_gate, w_o, norm2_g,
              peer_wq, peer_k1, peer_k2, peer_u, peer_v):
    B, S, D = x.shape
    L = N_META + S
    Lp = -(-L // Q_BLOCK) * Q_BLOCK
    meta = jnp.broadcast_to(meta_tokens[None].astype(x.dtype), (B, N_META, D))
    h = jnp.concatenate([meta, x, jnp.zeros((B, Lp - L, D), x.dtype)], axis=1)
    splits = [CONV_CH, 2 * CONV_CH, 2 * CONV_CH + SB_WIDTH, 2 * CONV_CH + 2 * SB_WIDTH]

    for l in range(DEPTH):
        hn = rms_norm(h, norm1_g[l])
        a, gt, q, k, v = jnp.split(hn @ w_in[l], splits, axis=-1)

        y_conv = conv_module(a, gt, conv_w[l], conv_b[l], conv_ln_g[l], conv_ln_b[l], w_conv_out[l])

        q = rms_norm(q.reshape(B, Lp, SB_HEADS, SB_HEAD_DIM), q_norm_g[l]).transpose(0, 2, 1, 3)
        k = rms_norm(k.reshape(B, Lp, SB_HEADS, SB_HEAD_DIM), k_norm_g[l]).transpose(0, 2, 1, 3)
        v = v.reshape(B, Lp, SB_HEADS, SB_HEAD_DIM).transpose(0, 2, 1, 3)
        o = stick_breaking_attention(q, k, v).transpose(0, 2, 1, 3).reshape(B, Lp, SB_WIDTH)
        y_sb = o @ w_sb_out[l]

        g_conv, g_sb = jnp.split(jax.nn.sigmoid(hn @ w_gate[l] + b_gate[l]), 2, axis=-1)
        h = h + (g_conv * y_conv + g_sb * y_sb) @ w_o[l]

        h = h + peer_ffn(rms_norm(h, norm2_g[l]), peer_wq[l], peer_k1[l], peer_k2[l],
                         peer_u[l], peer_v[l])

    return h[:, N_META:N_META + S]
```

```cpp
#include <hip/hip_runtime.h>
#include <hip/hip_cooperative_groups.h>
#include <cstdio>
#include <cstdint>
namespace cg = cooperative_groups;

#ifndef MULTI_LAUNCH
#define MULTI_LAUNCH 1
#endif

#define LAS __attribute__((address_space(3)))
#define GAS __attribute__((address_space(1)))
typedef unsigned short bf16_t;
typedef short bf16x8 __attribute__((ext_vector_type(8)));
typedef float f32x4 __attribute__((ext_vector_type(4)));
typedef float f32x2 __attribute__((ext_vector_type(2)));
typedef unsigned u32x4 __attribute__((ext_vector_type(4)));
typedef unsigned u32x2 __attribute__((ext_vector_type(2)));

constexpr int D = 1024, SEQ = 16384, NMETA = 16, LTOK = SEQ + NMETA, LP = 16512;
constexpr int CONVC = 512, CONVW = 31, NH = 8, DH = 64, INC = 2560;
constexpr int NCAT = 4608;
constexpr int PH = 8, NKEYS = 128, TOPK = 16;
constexpr float EPS = 1e-6f;
constexpr int LDS_BYTES = 67584;
constexpr int NTHREADS = 256;

constexpr size_t WS_RSTD1 = 16384;
constexpr size_t WS_SS2   = WS_RSTD1 + 131072;
constexpr size_t WS_WCAT  = WS_SS2 + 65536;
constexpr size_t WS_WCO   = WS_WCAT + (size_t)NCAT * 1024 * 2;
constexpr size_t WS_WSO   = WS_WCO + 1024 * 512 * 2;
constexpr size_t WS_WO    = WS_WSO + 1024 * 512 * 2;
constexpr size_t WS_WQ    = WS_WO + 1024 * 1024 * 2;
constexpr size_t WS_K1    = WS_WQ + 2048 * 1024 * 2;
constexpr size_t WS_K2    = WS_K1 + 8 * 128 * 128 * 2;
constexpr size_t WS_GATE  = WS_K2 + 8 * 128 * 128 * 2;
constexpr size_t WS_UB    = WS_GATE;
constexpr size_t WS_VB    = WS_GATE + (size_t)16384 * 1024 * 2;
constexpr size_t WS_HB    = WS_GATE + (size_t)LP * 2048 * 2;
constexpr size_t WS_GLU   = WS_HB + (size_t)LP * 1024 * 2;
constexpr size_t WS_Q     = WS_GLU + (size_t)LP * 512 * 2;
constexpr size_t WS_K     = WS_Q + (size_t)LP * 512 * 2;
constexpr size_t WS_VT    = WS_K + (size_t)LP * 512 * 2;
constexpr size_t WS_H2B   = WS_GLU;
constexpr size_t WS_CS    = WS_VT + (size_t)LP * 512 * 2;
constexpr size_t WS_O     = WS_CS + (size_t)LP * 512 * 2;
constexpr size_t WS_PIDX  = WS_O + (size_t)LP * 512 * 2;
constexpr size_t WS_PGATE = WS_PIDX + (size_t)SEQ * 128 * 4;
constexpr size_t WS_END   = WS_PGATE + (size_t)SEQ * 128 * 4;

struct Params {
    const float* x; const float* meta; const float* norm1_g; const float* w_in; const float* conv_w; const float* conv_b;
    const float* conv_ln_g; const float* conv_ln_b; const float* w_conv_out; const float* q_norm_g; const float* k_norm_g;
    const float* w_sb_out; const float* w_gate; const float* b_gate; const float* w_o; const float* norm2_g;
    const float* peer_wq; const float* peer_k1; const float* peer_k2; const float* peer_u; const float* peer_v;
    float* out; unsigned char* ws;
    int ph_lo, ph_hi;
};

__device__ __forceinline__ unsigned pack2bf(float lo, float hi) { unsigned r; asm("v_cvt_pk_bf16_f32 %0, %1, %2" : "=v"(r) : "v"(lo), "v"(hi)); return r; }
__device__ __forceinline__ float bflo(unsigned u) { return __uint_as_float(u << 16); }
__device__ __forceinline__ float bfhi(unsigned u) { return __uint_as_float(u & 0xFFFF0000u); }
__device__ __forceinline__ float bf2f(bf16_t b) { return __uint_as_float((unsigned)b << 16); }
__device__ __forceinline__ void glds16(const void* g, LAS char* l) {
    __builtin_amdgcn_global_load_lds((const GAS unsigned*)g, (LAS unsigned*)l, 16, 0, 0);
}
__device__ __forceinline__ float wave_sum(float v) {
#pragma unroll
    for (int o = 32; o > 0; o >>= 1) v += __shfl_xor(v, o);
    return v;
}
__device__ __forceinline__ float wave_max(float v) {
#pragma unroll
    for (int o = 32; o > 0; o >>= 1) v = fmaxf(v, __shfl_xor(v, o));
    return v;
}
__device__ __forceinline__ float sigmoidf_(float x) { return 1.f / (1.f + __expf(-x)); }
__device__ __forceinline__ int tid_opaque() { int t = threadIdx.x; asm volatile("" : "+v"(t)); return t; }
__device__ __forceinline__ int tswz(int r, int c) { return r * 512 + ((((c >> 2) ^ r) & 31) << 4) + ((c & 3) << 2); }

__device__ __forceinline__ void gemm128(const bf16_t* A, int lda, const bf16_t* Bt, int ldb, int K, LAS char* sm, f32x4 (&acc)[4][4]) {
    const int tid = tid_opaque(), lane = tid & 63, wid = tid >> 6, wr = wid >> 1, wc = wid & 1, fr = lane & 15, fq = lane >> 4;
    const int nk = K >> 6;
    auto stage = [&](int b, int kt) {
#pragma unroll
        for (int i = 0; i < 4; ++i) {
            const int p = tid + i * 256, row = p >> 3, c = (p & 7) ^ (row & 7);
            glds16(A + (size_t)row * lda + kt * 64 + c * 8, sm + b * 32768 + p * 16);
            glds16(Bt + (size_t)row * ldb + kt * 64 + c * 8, sm + b * 32768 + 16384 + p * 16);
        }
    };
    stage(0, 0);
    asm volatile("s_waitcnt vmcnt(0)" ::: "memory");
    __syncthreads();
    for (int kt = 0; kt < nk; ++kt) {
        const int cur = kt & 1;
        if (kt + 1 < nk) stage(cur ^ 1, kt + 1);
        LAS char* sa = sm + cur * 32768;
        LAS char* sb = sa + 16384;
#pragma unroll
        for (int kh = 0; kh < 2; ++kh) {
            bf16x8 af[4], bfr[4];
#pragma unroll
            for (int i = 0; i < 4; ++i) {
                const int ra = wr * 64 + i * 16 + fr;
                af[i] = *(LAS bf16x8*)(sa + ra * 128 + (((kh * 4 + fq) ^ (ra & 7)) << 4));
                const int rb = wc * 64 + i * 16 + fr;
                bfr[i] = *(LAS bf16x8*)(sb + rb * 128 + (((kh * 4 + fq) ^ (rb & 7)) << 4));
            }
#pragma unroll
            for (int mi = 0; mi < 4; ++mi)
#pragma unroll
                for (int ni = 0; ni < 4; ++ni)
                    acc[mi][ni] = __builtin_amdgcn_mfma_f32_16x16x32_bf16(bfr[ni], af[mi], acc[mi][ni], 0, 0, 0);
        }
        asm volatile("s_waitcnt vmcnt(0)" ::: "memory");
        __syncthreads();
    }
}
__device__ __forceinline__ void zero_acc(f32x4 (&acc)[4][4]) {
#pragma unroll
    for (int i = 0; i < 4; ++i)
#pragma unroll
        for (int j = 0; j < 4; ++j) acc[i][j] = (f32x4){0.f, 0.f, 0.f, 0.f};
}
__device__ __forceinline__ void acc_to_lds(const f32x4 (&acc)[4][4], LAS char* sm) {
    const int tid = tid_opaque(), lane = tid & 63, wid = tid >> 6, wr = wid >> 1, wc = wid & 1, fr = lane & 15, fq = lane >> 4;
#pragma unroll
    for (int mi = 0; mi < 4; ++mi)
#pragma unroll
        for (int ni = 0; ni < 4; ++ni) {
            const int r = wr * 64 + mi * 16 + fr, c = wc * 64 + ni * 16 + fq * 4;
            *(LAS f32x4*)(sm + tswz(r, c)) = acc[mi][ni];
        }
}

__device__ void phase_prep(const Params& p, LAS char* sm) {
    const int tid = tid_opaque(), lane = tid & 63, wid = tid >> 6;
    const int G = gridDim.x, b = blockIdx.x;
    bf16_t* hb = (bf16_t*)(p.ws + WS_HB);
    float* rstd1 = (float*)(p.ws + WS_RSTD1);
    float* ss2 = (float*)(p.ws + WS_SS2);
    for (int row = b * 4 + wid; row < LP; row += G * 4) {
        const float* src = row < NMETA ? p.meta + (size_t)row * D : (row < LTOK ? p.x + (size_t)(row - NMETA) * D : nullptr);
        float ss = 0.f;
#pragma unroll
        for (int i = 0; i < 4; ++i) {
            f32x4 v = (f32x4){0.f, 0.f, 0.f, 0.f};
            if (src) v = *(const f32x4*)(src + lane * 4 + 256 * i);
            ss += v[0] * v[0] + v[1] * v[1] + v[2] * v[2] + v[3] * v[3];
            u32x2 o; o[0] = pack2bf(v[0], v[1]); o[1] = pack2bf(v[2], v[3]);
            *(u32x2*)(hb + (size_t)row * D + lane * 4 + 256 * i) = o;
        }
        ss = wave_sum(ss);
        if (lane == 0) rstd1[row] = rsqrtf(ss * (1.f / D) + EPS);
    }
    for (int i = b * NTHREADS + tid; i < SEQ; i += G * NTHREADS) ss2[i] = 0.f;
    {
        bf16_t* k1b = (bf16_t*)(p.ws + WS_K1); bf16_t* k2b = (bf16_t*)(p.ws + WS_K2);
        for (int i = b * NTHREADS + tid; i < 8 * 128 * 128 / 4; i += G * NTHREADS) {
            f32x4 a = *(const f32x4*)(p.peer_k1 + (size_t)i * 4), c = *(const f32x4*)(p.peer_k2 + (size_t)i * 4);
            u32x2 o; o[0] = pack2bf(a[0], a[1]); o[1] = pack2bf(a[2], a[3]); *(u32x2*)(k1b + (size_t)i * 4) = o;
            o[0] = pack2bf(c[0], c[1]); o[1] = pack2bf(c[2], c[3]); *(u32x2*)(k2b + (size_t)i * 4) = o;
        }
    }
    constexpr int J0 = 72 * 16, J1 = J0 + 128, J2 = J1 + 128, J3 = J2 + 256, J4 = J3 + 512;
    LAS float* T = (LAS float*)sm;
    for (int it = b; it < J4; it += G) {
        const float* src; int N, K, srccol0, kt, nb; bf16_t* dst; const float* g = nullptr;
        if (it < J0) {
            nb = it / 16; kt = it % 16; K = 1024; g = p.norm1_g; dst = (bf16_t*)(p.ws + WS_WCAT);
            if (nb < 16) { src = p.w_in; N = INC; const int j = nb >> 1; srccol0 = (nb & 1) ? (512 + 64 * j) : (64 * j); }
            else if (nb < 40) { src = p.w_in; N = INC; srccol0 = 1024 + (nb - 16) * 64; }
            else { src = p.w_gate; N = 2048; srccol0 = (nb - 40) * 64; }
        } else if (it < J1) { const int q = it - J0; nb = q / 8; kt = q % 8; K = 512; src = p.w_conv_out; N = 1024; srccol0 = nb * 64; dst = (bf16_t*)(p.ws + WS_WCO); }
        else if (it < J2) { const int q = it - J1; nb = q / 8; kt = q % 8; K = 512; src = p.w_sb_out; N = 1024; srccol0 = nb * 64; dst = (bf16_t*)(p.ws + WS_WSO); }
        else if (it < J3) { const int q = it - J2; nb = q / 16; kt = q % 16; K = 1024; src = p.w_o; N = 1024; srccol0 = nb * 64; dst = (bf16_t*)(p.ws + WS_WO); }
        else { const int q = it - J3; nb = q / 16; kt = q % 16; K = 1024; src = p.peer_wq; N = 2048; srccol0 = nb * 64; g = p.norm2_g; dst = (bf16_t*)(p.ws + WS_WQ); }
        const int k0 = kt * 64;
#pragma unroll
        for (int i = 0; i < 16; ++i) {
            const int k = wid + 4 * i;
            float v = src[(size_t)(k0 + k) * N + srccol0 + lane];
            if (g) v *= g[k0 + k];
            T[k * 65 + lane] = v;
        }
        __syncthreads();
#pragma unroll
        for (int i = 0; i < 16; ++i) {
            const int n = wid + 4 * i;
            const float v = T[lane * 65 + n];
            const unsigned pk = pack2bf(v, 0.f);
            dst[(size_t)(nb * 64 + n) * K + k0 + lane] = (bf16_t)(pk & 0xFFFFu);
        }
        __syncthreads();
    }
}

__device__ void phase_gemm1(const Params& p, LAS char* sm) {
    const int tid = tid_opaque();
    const bf16_t* hb = (const bf16_t*)(p.ws + WS_HB);
    const bf16_t* wcat = (const bf16_t*)(p.ws + WS_WCAT);
    const float* rstd1 = (const float*)(p.ws + WS_RSTD1);
    bf16_t* glu = (bf16_t*)(p.ws + WS_GLU);
    bf16_t* qo = (bf16_t*)(p.ws + WS_Q);
    bf16_t* ko = (bf16_t*)(p.ws + WS_K);
    bf16_t* vt = (bf16_t*)(p.ws + WS_VT);
    bf16_t* gate = (bf16_t*)(p.ws + WS_GATE);
    LAS float* rs = (LAS float*)(sm + 65536);
    constexpr int NT = NCAT / 128, MT = LP / 128;
    for (int it = blockIdx.x; it < MT * NT; it += gridDim.x) {
        const int mt = it / NT, nt = it % NT, m0 = mt * 128;
        f32x4 acc[4][4]; zero_acc(acc);
        gemm128(hb + (size_t)m0 * D, D, wcat + (size_t)nt * 128 * D, D, D, sm, acc);
        acc_to_lds(acc, sm);
        if (tid < 128) rs[tid] = rstd1[m0 + tid];
        __syncthreads();
        int r = tid & 127, hf = tid >> 7;
        asm volatile("" : "+v"(r), "+v"(hf));
        if (nt < 8) {
            const float sc = rs[r];
            bf16_t* dst = glu + (size_t)(m0 + r) * CONVC + nt * 64 + hf * 32;
#pragma unroll
            for (int q = 0; q < 4; ++q) {
                f32x4 a0 = *(LAS f32x4*)(sm + tswz(r, hf * 32 + q * 8)), a1 = *(LAS f32x4*)(sm + tswz(r, hf * 32 + q * 8 + 4));
                f32x4 g0 = *(LAS f32x4*)(sm + tswz(r, 64 + hf * 32 + q * 8)), g1 = *(LAS f32x4*)(sm + tswz(r, 64 + hf * 32 + q * 8 + 4));
                float o[8];
#pragma unroll
                for (int e = 0; e < 4; ++e) { o[e] = a0[e] * sc * sigmoidf_(g0[e] * sc); o[4 + e] = a1[e] * sc * sigmoidf_(g1[e] * sc); }
                u32x4 pk; pk[0] = pack2bf(o[0], o[1]); pk[1] = pack2bf(o[2], o[3]); pk[2] = pack2bf(o[4], o[5]); pk[3] = pack2bf(o[6], o[7]);
                *(u32x4*)(dst + q * 8) = pk;
            }
        } else if (nt < 16) {
            const bool isq = nt < 12;
            const int head = (isq ? (nt - 8) : (nt - 12)) * 2 + hf;
            const float* gn = isq ? p.q_norm_g : p.k_norm_g;
            const float sc = rs[r];
            float ss = 0.f;
#pragma unroll
            for (int q = 0; q < 16; ++q) {
                f32x4 a = *(LAS f32x4*)(sm + tswz(r, hf * 64 + q * 4));
#pragma unroll
                for (int e = 0; e < 4; ++e) { const float t = a[e] * sc; ss += t * t; }
            }
            const float r2 = rsqrtf(ss * (1.f / 64.f) + EPS) * (isq ? 0.125f : 1.f) * sc;
            bf16_t* dst = (isq ? qo : ko) + ((size_t)head * LP + m0 + r) * DH;
#pragma unroll
            for (int q = 0; q < 8; ++q) {
                const f32x4 a0 = *(LAS f32x4*)(sm + tswz(r, hf * 64 + q * 8)), a1 = *(LAS f32x4*)(sm + tswz(r, hf * 64 + q * 8 + 4));
                const f32x4 g0 = *(const f32x4*)(gn + q * 8), g1 = *(const f32x4*)(gn + q * 8 + 4);
                u32x4 pk;
                pk[0] = pack2bf(a0[0] * r2 * g0[0], a0[1] * r2 * g0[1]); pk[1] = pack2bf(a0[2] * r2 * g0[2], a0[3] * r2 * g0[3]);
                pk[2] = pack2bf(a1[0] * r2 * g1[0], a1[1] * r2 * g1[1]); pk[3] = pack2bf(a1[2] * r2 * g1[2], a1[3] * r2 * g1[3]);
                *(u32x4*)(dst + q * 8) = pk;
            }
        } else if (nt < 20) {
            const int c = r, sh = hf;
            const int head = (nt - 16) * 2 + (c >> 6), d = c & 63;
            bf16_t* dst = vt + (((size_t)head * (LP / 64) + (mt * 2 + sh)) * 64 + d) * 64;
#pragma unroll
            for (int q = 0; q < 8; ++q) {
                float o[8];
#pragma unroll
                for (int e = 0; e < 8; ++e) { const int s = sh * 64 + q * 8 + e; o[e] = *(LAS float*)(sm + tswz(s, c)) * rs[s]; }
                u32x4 pk; pk[0] = pack2bf(o[0], o[1]); pk[1] = pack2bf(o[2], o[3]); pk[2] = pack2bf(o[4], o[5]); pk[3] = pack2bf(o[6], o[7]);
                *(u32x4*)(dst + q * 8) = pk;
            }
        } else {
            const int col0 = (nt - 20) * 128 + hf * 64;
            const float sc = rs[r];
            bf16_t* dst = gate + (size_t)(m0 + r) * 2048 + col0;
#pragma unroll
            for (int q = 0; q < 8; ++q) {
                f32x4 a0 = *(LAS f32x4*)(sm + tswz(r, hf * 64 + q * 8)), a1 = *(LAS f32x4*)(sm + tswz(r, hf * 64 + q * 8 + 4));
                f32x4 b0 = *(const f32x4*)(p.b_gate + col0 + q * 8), b1 = *(const f32x4*)(p.b_gate + col0 + q * 8 + 4);
                float o[8];
#pragma unroll
                for (int e = 0; e < 4; ++e) { o[e] = sigmoidf_(a0[e] * sc + b0[e]); o[4 + e] = sigmoidf_(a1[e] * sc + b1[e]); }
                u32x4 pk; pk[0] = pack2bf(o[0], o[1]); pk[1] = pack2bf(o[2], o[3]); pk[2] = pack2bf(o[4], o[5]); pk[3] = pack2bf(o[6], o[7]);
                *(u32x4*)(dst + q * 8) = pk;
            }
        }
        __syncthreads();
    }
}

__device__ void conv_item(const Params& p, LAS char* sm, int item) {
    const int tid = tid_opaque();
    const int lane = tid & 63, wid = tid >> 6;
    const bf16_t* glu = (const bf16_t*)(p.ws + WS_GLU);
    bf16_t* cs = (bf16_t*)(p.ws + WS_CS);
    const int t0 = item * 32;
    for (int c = tid; c < 62 * 64; c += NTHREADS) {
        const int row = c >> 6, ch = c & 63, g = t0 - 30 + row;
        u32x4 v = (u32x4){0u, 0u, 0u, 0u};
        if (g >= 0) v = *(const u32x4*)(glu + (size_t)g * CONVC + ch * 8);
        *(LAS u32x4*)(sm + row * 1024 + ch * 16) = v;
    }
    float wa[CONVW], wb[CONVW];
#pragma unroll
    for (int j = 0; j < CONVW; ++j) { const f32x2 w = *(const f32x2*)(p.conv_w + j * CONVC + tid * 2); wa[j] = w[0]; wb[j] = w[1]; }
    const f32x2 bias = *(const f32x2*)(p.conv_b + tid * 2);
    __syncthreads();
    float resa[2][16], resb[2][16];
#pragma unroll
    for (int ps = 0; ps < 2; ++ps) {
        float aa[16], ab[16];
#pragma unroll
        for (int r = 0; r < 16; ++r) { aa[r] = bias[0]; ab[r] = bias[1]; }
#pragma unroll
        for (int ii = 0; ii < 46; ++ii) {
            const int i = ps * 16 + ii;
            const unsigned u = *(LAS unsigned*)(sm + i * 1024 + tid * 4);
            const float xa = bflo(u), xb = bfhi(u);
#pragma unroll
            for (int r = 0; r < 16; ++r) {
                const int j = ii - r;
                if (j >= 0 && j < CONVW) { aa[r] += wa[j] * xa; ab[r] += wb[j] * xb; }
            }
        }
#pragma unroll
        for (int r = 0; r < 16; ++r) { resa[ps][r] = aa[r]; resb[ps][r] = ab[r]; }
        asm volatile("" ::: "memory");
    }
    __syncthreads();
#pragma unroll
    for (int r = 0; r < 32; ++r) { f32x2 o; o[0] = resa[r >> 4][r & 15]; o[1] = resb[r >> 4][r & 15]; *(LAS f32x2*)(sm + (r * 516 + tid * 2) * 4) = o; }
    __syncthreads();
#pragma unroll 1
    for (int rr = 0; rr < 8; ++rr) {
        const int r = wid * 8 + rr;
        f32x4 v0 = *(LAS f32x4*)(sm + (r * 516 + lane * 4) * 4), v1 = *(LAS f32x4*)(sm + (r * 516 + 256 + lane * 4) * 4);
        float s = v0[0] + v0[1] + v0[2] + v0[3] + v1[0] + v1[1] + v1[2] + v1[3];
        s = wave_sum(s);
        const float mu = s * (1.f / CONVC);
        float q = 0.f;
#pragma unroll
        for (int e = 0; e < 4; ++e) { v0[e] -= mu; v1[e] -= mu; q += v0[e] * v0[e] + v1[e] * v1[e]; }
        q = wave_sum(q);
        const float rstd = rsqrtf(q * (1.f / CONVC) + EPS);
        const f32x4 g0 = *(const f32x4*)(p.conv_ln_g + lane * 4), g1 = *(const f32x4*)(p.conv_ln_g + 256 + lane * 4);
        const f32x4 b0 = *(const f32x4*)(p.conv_ln_b + lane * 4), b1 = *(const f32x4*)(p.conv_ln_b + 256 + lane * 4);
        float y0[4], y1[4];
#pragma unroll
        for (int e = 0; e < 4; ++e) {
            float a = v0[e] * rstd * g0[e] + b0[e]; y0[e] = a * sigmoidf_(a);
            float c = v1[e] * rstd * g1[e] + b1[e]; y1[e] = c * sigmoidf_(c);
        }
        const int t = t0 + r;
        if (t < LP) {
            u32x2 o; o[0] = pack2bf(y0[0], y0[1]); o[1] = pack2bf(y0[2], y0[3]);
            *(u32x2*)(cs + (size_t)t * CONVC + lane * 4) = o;
            o[0] = pack2bf(y1[0], y1[1]); o[1] = pack2bf(y1[2], y1[3]);
            *(u32x2*)(cs + (size_t)t * CONVC + 256 + lane * 4) = o;
        }
    }
    __syncthreads();
}

__device__ __forceinline__ float softplusf_(float z) { return fmaxf(z, 0.f) + __logf(1.f + __expf(-fabsf(z))); }

__device__ void attn_item(const Params& p, LAS char* sm, int head, int qb) {
    const int tid = tid_opaque(), lane = tid & 63, w = tid >> 6, fr = lane & 15, fq = lane >> 4;
    const bf16_t* Qh = (const bf16_t*)(p.ws + WS_Q) + (size_t)head * LP * DH;
    const bf16_t* Kh = (const bf16_t*)(p.ws + WS_K) + (size_t)head * LP * DH;
    const bf16_t* Vth = (const bf16_t*)(p.ws + WS_VT) + (size_t)head * (LP / 64) * 4096;
    bf16_t* og = (bf16_t*)(p.ws + WS_O);
    LAS char* Ks = sm;
    LAS char* Vs = sm + 8192;
    LAS char* LKH = sm + 16384 + w * 12288;
    LAS char* LKL = LKH + 4096;
    LAS char* PS = LKH + 8192;
    LAS float* flags = (LAS float*)(sm + 65536);
    const int t0 = qb * 128 + w * 32;
    bf16x8 qf[2][2];
#pragma unroll
    for (int nt = 0; nt < 2; ++nt)
#pragma unroll
        for (int kh = 0; kh < 2; ++kh) qf[nt][kh] = *(const bf16x8*)(Qh + (size_t)(t0 + 16 * nt + fr) * DH + 32 * kh + 8 * fq);
    f32x4 oT[4][2];
#pragma unroll
    for (int i = 0; i < 4; ++i) { oT[i][0] = (f32x4){0.f, 0.f, 0.f, 0.f}; oT[i][1] = (f32x4){0.f, 0.f, 0.f, 0.f}; }
    float R[2] = {0.f, 0.f};
    const int swz = fr & 7;
    for (int kt = 2 * qb + 1; kt >= 0; --kt) {
#pragma unroll
        for (int i = 0; i < 2; ++i) {
            const int pi = tid + 256 * i, row = pi >> 3, c = (pi & 7) ^ (row & 7);
            const u32x4 kv = *(const u32x4*)(Kh + (size_t)(kt * 64 + row) * DH + c * 8);
            const u32x4 vv = *(const u32x4*)(Vth + (size_t)kt * 4096 + row * 64 + c * 8);
            *(LAS u32x4*)(Ks + pi * 16) = kv;
            *(LAS u32x4*)(Vs + pi * 16) = vv;
        }
        __syncthreads();
        if (kt * 64 <= t0) {
            const int s0 = kt * 64;
            f32x4 z[4][2];
#pragma unroll
            for (int i = 0; i < 4; ++i) { z[i][0] = (f32x4){0.f, 0.f, 0.f, 0.f}; z[i][1] = (f32x4){0.f, 0.f, 0.f, 0.f}; }
#pragma unroll
            for (int kh = 0; kh < 2; ++kh)
#pragma unroll
                for (int ms = 0; ms < 4; ++ms) {
                    const bf16x8 kf = *(LAS bf16x8*)(Ks + (16 * ms + fr) * 128 + (((4 * kh + fq) ^ swz) << 4));
                    z[ms][0] = __builtin_amdgcn_mfma_f32_16x16x32_bf16(kf, qf[0][kh], z[ms][0], 0, 0, 0);
                    z[ms][1] = __builtin_amdgcn_mfma_f32_16x16x32_bf16(kf, qf[1][kh], z[ms][1], 0, 0, 0);
                }
            float lsum[2] = {0.f, 0.f};
#pragma unroll
            for (int ms = 0; ms < 4; ++ms)
#pragma unroll
                for (int nt = 0; nt < 2; ++nt) {
                    const int t = t0 + 16 * nt + fr;
                    float hi[4], lo[4];
#pragma unroll
                    for (int j = 0; j < 4; ++j) {
                        const int s = s0 + 16 * ms + 4 * fq + j;
                        const float zz = z[ms][nt][j];
                        const float sp = softplusf_(zz);
                        const float lk = (s < t) ? -sp : 0.f;
                        lsum[nt] += lk;
                        z[ms][nt][j] = zz - sp;
                        const unsigned hb_ = pack2bf(lk, 0.f) & 0xFFFFu;
                        hi[j] = lk; lo[j] = lk - __uint_as_float(hb_ << 16);
                    }
                    const int row = 16 * nt + fr;
                    const int off = row * 128 + ((((2 * ms + (fq >> 1)) ^ swz)) << 4) + (fq & 1) * 8;
                    u32x2 ph; ph[0] = pack2bf(hi[0], hi[1]); ph[1] = pack2bf(hi[2], hi[3]);
                    u32x2 pl; pl[0] = pack2bf(lo[0], lo[1]); pl[1] = pack2bf(lo[2], lo[3]);
                    *(LAS u32x2*)(LKH + off) = ph;
                    *(LAS u32x2*)(LKL + off) = pl;
                }
            __builtin_amdgcn_wave_barrier();
            asm volatile("s_waitcnt lgkmcnt(0)" ::: "memory");
            f32x4 st[4][2];
#pragma unroll
            for (int i = 0; i < 4; ++i) { st[i][0] = (f32x4){0.f, 0.f, 0.f, 0.f}; st[i][1] = (f32x4){0.f, 0.f, 0.f, 0.f}; }
#pragma unroll
            for (int kh = 0; kh < 2; ++kh) {
                bf16x8 bh[2], bl[2];
#pragma unroll
                for (int nt = 0; nt < 2; ++nt) {
                    const int off = (16 * nt + fr) * 128 + (((4 * kh + fq) ^ swz) << 4);
                    bh[nt] = *(LAS bf16x8*)(LKH + off);
                    bl[nt] = *(LAS bf16x8*)(LKL + off);
                }
#pragma unroll
                for (int ms = 0; ms < 4; ++ms) {
                    if (32 * kh + 32 <= 16 * ms + 1) continue;
                    bf16x8 tm;
#pragma unroll
                    for (int e = 0; e < 8; ++e) tm[e] = (32 * kh + 8 * fq + e > 16 * ms + fr) ? (short)0x3F80 : (short)0;
#pragma unroll
                    for (int nt = 0; nt < 2; ++nt) {
                        st[ms][nt] = __builtin_amdgcn_mfma_f32_16x16x32_bf16(tm, bh[nt], st[ms][nt], 0, 0, 0);
                        st[ms][nt] = __builtin_amdgcn_mfma_f32_16x16x32_bf16(tm, bl[nt], st[ms][nt], 0, 0, 0);
                    }
                }
            }
#pragma unroll
            for (int ms = 0; ms < 4; ++ms)
#pragma unroll
                for (int nt = 0; nt < 2; ++nt) {
                    const int t = t0 + 16 * nt + fr;
                    float wv[4];
#pragma unroll
                    for (int j = 0; j < 4; ++j) {
                        const int s = s0 + 16 * ms + 4 * fq + j;
                        const float a = z[ms][nt][j] + R[nt] + st[ms][nt][j];
                        wv[j] = (s < t) ? __expf(a) : 0.f;
                    }
                    const int row = 16 * nt + fr;
                    const int off = row * 128 + ((((2 * ms + (fq >> 1)) ^ swz)) << 4) + (fq & 1) * 8;
                    u32x2 pw; pw[0] = pack2bf(wv[0], wv[1]); pw[1] = pack2bf(wv[2], wv[3]);
                    *(LAS u32x2*)(PS + off) = pw;
                }
#pragma unroll
            for (int nt = 0; nt < 2; ++nt) {
                float tsum = lsum[nt];
                tsum += __shfl_xor(tsum, 16);
                tsum += __shfl_xor(tsum, 32);
                R[nt] += tsum;
            }
            __builtin_amdgcn_wave_barrier();
            asm volatile("s_waitcnt lgkmcnt(0)" ::: "memory");
#pragma unroll
            for (int kh = 0; kh < 2; ++kh) {
                bf16x8 pf[2];
#pragma unroll
                for (int nt = 0; nt < 2; ++nt) pf[nt] = *(LAS bf16x8*)(PS + (16 * nt + fr) * 128 + (((4 * kh + fq) ^ swz) << 4));
#pragma unroll
                for (int md = 0; md < 4; ++md) {
                    const bf16x8 vf = *(LAS bf16x8*)(Vs + (16 * md + fr) * 128 + (((4 * kh + fq) ^ swz) << 4));
                    oT[md][0] = __builtin_amdgcn_mfma_f32_16x16x32_bf16(vf, pf[0], oT[md][0], 0, 0, 0);
                    oT[md][1] = __builtin_amdgcn_mfma_f32_16x16x32_bf16(vf, pf[1], oT[md][1], 0, 0, 0);
                }
            }
        }
        const float wm = wave_max(fmaxf(R[0], R[1]));
        if (lane == 0) flags[(kt & 1) * 4 + w] = wm;
        __syncthreads();
        const float m4 = fmaxf(fmaxf(flags[(kt & 1) * 4 + 0], flags[(kt & 1) * 4 + 1]), fmaxf(flags[(kt & 1) * 4 + 2], flags[(kt & 1) * 4 + 3]));
        if (m4 < -104.5f) break;
    }
#pragma unroll
    for (int md = 0; md < 4; ++md)
#pragma unroll
        for (int nt = 0; nt < 2; ++nt) {
            const int t = t0 + 16 * nt + fr;
            u32x2 o; o[0] = pack2bf(oT[md][nt][0], oT[md][nt][1]); o[1] = pack2bf(oT[md][nt][2], oT[md][nt][3]);
            *(u32x2*)(og + (size_t)t * 512 + head * 64 + 16 * md + 4 * fq) = o;
        }
    __syncthreads();
}

__device__ void phase_mixers(const Params& p, LAS char* sm) {
    constexpr int NQB = LP / 128, NATT = NH * NQB, NCONV = (LTOK + 31) / 32;
    for (int it = blockIdx.x; it < NATT + NCONV; it += gridDim.x) {
        if (it < NATT) { const int qb = NQB - 1 - it / NH, head = it % NH; attn_item(p, sm, head, qb); }
        else conv_item(p, sm, it - NATT);
    }
}

__device__ void phase_gemm2(const Params& p, LAS char* sm) {
    const int tid = tid_opaque(), lane = tid & 63, wid = tid >> 6, wr = wid >> 1, wc = wid & 1, fr = lane & 15, fq = lane >> 4;
    const bf16_t* cs = (const bf16_t*)(p.ws + WS_CS);
    const bf16_t* og = (const bf16_t*)(p.ws + WS_O);
    const bf16_t* wco = (const bf16_t*)(p.ws + WS_WCO);
    const bf16_t* wso = (const bf16_t*)(p.ws + WS_WSO);
    const bf16_t* gate = (const bf16_t*)(p.ws + WS_GATE);
    bf16_t* mixed = (bf16_t*)(p.ws + WS_HB);
    for (int it = blockIdx.x; it < 128 * 8; it += gridDim.x) {
        const int mt = it >> 3, nt = it & 7, m0 = NMETA + mt * 128;
        f32x4 a1[4][4], a2[4][4]; zero_acc(a1); zero_acc(a2);
        gemm128(cs + (size_t)m0 * 512, 512, wco + (size_t)nt * 128 * 512, 512, 512, sm, a1);
        gemm128(og + (size_t)m0 * 512, 512, wso + (size_t)nt * 128 * 512, 512, 512, sm, a2);
#pragma unroll
        for (int mi = 0; mi < 4; ++mi)
#pragma unroll
            for (int ni = 0; ni < 4; ++ni) {
                const int row = m0 + wr * 64 + mi * 16 + fr, col = nt * 128 + wc * 64 + ni * 16 + fq * 4;
                const u32x2 gc = *(const u32x2*)(gate + (size_t)row * 2048 + col);
                const u32x2 gs = *(const u32x2*)(gate + (size_t)row * 2048 + 1024 + col);
                const float m0v = bflo(gc[0]) * a1[mi][ni][0] + bflo(gs[0]) * a2[mi][ni][0];
                const float m1v = bfhi(gc[0]) * a1[mi][ni][1] + bfhi(gs[0]) * a2[mi][ni][1];
                const float m2v = bflo(gc[1]) * a1[mi][ni][2] + bflo(gs[1]) * a2[mi][ni][2];
                const float m3v = bfhi(gc[1]) * a1[mi][ni][3] + bfhi(gs[1]) * a2[mi][ni][3];
                u32x2 o; o[0] = pack2bf(m0v, m1v); o[1] = pack2bf(m2v, m3v);
                *(u32x2*)(mixed + (size_t)row * D + col) = o;
            }
    }
}

__device__ void phase_gemm3(const Params& p, LAS char* sm) {
    const int tid = tid_opaque(), lane = tid & 63, wid = tid >> 6, wr = wid >> 1, wc = wid & 1, fr = lane & 15, fq = lane >> 4;
    const bf16_t* mixed = (const bf16_t*)(p.ws + WS_HB);
    const bf16_t* wo = (const bf16_t*)(p.ws + WS_WO);
    bf16_t* h2b = (bf16_t*)(p.ws + WS_H2B);
    float* ss2 = (float*)(p.ws + WS_SS2);
    for (int it = blockIdx.x; it < 128 * 8; it += gridDim.x) {
        const int mt = it >> 3, nt = it & 7;
        f32x4 acc[4][4]; zero_acc(acc);
        gemm128(mixed + (size_t)(NMETA + mt * 128) * D, D, wo + (size_t)nt * 128 * D, D, D, sm, acc);
#pragma unroll
        for (int mi = 0; mi < 4; ++mi) {
            const int tok = mt * 128 + wr * 64 + mi * 16 + fr;
            float ssq = 0.f;
#pragma unroll
            for (int ni = 0; ni < 4; ++ni) {
                const int col = nt * 128 + wc * 64 + ni * 16 + fq * 4;
                const f32x4 hv = *(const f32x4*)(p.x + (size_t)tok * D + col);
                const f32x4 h2 = hv + acc[mi][ni];
                *(f32x4*)(p.out + (size_t)tok * D + col) = h2;
                u32x2 o; o[0] = pack2bf(h2[0], h2[1]); o[1] = pack2bf(h2[2], h2[3]);
                *(u32x2*)(h2b + (size_t)tok * D + col) = o;
                ssq += h2[0] * h2[0] + h2[1] * h2[1] + h2[2] * h2[2] + h2[3] * h2[3];
            }
            ssq += __shfl_xor(ssq, 16);
            ssq += __shfl_xor(ssq, 32);
            if (fq == 0) atomicAdd(&ss2[tok], ssq);
        }
    }
    {
        bf16_t* ub = (bf16_t*)(p.ws + WS_UB); bf16_t* vb = (bf16_t*)(p.ws + WS_VB);
        const size_t n8 = (size_t)16384 * 1024 / 8;
        for (size_t i = (size_t)blockIdx.x * NTHREADS + tid; i < n8; i += (size_t)gridDim.x * NTHREADS) {
            const f32x4 a0 = *(const f32x4*)(p.peer_u + i * 8), a1 = *(const f32x4*)(p.peer_u + i * 8 + 4);
            const f32x4 b0 = *(const f32x4*)(p.peer_v + i * 8), b1 = *(const f32x4*)(p.peer_v + i * 8 + 4);
            u32x4 o; o[0] = pack2bf(a0[0], a0[1]); o[1] = pack2bf(a0[2], a0[3]); o[2] = pack2bf(a1[0], a1[1]); o[3] = pack2bf(a1[2], a1[3]);
            *(u32x4*)(ub + i * 8) = o;
            o[0] = pack2bf(b0[0], b0[1]); o[1] = pack2bf(b0[2], b0[3]); o[2] = pack2bf(b1[0], b1[1]); o[3] = pack2bf(b1[2], b1[3]);
            *(u32x4*)(vb + i * 8) = o;
        }
    }
}

__device__ __forceinline__ void bitonic_sort16_desc(int (&a)[16]) {
#pragma unroll
    for (int k = 2; k <= 16; k <<= 1)
#pragma unroll
        for (int j = k >> 1; j > 0; j >>= 1)
#pragma unroll
            for (int i = 0; i < 16; ++i) {
                const int l = i ^ j;
                if (l > i) {
                    const bool desc = ((i & k) == 0);
                    const int x = max(a[i], a[l]), y = min(a[i], a[l]);
                    a[i] = desc ? x : y; a[l] = desc ? y : x;
                }
            }
}
__device__ __forceinline__ void merge_top16_desc(int (&r)[16], const int (&g)[16]) {
#pragma unroll
    for (int i = 0; i < 16; ++i) r[i] = max(r[i], g[15 - i]);
#pragma unroll
    for (int j = 8; j > 0; j >>= 1)
#pragma unroll
        for (int i = 0; i < 16; ++i) {
            const int l = i ^ j;
            if (l > i) { const int x = max(r[i], r[l]), y = min(r[i], r[l]); r[i] = x; r[l] = y; }
        }
}
__device__ __forceinline__ int f2key(float f) { const int b = __float_as_int(f); return b ^ ((b >> 31) & 0x7FFFFFFF); }
__device__ __forceinline__ float key2f(int k) { return __int_as_float(k ^ ((k >> 31) & 0x7FFFFFFF)); }

__device__ void phase_route(const Params& p, LAS char* sm) {
    const int tid = tid_opaque(), lane = tid & 63, wid = tid >> 6, wr = wid >> 1, wc = wid & 1, fr = lane & 15, fq = lane >> 4;
    const bf16_t* h2b = (const bf16_t*)(p.ws + WS_H2B);
    const bf16_t* wq = (const bf16_t*)(p.ws + WS_WQ);
    const float* ss2 = (const float*)(p.ws + WS_SS2);
    int* pidx = (int*)(p.ws + WS_PIDX);
    float* pgate = (float*)(p.ws + WS_PGATE);
    for (int it = blockIdx.x; it < 128 * PH; it += gridDim.x) {
        const int mt = it / PH, head = it % PH;
        int keep0[16];
#pragma unroll 1
        for (int half = 0; half < 2; ++half) {
            f32x4 acc[4][4]; zero_acc(acc);
            gemm128(h2b + (size_t)mt * 128 * D, D, wq + (size_t)(head * 256 + half * 128) * D, D, D, sm, acc);
#pragma unroll
            for (int mi = 0; mi < 4; ++mi) {
                const int row = wr * 64 + mi * 16 + fr;
                const float sc = rsqrtf(ss2[mt * 128 + row] * (1.f / D) + EPS);
#pragma unroll
                for (int ni = 0; ni < 4; ++ni) {
                    const int chunk = 8 * wc + 2 * ni + (fq >> 1);
                    u32x2 o; o[0] = pack2bf(acc[mi][ni][0] * sc, acc[mi][ni][1] * sc); o[1] = pack2bf(acc[mi][ni][2] * sc, acc[mi][ni][3] * sc);
                    *(LAS u32x2*)(sm + row * 256 + ((chunk ^ (row & 15)) << 4) + (fq & 1) * 8) = o;
                }
            }
            __syncthreads();
            const bf16_t* kb = (const bf16_t*)(p.ws + (half ? WS_K2 : WS_K1)) + (size_t)head * 128 * 128;
            f32x4 sacc[2][8];
#pragma unroll
            for (int i = 0; i < 2; ++i)
#pragma unroll
                for (int j = 0; j < 8; ++j) sacc[i][j] = (f32x4){0.f, 0.f, 0.f, 0.f};
#pragma unroll 1
            for (int kh = 0; kh < 4; ++kh) {
                bf16x8 qa[2];
#pragma unroll
                for (int mi = 0; mi < 2; ++mi) {
                    const int row = wid * 32 + mi * 16 + fr;
                    qa[mi] = *(LAS bf16x8*)(sm + row * 256 + (((4 * kh + fq) ^ (row & 15)) << 4));
                }
#pragma unroll
                for (int ni = 0; ni < 8; ++ni) {
                    const bf16x8 kf = *(const bf16x8*)(kb + (size_t)(16 * ni + fr) * 128 + 32 * kh + 8 * fq);
                    sacc[0][ni] = __builtin_amdgcn_mfma_f32_16x16x32_bf16(kf, qa[0], sacc[0][ni], 0, 0, 0);
                    sacc[1][ni] = __builtin_amdgcn_mfma_f32_16x16x32_bf16(kf, qa[1], sacc[1][ni], 0, 0, 0);
                }
            }
            __syncthreads();
#pragma unroll
            for (int mi = 0; mi < 2; ++mi)
#pragma unroll
                for (int ni = 0; ni < 8; ++ni) *(LAS f32x4*)(sm + tswz(wid * 32 + mi * 16 + fr, 16 * ni + 4 * fq)) = sacc[mi][ni];
            __syncthreads();
            if (tid < 128) {
                int run[16];
#pragma unroll
                for (int g = 0; g < 8; ++g) {
                    int grp[16];
#pragma unroll
                    for (int q = 0; q < 4; ++q) {
                        const f32x4 v = *(LAS f32x4*)(sm + tswz(tid, 16 * g + 4 * q));
#pragma unroll
                        for (int e = 0; e < 4; ++e) grp[4 * q + e] = (f2key(v[e]) & ~127) | (127 - (16 * g + 4 * q + e));
                    }
                    bitonic_sort16_desc(grp);
                    if (g == 0) {
#pragma unroll
                        for (int i = 0; i < 16; ++i) run[i] = grp[i];
                    } else merge_top16_desc(run, grp);
                }
                if (half == 0) {
#pragma unroll
                    for (int i = 0; i < 16; ++i) keep0[i] = run[i];
                } else {
                    float v1[16], v2[16];
#pragma unroll
                    for (int i = 0; i < 16; ++i) { v1[i] = key2f(keep0[i] & ~127); v2[i] = key2f(run[i] & ~127); }
                    int best[16];
#pragma unroll
                    for (int i = 0; i < 16; ++i) {
                        int grp[16];
#pragma unroll
                        for (int j = 0; j < 16; ++j) grp[j] = (f2key(v1[i] + v2[j]) & ~255) | (255 - (16 * i + j));
                        if (i == 0) {
#pragma unroll
                            for (int j = 0; j < 16; ++j) best[j] = grp[j];
                        } else merge_top16_desc(best, grp);
                    }
                    LAS int* myrow = (LAS int*)(sm + tid * 512);
#pragma unroll
                    for (int i = 0; i < 16; ++i) { myrow[i] = 127 - (keep0[i] & 127); myrow[16 + i] = 127 - (run[i] & 127); }
                    float bv[16]; float mx = -3.0e38f;
#pragma unroll
                    for (int k = 0; k < 16; ++k) { bv[k] = key2f(best[k] & ~255); mx = fmaxf(mx, bv[k]); }
                    float se = 0.f;
#pragma unroll
                    for (int k = 0; k < 16; ++k) { bv[k] = __expf(bv[k] - mx); se += bv[k]; }
                    const float inv = 1.f / se;
                    const size_t ob = ((size_t)(mt * 128 + tid)) * 128 + head * 16;
#pragma unroll
                    for (int k4 = 0; k4 < 4; ++k4) {
                        int id[4]; f32x4 gv;
#pragma unroll
                        for (int e = 0; e < 4; ++e) {
                            const int code = 255 - (best[k4 * 4 + e] & 255);
                            id[e] = myrow[code >> 4] * NKEYS + myrow[16 + (code & 15)];
                            gv[e] = bv[k4 * 4 + e] * inv;
                        }
                        *(int4*)(pidx + ob + k4 * 4) = make_int4(id[0], id[1], id[2], id[3]);
                        *(f32x4*)(pgate + ob + k4 * 4) = gv;
                    }
                }
            }
            __syncthreads();
        }
    }
}

__device__ __forceinline__ float gelu_exact(float x) { return 0.5f * x * (1.f + erff(x * 0.70710678118654752f)); }

__device__ void phase_peer(const Params& p) {
    const int tid = tid_opaque(), lane = tid & 63, wid = tid >> 6;
    const float* ss2 = (const float*)(p.ws + WS_SS2);
    const int* pidx = (const int*)(p.ws + WS_PIDX);
    const float* pgate = (const float*)(p.ws + WS_PGATE);
    const bf16_t* ub = (const bf16_t*)(p.ws + WS_UB);
    const bf16_t* vb = (const bf16_t*)(p.ws + WS_VB);
    for (int tok = blockIdx.x * 4 + wid; tok < SEQ; tok += gridDim.x * 4) {
        const float rstd = rsqrtf(ss2[tok] * (1.f / D) + EPS);
        float xn[16], oacc[16];
#pragma unroll
        for (int i = 0; i < 2; ++i)
#pragma unroll
            for (int h = 0; h < 2; ++h) {
                const int d0 = 8 * lane + 512 * i + 4 * h;
                const f32x4 hv = *(const f32x4*)(p.out + (size_t)tok * D + d0);
                const f32x4 g = *(const f32x4*)(p.norm2_g + d0);
#pragma unroll
                for (int e = 0; e < 4; ++e) { oacc[i * 8 + h * 4 + e] = hv[e]; xn[i * 8 + h * 4 + e] = hv[e] * rstd * g[e]; }
            }
        const int id0 = pidx[(size_t)tok * 128 + lane], id1 = pidx[(size_t)tok * 128 + 64 + lane];
        const float gt0 = pgate[(size_t)tok * 128 + lane], gt1 = pgate[(size_t)tok * 128 + 64 + lane];
#pragma unroll 1
        for (int b = 0; b < 16; ++b) {
            const int idsel = (b < 8) ? id0 : id1;
            const float gtsel = (b < 8) ? gt0 : gt1;
            u32x4 ur[8][2], vr[8][2];
#pragma unroll
            for (int q = 0; q < 8; ++q) {
                const int e = __builtin_amdgcn_readlane(idsel, (b & 7) * 8 + q);
                const bf16_t* up = ub + (size_t)e * D + 8 * lane;
                const bf16_t* vp = vb + (size_t)e * D + 8 * lane;
                ur[q][0] = *(const u32x4*)(up); ur[q][1] = *(const u32x4*)(up + 512);
                vr[q][0] = *(const u32x4*)(vp); vr[q][1] = *(const u32x4*)(vp + 512);
            }
            float a[8];
#pragma unroll
            for (int q = 0; q < 8; ++q) {
                float s = 0.f;
#pragma unroll
                for (int i = 0; i < 2; ++i)
#pragma unroll
                    for (int c = 0; c < 4; ++c) { s += xn[i * 8 + 2 * c] * bflo(ur[q][i][c]); s += xn[i * 8 + 2 * c + 1] * bfhi(ur[q][i][c]); }
                a[q] = s;
            }
            float b4[4], c2[2], d1;
            const bool h32 = lane & 32, h16 = lane & 16, h8 = lane & 8;
#pragma unroll
            for (int q = 0; q < 4; ++q) { const float keep = h32 ? a[q + 4] : a[q], send = h32 ? a[q] : a[q + 4]; b4[q] = keep + __shfl_xor(send, 32); }
#pragma unroll
            for (int q = 0; q < 2; ++q) { const float keep = h16 ? b4[q + 2] : b4[q], send = h16 ? b4[q] : b4[q + 2]; c2[q] = keep + __shfl_xor(send, 16); }
            { const float keep = h8 ? c2[1] : c2[0], send = h8 ? c2[0] : c2[1]; d1 = keep + __shfl_xor(send, 8); }
            d1 += __shfl_xor(d1, 4); d1 += __shfl_xor(d1, 2); d1 += __shfl_xor(d1, 1);
            const int myq = ((lane >> 5) & 1) * 4 + ((lane >> 4) & 1) * 2 + ((lane >> 3) & 1);
            const float gq = __shfl(gtsel, (b & 7) * 8 + myq);
            const float coef = gq * gelu_exact(d1);
#pragma unroll
            for (int q = 0; q < 8; ++q) {
                const int srcl = ((q >> 2) & 1) * 32 + ((q >> 1) & 1) * 16 + (q & 1) * 8;
                const float cc = __int_as_float(__builtin_amdgcn_readlane(__float_as_int(coef), srcl));
#pragma unroll
                for (int i = 0; i < 2; ++i)
#pragma unroll
                    for (int c = 0; c < 4; ++c) { oacc[i * 8 + 2 * c] += cc * bflo(vr[q][i][c]); oacc[i * 8 + 2 * c + 1] += cc * bfhi(vr[q][i][c]); }
            }
        }
#pragma unroll
        for (int i = 0; i < 2; ++i)
#pragma unroll
            for (int h = 0; h < 2; ++h) {
                const int d0 = 8 * lane + 512 * i + 4 * h;
                f32x4 o; o[0] = oacc[i * 8 + h * 4]; o[1] = oacc[i * 8 + h * 4 + 1]; o[2] = oacc[i * 8 + h * 4 + 2]; o[3] = oacc[i * 8 + h * 4 + 3];
                *(f32x4*)(p.out + (size_t)tok * D + d0) = o;
            }
    }
}

__global__ void __launch_bounds__(NTHREADS, 2) fwd_kernel(Params p) {
    __shared__ __attribute__((aligned(16))) char smem[LDS_BYTES];
    LAS char* sm = (LAS char*)smem;
    cg::grid_group grid = cg::this_grid();
    for (int ph = p.ph_lo; ph < p.ph_hi; ++ph) {
        switch (ph) {
            case 0: phase_prep(p, sm); break;
            case 1: phase_gemm1(p, sm); break;
            case 2: phase_mixers(p, sm); break;
            case 3: phase_gemm2(p, sm); break;
            case 4: phase_gemm3(p, sm); break;
            case 5: phase_route(p, sm); break;
            case 6: phase_peer(p); break;
        }
        if (ph + 1 < p.ph_hi) grid.sync();
    }
}

extern "C" void kernel_launch(void* const* d_in, const int* in_sizes, int n_in, void* d_out, int out_size, void* d_ws, size_t ws_size, hipStream_t stream) {
    static int grid = 0;
    if (grid == 0) {
        int dev = 0, cus = 0, per_cu = 0;
        hipGetDevice(&dev);
        hipDeviceGetAttribute(&cus, hipDeviceAttributeMultiprocessorCount, dev);
        hipOccupancyMaxActiveBlocksPerMultiprocessor(&per_cu, (const void*)fwd_kernel, NTHREADS, 0);
        if (per_cu > 2) per_cu = 2;
        if (per_cu < 1) per_cu = 1;
        grid = cus * per_cu;
        if (ws_size < WS_END) { fprintf(stderr, "kernel_launch: workspace too small: %zu < %zu\n", ws_size, (size_t)WS_END); grid = -1; }
    }
    if (grid < 0) return;
    Params p{};
    const float* const* in = (const float* const*)d_in;
    p.x = in[0]; p.meta = in[1]; p.norm1_g = in[2]; p.w_in = in[3]; p.conv_w = in[4]; p.conv_b = in[5]; p.conv_ln_g = in[6]; p.conv_ln_b = in[7];
    p.w_conv_out = in[8]; p.q_norm_g = in[9]; p.k_norm_g = in[10]; p.w_sb_out = in[11]; p.w_gate = in[12]; p.b_gate = in[13]; p.w_o = in[14];
    p.norm2_g = in[15]; p.peer_wq = in[16]; p.peer_k1 = in[17]; p.peer_k2 = in[18]; p.peer_u = in[19]; p.peer_v = in[20];
    p.out = (float*)d_out; p.ws = (unsigned char*)d_ws;
#if MULTI_LAUNCH
    for (int ph = 0; ph < 7; ++ph) {
        p.ph_lo = ph; p.ph_hi = ph + 1;
        hipLaunchKernelGGL(fwd_kernel, dim3(grid), dim3(NTHREADS), 0, stream, p);
    }
#else
    p.ph_lo = 0; p.ph_hi = 7;
    void* args[] = {&p};
    hipError_t e = hipLaunchCooperativeKernel((const void*)fwd_kernel, dim3(grid), dim3(NTHREADS), args, 0, stream);
    if (e != hipSuccess) fprintf(stderr, "cooperative launch failed: %s (grid %d)\n", hipGetErrorString(e), grid);
#endif
}
```

```cpp
#include <hip/hip_runtime.h>
#include <hip/hip_cooperative_groups.h>
#include <cstdio>
#include <cstdint>
#include <type_traits>
namespace cg = cooperative_groups;

#ifndef MULTI_LAUNCH
#define MULTI_LAUNCH 0
#endif

#define LAS __attribute__((address_space(3)))
#define GAS __attribute__((address_space(1)))
typedef unsigned short bf16_t;
typedef short bf16x8 __attribute__((ext_vector_type(8)));
typedef _Float16 f16x8 __attribute__((ext_vector_type(8)));
typedef float f32x4 __attribute__((ext_vector_type(4)));
typedef float f32x2 __attribute__((ext_vector_type(2)));
typedef unsigned u32x4 __attribute__((ext_vector_type(4)));
typedef unsigned u32x2 __attribute__((ext_vector_type(2)));
typedef int i32x4 __attribute__((ext_vector_type(4)));
typedef int i32x2 __attribute__((ext_vector_type(2)));

constexpr int D = 1024, SEQ = 16384, NMETA = 16, LTOK = SEQ + NMETA, LP2 = 16640;
constexpr int CONVC = 512, CONVW = 31, NH = 8, DH = 64, INC = 2560;
constexpr int PH = 8, NKEYS = 128;
constexpr float EPS = 1e-6f;
constexpr int NT = 512, NWV = 8;
constexpr int LDS_MAIN = 131072, LDS_BYTES = LDS_MAIN + 4096;

constexpr size_t TS = 524288;
constexpr size_t WS_RSTD1 = 16384;
constexpr size_t WS_RSTD2 = WS_RSTD1 + 131072;
constexpr size_t WS_SCU   = WS_RSTD2 + 65536;
constexpr size_t WS_SCV   = WS_SCU + 65536;
constexpr size_t WS_K1    = WS_SCV + 65536;
constexpr size_t WS_K2    = WS_K1 + 262144;
constexpr size_t WS_SSP   = WS_K2 + 262144;
constexpr size_t WS_WCAT  = 4 * TS;
constexpr size_t WS_WVT   = WS_WCAT + 16 * TS;
constexpr size_t WS_W2    = WS_WVT + 2 * TS;
constexpr size_t WS_WO    = WS_W2 + 4 * TS;
constexpr size_t WS_WQ    = WS_WO + 4 * TS;
constexpr size_t WS_HB    = WS_WQ + 8 * TS;
constexpr size_t WS_GATE  = WS_HB + 65 * TS;
constexpr size_t WS_GLU   = WS_GATE + 130 * TS;
constexpr size_t WS_Q     = WS_GLU + (size_t)LP2 * 512 * 2;
constexpr size_t WS_K     = WS_Q + (size_t)LP2 * 512 * 2;
constexpr size_t WS_VT    = WS_K + (size_t)LP2 * 512 * 2;
constexpr size_t WS_CO    = WS_VT + (size_t)LP2 * 512 * 2;
constexpr size_t WS_MIXED = WS_K;
constexpr size_t WS_H2B   = WS_GLU;
constexpr size_t WS_QP    = WS_K;
constexpr size_t WS_PART  = WS_K;
constexpr size_t WS_COEF  = WS_HB;
constexpr size_t WS_PIDX  = WS_GATE;
constexpr size_t WS_PGATE = WS_PIDX + (size_t)SEQ * 128 * 4;
constexpr size_t WS_UB    = WS_CO + (size_t)LP2 * 1024 * 2;
constexpr size_t WS_VB    = WS_UB + (size_t)16384 * 1024;
constexpr size_t WS_END   = WS_VB + (size_t)16384 * 1024;
static_assert(WS_SSP + (size_t)SEQ * 16 * 4 <= WS_WCAT, "small region overflow");
static_assert((size_t)SEQ * 2048 * 2 <= (size_t)LP2 * 512 * 2 * 2 + (size_t)LP2 * 1024 * 2, "qp does not fit");
static_assert((size_t)8 * SEQ * 128 * 4 <= (size_t)LP2 * 512 * 2 * 4, "part does not fit");
constexpr int TILE_WCAT = (int)(WS_WCAT / TS), TILE_WVT = (int)(WS_WVT / TS), TILE_HB = (int)(WS_HB / TS);
constexpr int CTR_MIX = 8, CTR_CONV = 9;

struct Params {
    const float* x; const float* meta; const float* norm1_g; const float* w_in; const float* conv_w; const float* conv_b;
    const float* conv_ln_g; const float* conv_ln_b; const float* w_conv_out; const float* q_norm_g; const float* k_norm_g;
    const float* w_sb_out; const float* w_gate; const float* b_gate; const float* w_o; const float* norm2_g;
    const float* peer_wq; const float* peer_k1; const float* peer_k2; const float* peer_u; const float* peer_v;
    float* out; unsigned char* ws;
    int ph_lo, ph_hi;
};

typedef float pk_f32x2 __attribute__((ext_vector_type(2)));
typedef __bf16 pk_bf16x2 __attribute__((ext_vector_type(2)));
typedef _Float16 pk_f16x2 __attribute__((ext_vector_type(2)));
__device__ __forceinline__ unsigned pack2bf(float lo, float hi) { pk_f32x2 v = {lo, hi}; return __builtin_bit_cast(unsigned, __builtin_convertvector(v, pk_bf16x2)); }
__device__ __forceinline__ unsigned pack2h(float lo, float hi) { pk_f32x2 v = {lo, hi}; return __builtin_bit_cast(unsigned, __builtin_convertvector(v, pk_f16x2)); }
__device__ __forceinline__ float bflo(unsigned u) { return __uint_as_float(u << 16); }
__device__ __forceinline__ float bfhi(unsigned u) { return __uint_as_float(u & 0xFFFF0000u); }
__device__ __forceinline__ float wave_sum(float v) {
#pragma unroll
    for (int o = 32; o > 0; o >>= 1) v += __shfl_xor(v, o);
    return v;
}
__device__ __forceinline__ float wave_max(float v) {
#pragma unroll
    for (int o = 32; o > 0; o >>= 1) v = fmaxf(v, __shfl_xor(v, o));
    return v;
}
__device__ __forceinline__ float sigmoidf_(float x) { return 1.f / (1.f + __expf(-x)); }
__device__ __forceinline__ int tid_opaque() { int t = threadIdx.x; asm volatile("" : "+v"(t)); return t; }
__device__ __forceinline__ int tswz(int r, int c) { return r * 512 + ((((c >> 2) ^ r) & 31) << 4) + ((c & 3) << 2); }

#define XB_TMO      128
#define XB_XCNT(j)  (256  + 64 * (j))
#define XB_XSUB(j)  (1280 + 64 * (j))
#define XB_XGEN(j)  (2304 + 64 * (j))
#define XB_TOP      3328
#define XB_TOPGEN   3392
#define XCD_BAR_WORDS 3456
#define XB_SPIN_CAP (1u << 20)
__device__ __forceinline__ unsigned xb_ld(unsigned* p)              { return __hip_atomic_load(p, __ATOMIC_RELAXED, __HIP_MEMORY_SCOPE_AGENT); }
__device__ __forceinline__ unsigned xb_add(unsigned* p, unsigned v) { return __hip_atomic_fetch_add(p, v, __ATOMIC_RELAXED, __HIP_MEMORY_SCOPE_AGENT); }
__device__ __forceinline__ unsigned xb_xcc_id() { return (unsigned)__builtin_amdgcn_s_getreg((3 << 11) | 20) & 0xFu; }
#define XB_SPIN(cond, bar) do { unsigned _sp = 0; while (cond) { __builtin_amdgcn_s_sleep(1); \
    if ((++_sp & 255u) == 0u) { if (xb_ld(&(bar)[XB_TMO])) break; if (_sp > XB_SPIN_CAP) { atomicAdd(&(bar)[XB_TMO], 1u); break; } } } } while (0)
struct XcdBarrier { unsigned* bar; unsigned x; volatile LAS unsigned* st; };
__device__ __forceinline__ XcdBarrier xcd_barrier_post(unsigned* bar, volatile LAS unsigned* st) {
    XcdBarrier b; b.bar = bar; b.x = xb_xcc_id(); b.st = st;
    if (threadIdx.x == 0) (void)xb_add(&bar[XB_XCNT(b.x)], 1u);
    return b;
}
__device__ __forceinline__ void xcd_barrier_complete(unsigned* bar, unsigned x, unsigned& nloc, unsigned& nx) {
    const unsigned G = gridDim.x * gridDim.y * gridDim.z;
    unsigned sum, cnt, mine, sp = 0u;
    for (;;) {
        sum = 0u; cnt = 0u; mine = 0u;
#pragma unroll
        for (unsigned j = 0; j < 16; ++j) { const unsigned c = xb_ld(&bar[XB_XCNT(j)]); sum += c; cnt += (c > 0u) ? 1u : 0u; mine = (j == x) ? c : mine; }
        if (sum == G) break;
        __builtin_amdgcn_s_sleep(1);
        if ((++sp & 255u) == 0u) { if (xb_ld(&bar[XB_TMO])) break; if (sp > XB_SPIN_CAP) { atomicAdd(&bar[XB_TMO], 1u); break; } }
    }
    nloc = mine > 0u ? mine : 1u; nx = cnt > 0u ? cnt : 1u;
}
__device__ __forceinline__ void xcd_barrier(const XcdBarrier& b) {
    asm volatile("s_waitcnt vmcnt(0)" ::: "memory");
    __syncthreads();
    if (threadIdx.x == 0) {
        unsigned* bar = b.bar;
        __builtin_amdgcn_s_waitcnt(0);
        unsigned nloc = b.st[0], nx = b.st[1];
        if (nloc == 0u) { xcd_barrier_complete(bar, b.x, nloc, nx); b.st[0] = nloc; b.st[1] = nx; }
        const unsigned old = xb_add(&bar[XB_XSUB(b.x)], 1u);
        const unsigned gen = old / nloc;
        if (old + 1u == (gen + 1u) * nloc) {
            __builtin_amdgcn_fence(__ATOMIC_RELEASE, "agent");
            asm volatile("s_waitcnt vmcnt(0)" ::: "memory");
            const unsigned og = xb_add(&bar[XB_TOP], 1u);
            const unsigned tg = og / nx;
            if (og + 1u == (tg + 1u) * nx) xb_add(&bar[XB_TOPGEN], 1u);
            else XB_SPIN(xb_ld(&bar[XB_TOPGEN]) == tg, bar);
            __builtin_amdgcn_fence(__ATOMIC_ACQUIRE, "agent");
            xb_add(&bar[XB_XGEN(b.x)], 1u);
            asm volatile("s_waitcnt vmcnt(0)" ::: "memory");
        } else {
            XB_SPIN(xb_ld(&bar[XB_XGEN(b.x)]) == gen, bar);
            __builtin_amdgcn_fence(__ATOMIC_ACQUIRE, "agent");
            asm volatile("s_waitcnt vmcnt(0)" ::: "memory");
        }
    }
    __syncthreads();
}

namespace pg8 {
constexpr int BM = 256, BK = 64, HALF = 128, HTB = HALF * BK * 2, STAGE_BYTES = 8 * HTB;
__host__ __device__ __forceinline__ int lds_byte(int r, int c) { const int st = (r >> 4) * 2 + (c >> 5), rr = r & 15, cc = c & 31, ob = rr * 64 + cc * 2; return st * 1024 + (ob ^ (((ob >> 9) & 1) << 5)); }
__host__ __device__ __forceinline__ void stage_rc(int b, int& R, int& C) { const int st = b / 1024, sb = b % 1024, swz = sb ^ (((sb >> 9) & 1) << 5); R = (st >> 1) * 16 + swz / 64; C = (st & 1) * 32 + (swz % 64) / 2; }
__host__ __device__ __forceinline__ int perm32(int rho) { const int n = rho >> 4, i = rho & 15; return 8 * (i >> 2) + 4 * n + (i & 3); }
struct Unit { int pm, pn; };
struct Gemm { const bf16_t* A; const bf16_t* Bt; int K; };

template <class Epi, class Sched>
__device__ __forceinline__ void gemm_phase(LAS unsigned char* lds, const Gemm g, const Sched& S, const Epi& E) {
    const int tid = threadIdx.x, wid = __builtin_amdgcn_readfirstlane(tid >> 6), lane = tid & 63, wr = wid >> 2, wc = wid & 3, fr = lane & 15, fq = lane >> 4;
    const int K = g.K, nt = K / BK;
    unsigned voffA[2], voffB[2];
#pragma unroll
    for (int i = 0; i < 2; ++i) { int R, C; stage_rc(tid * 16 + i * 8192, R, C); const int Rb = (R & ~31) + perm32(R & 31);
        voffA[i] = (unsigned)(R * K + C) * 2u; voffB[i] = (unsigned)(Rb * K + C) * 2u; }
    const size_t kstep = (size_t)(BK * 2);
    const size_t hstep = (size_t)HALF * K * 2;
    const size_t tstep = 2 * hstep;
    const unsigned ldsw = (unsigned)wid * 1024u;
    const int aoff = lds_byte(wr * 64 + fr, fq * 8), boff = lds_byte(wc * 32 + fr, fq * 8);
#define PG8_SA(b, h) (((b) * 2 + (h)) * HTB)
#define PG8_SB(b, h) ((4 + (b) * 2 + (h)) * HTB)
#define PG8_STAGE(bufoff, gbase, voff) do { _Pragma("unroll") for (int _i = 0; _i < 2; ++_i) \
        __builtin_amdgcn_global_load_lds((const GAS unsigned*)((const char*)(gbase) + (voff)[_i]), (LAS unsigned*)(lds + (bufoff) + ldsw + _i * 8192), 16, 0, 0); } while (0)
#define PG8_LDA(dst, b, h) do { _Pragma("unroll") for (int m = 0; m < 4; ++m) _Pragma("unroll") for (int k = 0; k < 2; ++k) dst[m][k] = *(const LAS bf16x8*)(lds + PG8_SA(b, h) + aoff + m * 2048 + k * 1024); } while (0)
#define PG8_LDB(dst, b, h) do { _Pragma("unroll") for (int n = 0; n < 2; ++n) _Pragma("unroll") for (int k = 0; k < 2; ++k) dst[n][k] = *(const LAS bf16x8*)(lds + PG8_SB(b, h) + boff + n * 2048 + k * 1024); } while (0)
#define PG8_MMA(ai, bj, At, Bt) do { __builtin_amdgcn_s_setprio(1); _Pragma("unroll") for (int m = 0; m < 4; ++m) _Pragma("unroll") for (int n = 0; n < 2; ++n) _Pragma("unroll") for (int k = 0; k < 2; ++k) \
        acc[ai][bj][m][n] = __builtin_amdgcn_mfma_f32_16x16x32_bf16(Bt[n][k], At[m][k], acc[ai][bj][m][n], 0, 0, 0); __builtin_amdgcn_s_setprio(0); } while (0)
#define PG8_WAIT_V(n) asm volatile("s_waitcnt vmcnt(" #n ")" ::: "memory")
#define PG8_WAIT_L(n) asm volatile("s_waitcnt lgkmcnt(" #n ")" ::: "memory")
#define PG8_BAR __builtin_amdgcn_s_barrier()
#define PG8_SCHED __builtin_amdgcn_sched_barrier(0)
    Unit cur, nxt; int ui = 0;
    if (!S.next(0, cur)) return;
    f32x4 acc[2][2][4][2];
#pragma unroll
    for (int a = 0; a < 2; ++a)
#pragma unroll
        for (int b = 0; b < 2; ++b)
#pragma unroll
            for (int m = 0; m < 4; ++m)
#pragma unroll
                for (int n = 0; n < 2; ++n) acc[a][b][m][n] = (f32x4){0.f, 0.f, 0.f, 0.f};
    bf16x8 At[4][2], B0[2][2], B1[2][2];
    const char* cA = (const char*)g.A + (size_t)cur.pm * tstep; const char* cB = (const char*)g.Bt + (size_t)cur.pn * tstep;
    PG8_STAGE(PG8_SB(0, 0), cB, voffB); PG8_STAGE(PG8_SA(0, 0), cA, voffA); PG8_STAGE(PG8_SB(0, 1), cB + hstep, voffB); PG8_STAGE(PG8_SA(0, 1), cA + hstep, voffA);
    if (wr == 1) PG8_BAR;
    PG8_WAIT_V(4); PG8_BAR;
    PG8_STAGE(PG8_SB(1, 0), cB + kstep, voffB); PG8_STAGE(PG8_SA(1, 0), cA + kstep, voffA); PG8_STAGE(PG8_SB(1, 1), cB + hstep + kstep, voffB);
    PG8_WAIT_V(6); PG8_BAR;
    for (;;) {
        const bool has_next = S.next(ui + 1, nxt);
        const char* nA = has_next ? (const char*)g.A + (size_t)nxt.pm * tstep : cA; const char* nB = has_next ? (const char*)g.Bt + (size_t)nxt.pn * tstep : cB;
        for (int t = 0; t < nt; t += 2) {
            const bool last = (t == nt - 2);
            const char* a1 = cA + (size_t)(t + 1) * kstep;
            const char* a2 = last ? nA : cA + (size_t)(t + 2) * kstep; const char* b2 = last ? nB : cB + (size_t)(t + 2) * kstep;
            const char* a3 = a2 + kstep; const char* b3 = b2 + kstep;
            if constexpr (Epi::HAS_MID) { if (t == nt / 2) E.mid(acc, cur, wr, wc, fr, fq); }
            PG8_LDB(B0, 0, 0); PG8_SCHED; PG8_LDA(At, 0, 0); PG8_STAGE(PG8_SA(1, 1), a1 + hstep, voffA);
            PG8_WAIT_L(8); PG8_BAR; PG8_WAIT_L(0); PG8_MMA(0, 0, At, B0); PG8_BAR; PG8_SCHED;
            PG8_LDB(B1, 0, 1); PG8_STAGE(PG8_SB(0, 0), b2, voffB);
            PG8_BAR; PG8_WAIT_L(0); PG8_MMA(0, 1, At, B1); PG8_BAR;
            PG8_LDA(At, 0, 1); PG8_STAGE(PG8_SA(0, 0), a2, voffA);
            PG8_BAR; PG8_WAIT_L(0); PG8_MMA(1, 0, At, B0); PG8_BAR; PG8_SCHED;
            PG8_STAGE(PG8_SB(0, 1), b2 + hstep, voffB);
            PG8_WAIT_V(6); PG8_BAR; PG8_MMA(1, 1, At, B1); PG8_BAR;
            PG8_LDB(B0, 1, 0); PG8_SCHED; PG8_LDA(At, 1, 0); PG8_STAGE(PG8_SA(0, 1), a2 + hstep, voffA);
            PG8_WAIT_L(8); PG8_BAR; PG8_WAIT_L(0); PG8_MMA(0, 0, At, B0); PG8_BAR; PG8_SCHED;
            PG8_LDB(B1, 1, 1); PG8_STAGE(PG8_SB(1, 0), b3, voffB);
            PG8_BAR; PG8_WAIT_L(0); PG8_MMA(0, 1, At, B1); PG8_BAR;
            PG8_LDA(At, 1, 1); PG8_STAGE(PG8_SA(1, 0), a3, voffA);
            PG8_BAR; PG8_WAIT_L(0); PG8_MMA(1, 0, At, B0); PG8_BAR; PG8_SCHED;
            PG8_STAGE(PG8_SB(1, 1), b3 + hstep, voffB);
            PG8_WAIT_V(6); PG8_BAR; PG8_MMA(1, 1, At, B1); PG8_BAR;
        }
        E(acc, cur, wr, wc, fr, fq);
        if (!has_next) break;
#pragma unroll
        for (int a = 0; a < 2; ++a)
#pragma unroll
            for (int b = 0; b < 2; ++b)
#pragma unroll
                for (int m = 0; m < 4; ++m)
#pragma unroll
                    for (int n = 0; n < 2; ++n) acc[a][b][m][n] = (f32x4){0.f, 0.f, 0.f, 0.f};
        cur = nxt; cA = nA; cB = nB; ++ui;
    }
    PG8_WAIT_V(0);
    if (wr == 0) PG8_BAR;
    PG8_BAR;
#undef PG8_SA
#undef PG8_SB
#undef PG8_STAGE
#undef PG8_LDA
#undef PG8_LDB
#undef PG8_MMA
#undef PG8_WAIT_V
#undef PG8_WAIT_L
#undef PG8_BAR
#undef PG8_SCHED
}
struct LinearOrder {
    int c, G, n;
    __device__ __forceinline__ int unit_id(int i) const { return ((i * 8 + (c & 7)) * (G >> 3)) + (c >> 3); }
};
}

__device__ void convert_tables(const Params& p, LAS char* sm) {
    const int tid = tid_opaque(), lane = tid & 63, wid = tid >> 6;
    unsigned char* ub = p.ws + WS_UB; unsigned char* vb = p.ws + WS_VB;
    float* scu = (float*)(p.ws + WS_SCU); float* scv = (float*)(p.ws + WS_SCV);
    unsigned* ctr = (unsigned*)p.ws + CTR_CONV;
    LAS int* slot = (LAS int*)(sm + LDS_MAIN + 128);
    for (;;) {
        if (threadIdx.x == 0) *slot = (int)atomicAdd(ctr, 1u);
        __syncthreads();
        const int chunk = *slot;
        __syncthreads();
        if (chunk >= 2 * 16384 / 64) break;
        const int r8 = chunk * 8 + wid;
        const int row0 = r8 * 8;
        const bool isv = row0 >= 16384; const int e0 = isv ? row0 - 16384 : row0;
        const float* src = (isv ? p.peer_v : p.peer_u) + (size_t)e0 * D + 16 * lane;
        f32x4 a[8][4];
#pragma unroll
        for (int r = 0; r < 8; ++r)
#pragma unroll
            for (int i = 0; i < 4; ++i) a[r][i] = *(const f32x4*)(src + (size_t)r * D + 4 * i);
        if (!isv) {
#pragma unroll
            for (int i = 0; i < 4; ++i) { const f32x4 gg = *(const f32x4*)(p.norm2_g + 16 * lane + 4 * i);
#pragma unroll
                for (int r = 0; r < 8; ++r) a[r][i] = a[r][i] * gg; }
        }
#pragma unroll
        for (int r = 0; r < 8; ++r) {
            float am = 0.f;
#pragma unroll
            for (int i = 0; i < 4; ++i) am = fmaxf(am, fmaxf(fmaxf(fabsf(a[r][i][0]), fabsf(a[r][i][1])), fmaxf(fabsf(a[r][i][2]), fabsf(a[r][i][3]))));
            am = wave_max(am);
            u32x4 o;
            if (isv) {
                const float sc = am > 0.f ? 448.f / am : 1.f;
#pragma unroll
                for (int i = 0; i < 4; ++i) {
                    int w = 0;
                    w = __builtin_amdgcn_cvt_pk_fp8_f32(a[r][i][0] * sc, a[r][i][1] * sc, w, false);
                    w = __builtin_amdgcn_cvt_pk_fp8_f32(a[r][i][2] * sc, a[r][i][3] * sc, w, true);
                    o[i] = (unsigned)w;
                }
                *(u32x4*)(vb + ((size_t)(lane >> 3) * 16384 + (e0 + r)) * 128 + 16 * (lane & 7)) = o;
                if (lane == 0) scv[e0 + r] = am > 0.f ? am * (1.f / 448.f) : 1.f;
            } else {
                const float sc = am > 0.f ? 127.f / am : 0.f;
#pragma unroll
                for (int i = 0; i < 4; ++i) {
                    const int q0 = __float2int_rn(a[r][i][0] * sc), q1 = __float2int_rn(a[r][i][1] * sc), q2 = __float2int_rn(a[r][i][2] * sc), q3 = __float2int_rn(a[r][i][3] * sc);
                    o[i] = (unsigned)(q0 & 255) | ((unsigned)(q1 & 255) << 8) | ((unsigned)(q2 & 255) << 16) | ((unsigned)q3 << 24);
                }
                *(u32x4*)(ub + ((size_t)(lane >> 3) * 16384 + (e0 + r)) * 128 + 16 * (lane & 7)) = o;
                if (lane == 0) scu[e0 + r] = am * (1.f / 127.f);
            }
        }
    }
}
__device__ void phase_prep(const Params& p, LAS char* sm) {
    const int tid = tid_opaque(), lane = tid & 63, wid = tid >> 6;
    const int G = gridDim.x, b = blockIdx.x;
    const int gwv = b * NWV + wid, nwv = G * NWV;
    bf16_t* hb = (bf16_t*)(p.ws + WS_HB);
    float* rstd1 = (float*)(p.ws + WS_RSTD1);
    constexpr int J0 = 64 * 16, J1 = J0 + 8 * 16, J2 = J1 + 16 * 16, J3 = J2 + 16 * 16, J4 = J3;
    LAS float* T = (LAS float*)(sm + wid * 16640);
    for (int it = gwv; it < J4; it += nwv) {
        const float* src; int N, col, kt, rt, koff = 0; bf16_t* dst; const float* g = nullptr;
        if (it < J0) {
            kt = it >> 6; rt = it & 63; g = p.norm1_g; dst = (bf16_t*)(p.ws + WS_WCAT);
            const int R = rt * 64 + lane, u = R >> 8, t = R & 255;
            if (u < 4) { src = p.w_in; N = INC; col = t < 128 ? (128 * u + t) : (512 + 128 * u + t - 128); }
            else if (u < 8) { src = p.w_in; N = INC; const int head = 4 * ((u - 4) & 1) + ((t >> 5) & 3), d = 32 * (t >> 7) + 16 * ((t >> 4) & 1) + (t & 15); col = (u < 6 ? 1024 : 1536) + 64 * head + d; }
            else { src = p.w_gate; N = 2048; col = t < 128 ? (128 * (u - 8) + t) : (1024 + 128 * (u - 8) + t - 128); }
        } else if (it < J1) { const int q = it - J0; kt = q >> 3; rt = q & 7; g = p.norm1_g; dst = (bf16_t*)(p.ws + WS_WVT); src = p.w_in; N = INC; col = 2048 + rt * 64 + lane; }
        else if (it < J2) {
            const int q = it - J1; kt = q >> 4; rt = q & 15; dst = (bf16_t*)(p.ws + WS_W2); N = 1024; col = rt * 64 + lane;
            if (kt < 8) src = p.w_conv_out; else { src = p.w_sb_out; koff = -512; }
        } else if (it < J3) { const int q = it - J2; kt = q >> 4; rt = q & 15; dst = (bf16_t*)(p.ws + WS_WO); src = p.w_o; N = 1024; col = rt * 64 + lane; }
        else break;
        const int k0 = kt * 64;
        {
            float v[64];
#pragma unroll
            for (int k = 0; k < 64; ++k) v[k] = src[(size_t)(k0 + k + koff) * N + col];
#pragma unroll
            for (int k = 0; k < 64; ++k) T[k * 65 + lane] = v[k];
            __builtin_amdgcn_wave_barrier();
            asm volatile("s_waitcnt lgkmcnt(0)" ::: "memory");
            const int ko = lane & 7, nl = lane >> 3;
            f32x4 g0 = (f32x4){1.f, 1.f, 1.f, 1.f}, g1 = g0;
            if (g) { g0 = *(const f32x4*)(g + k0 + 8 * ko); g1 = *(const f32x4*)(g + k0 + 8 * ko + 4); }
#pragma unroll
            for (int nb = 0; nb < 8; ++nb) {
                const int n = nb * 8 + nl;
                float t[8];
#pragma unroll
                for (int j = 0; j < 8; ++j) t[j] = T[(8 * ko + j) * 65 + n];
                u32x4 o; o[0] = pack2bf(t[0] * g0[0], t[1] * g0[1]); o[1] = pack2bf(t[2] * g0[2], t[3] * g0[3]); o[2] = pack2bf(t[4] * g1[0], t[5] * g1[1]); o[3] = pack2bf(t[6] * g1[2], t[7] * g1[3]);
                *(u32x4*)(dst + (size_t)(rt * 64 + n) * D + k0 + 8 * ko) = o;
            }
            __builtin_amdgcn_wave_barrier();
            asm volatile("s_waitcnt lgkmcnt(0)" ::: "memory");
        }
    }
    {
        bf16_t* wf = (bf16_t*)(p.ws + WS_WQ);
        const int fr = lane & 15, fq = lane >> 4;
        for (int it = gwv; it < 128 * 64; it += nwv) {
            const int nt16 = it >> 6, kt16 = it & 63;
            const int hh = nt16 >> 3, key0 = (nt16 & 7) * 16, k0 = kt16 * 16;
            const float* ka = ((hh & 1) ? p.peer_k2 : p.peer_k1) + ((size_t)(hh >> 1) * 128 + key0 + fr) * 128 + 32 * fq;
            const float* wb = p.peer_wq + (size_t)(k0 + fr) * 2048 + hh * 128 + 32 * fq;
            f32x4 av[8], bv[8];
#pragma unroll
            for (int c = 0; c < 8; ++c) { av[c] = *(const f32x4*)(ka + 4 * c); bv[c] = *(const f32x4*)(wb + 4 * c); }
            f32x4 acc = (f32x4){0.f, 0.f, 0.f, 0.f};
#pragma unroll
            for (int st = 0; st < 32; ++st) acc = __builtin_amdgcn_mfma_f32_16x16x4f32(bv[st >> 2][st & 3], av[st >> 2][st & 3], acc, 0, 0, 0);
            const f32x4 gk = *(const f32x4*)(p.norm2_g + k0 + 4 * fq);
            u32x2 o; o[0] = pack2bf(acc[0] * gk[0], acc[1] * gk[1]); o[1] = pack2bf(acc[2] * gk[2], acc[3] * gk[3]);
            *(u32x2*)(wf + (size_t)(hh * 128 + key0 + fr) * D + k0 + 4 * fq) = o;
        }
    }
    for (int r0 = gwv; r0 < LP2; r0 += 4 * nwv) {
        f32x4 v[4][4];
#pragma unroll
        for (int r = 0; r < 4; ++r) {
            const int row = r0 + r * nwv;
            const float* src = row < NMETA ? p.meta + (size_t)row * D : (row < LTOK ? p.x + (size_t)(row - NMETA) * D : nullptr);
#pragma unroll
            for (int i = 0; i < 4; ++i) { v[r][i] = (f32x4){0.f, 0.f, 0.f, 0.f}; if (src) v[r][i] = *(const f32x4*)(src + lane * 4 + 256 * i); }
        }
#pragma unroll
        for (int r = 0; r < 4; ++r) {
            const int row = r0 + r * nwv;
            if (row < LP2) {
                float ss = 0.f;
#pragma unroll
                for (int i = 0; i < 4; ++i) {
                    ss += v[r][i][0] * v[r][i][0] + v[r][i][1] * v[r][i][1] + v[r][i][2] * v[r][i][2] + v[r][i][3] * v[r][i][3];
                    u32x2 o; o[0] = pack2bf(v[r][i][0], v[r][i][1]); o[1] = pack2bf(v[r][i][2], v[r][i][3]);
                    *(u32x2*)(hb + (size_t)row * D + lane * 4 + 256 * i) = o;
                }
                ss = wave_sum(ss);
                if (lane == 0) rstd1[row] = rsqrtf(ss * (1.f / D) + EPS);
            }
        }
    }
}

struct OrderP1 : pg8::LinearOrder {
    __device__ __forceinline__ bool next(int i, pg8::Unit& u) const {
        const int L = unit_id(i);
        if (L >= 1040 + 130) return false;
        if (L < 1040) { u.pm = TILE_HB + (L >> 4); u.pn = TILE_WCAT + (L & 15); }
        else { const int q = L - 1040; u.pm = TILE_WVT + (q & 1); u.pn = TILE_HB + (q >> 1); }
        return true;
    }
};
struct EpiP1 {
    static constexpr bool HAS_MID = false;
    const float* rstd1; bf16_t* glu; bf16_t* qo; bf16_t* ko; bf16_t* vt; bf16_t* gate; const float* qg; const float* kg; const float* bgate;
    __device__ __forceinline__ void operator()(const f32x4 (&acc)[2][2][4][2], const pg8::Unit& u, int wr, int wc, int fr_, int fq_) const {
        int fr = fr_, fq = fq_; asm volatile("" : "+v"(fr), "+v"(fq));
        if (u.pm >= TILE_WVT && u.pm < TILE_WVT + 2) {
            const int s0 = 256 * (u.pn - TILE_HB);
            f32x4 rs[2][2];
#pragma unroll
            for (int bj = 0; bj < 2; ++bj)
#pragma unroll
                for (int n = 0; n < 2; ++n) rs[bj][n] = *(const f32x4*)(rstd1 + s0 + 128 * bj + 32 * wc + 8 * fq + 4 * n);
            asm volatile("s_waitcnt vmcnt(0)" ::: "memory");
#pragma unroll
            for (int bj = 0; bj < 2; ++bj) {
                const int s = s0 + 128 * bj + 32 * wc + 8 * fq;
#pragma unroll
                for (int ai = 0; ai < 2; ++ai)
#pragma unroll
                    for (int m = 0; m < 4; ++m) {
                        const int rv = 256 * (u.pm - TILE_WVT) + 128 * ai + 64 * wr + 16 * m + fr, head = rv >> 6, d = rv & 63;
                        const f32x4 v0 = acc[ai][bj][m][0] * rs[bj][0], v1 = acc[ai][bj][m][1] * rs[bj][1];
                        u32x4 o; o[0] = pack2h(v0[0], v0[1]); o[1] = pack2h(v0[2], v0[3]); o[2] = pack2h(v1[0], v1[1]); o[3] = pack2h(v1[2], v1[3]);
                        *(u32x4*)(vt + (((size_t)head * (LP2 / 64) + (s >> 6)) * 64 + d) * 64 + (s & 63)) = o;
                    }
            }
            return;
        }
        const int pmr = u.pm - TILE_HB, un = u.pn - TILE_WCAT;
        const int row0 = 256 * pmr + 64 * wr + fr;
        float scv[2][4];
#pragma unroll
        for (int ai = 0; ai < 2; ++ai)
#pragma unroll
            for (int m = 0; m < 4; ++m) scv[ai][m] = rstd1[row0 + 128 * ai + 16 * m];
        f32x4 aux[2][2];
        if (un >= 4) {
            const bool isq = un < 6;
            const float* ap = un < 8 ? (isq ? qg : kg) : (bgate + 128 * (un - 8) + 32 * wc);
#pragma unroll
            for (int bj = 0; bj < 2; ++bj)
#pragma unroll
                for (int n = 0; n < 2; ++n) aux[bj][n] = *(const f32x4*)(ap + (un < 8 ? 32 : 1024) * bj + 8 * fq + 4 * n);
        }
        asm volatile("s_waitcnt vmcnt(0)" ::: "memory");
#pragma unroll
        for (int ai = 0; ai < 2; ++ai)
#pragma unroll
            for (int m = 0; m < 4; ++m) {
                const int row = row0 + 128 * ai + 16 * m;
                const float sc = scv[ai][m];
                if (un < 4) {
                    u32x4 o;
#pragma unroll
                    for (int n = 0; n < 2; ++n) {
                        const f32x4 a = acc[ai][0][m][n] * sc, gt = acc[ai][1][m][n] * sc;
                        o[2 * n] = pack2bf(a[0] * sigmoidf_(gt[0]), a[1] * sigmoidf_(gt[1])); o[2 * n + 1] = pack2bf(a[2] * sigmoidf_(gt[2]), a[3] * sigmoidf_(gt[3]));
                    }
                    *(u32x4*)(glu + (size_t)row * CONVC + 128 * un + 32 * wc + 8 * fq) = o;
                } else if (un < 8) {
                    const bool isq = un < 6;
                    const int head = 4 * ((un - 4) & 1) + wc;
                    float ss = 0.f;
#pragma unroll
                    for (int bj = 0; bj < 2; ++bj)
#pragma unroll
                        for (int n = 0; n < 2; ++n) { const f32x4 v = acc[ai][bj][m][n]; ss += v[0] * v[0] + v[1] * v[1] + v[2] * v[2] + v[3] * v[3]; }
                    ss += __shfl_xor(ss, 16); ss += __shfl_xor(ss, 32);
                    const float r2 = rsqrtf(ss * sc * sc * (1.f / 64.f) + EPS) * (isq ? 0.125f * 1.44269504088896341f : 1.f) * sc;
                    bf16_t* dst = (isq ? qo : ko) + ((size_t)head * LP2 + row) * DH;
#pragma unroll
                    for (int bj = 0; bj < 2; ++bj) {
                        const f32x4 v0 = acc[ai][bj][m][0] * aux[bj][0] * r2, v1 = acc[ai][bj][m][1] * aux[bj][1] * r2;
                        u32x4 o; o[0] = pack2bf(v0[0], v0[1]); o[1] = pack2bf(v0[2], v0[3]); o[2] = pack2bf(v1[0], v1[1]); o[3] = pack2bf(v1[2], v1[3]);
                        *(u32x4*)(dst + 32 * bj + 8 * fq) = o;
                    }
                } else {
                    const int col = 128 * (un - 8) + 32 * wc + 8 * fq;
                    u32x4 orat, ogs;
#pragma unroll
                    for (int n = 0; n < 2; ++n) {
                        const f32x4 vc = acc[ai][0][m][n] * sc + aux[0][n], vs = acc[ai][1][m][n] * sc + aux[1][n];
                        float rt_[4], gs_[4];
#pragma unroll
                        for (int e = 0; e < 4; ++e) { const float ec = __expf(-vc[e]), es = __expf(-vs[e]); gs_[e] = 1.f / (1.f + es); rt_[e] = (1.f + es) / (1.f + ec); }
                        orat[2 * n] = pack2bf(rt_[0], rt_[1]); orat[2 * n + 1] = pack2bf(rt_[2], rt_[3]);
                        ogs[2 * n] = pack2bf(gs_[0], gs_[1]); ogs[2 * n + 1] = pack2bf(gs_[2], gs_[3]);
                    }
                    *(u32x4*)(gate + (size_t)row * 2048 + col) = orat;
                    *(u32x4*)(gate + (size_t)row * 2048 + 1024 + col) = ogs;
                }
            }
    }
};
__device__ void phase_gemm1(const Params& p, LAS char* sm) {
    OrderP1 S; S.c = blockIdx.x; S.G = gridDim.x; S.n = 0;
    EpiP1 E{(const float*)(p.ws + WS_RSTD1), (bf16_t*)(p.ws + WS_GLU), (bf16_t*)(p.ws + WS_Q), (bf16_t*)(p.ws + WS_K), (bf16_t*)(p.ws + WS_VT), (bf16_t*)(p.ws + WS_GATE),
            p.q_norm_g, p.k_norm_g, p.b_gate};
    pg8::Gemm g{(const bf16_t*)p.ws, (const bf16_t*)p.ws, D};
    pg8::gemm_phase((LAS unsigned char*)sm, g, S, E);
    convert_tables(p, sm);
}

__device__ void conv_item(const Params& p, LAS char* sm, int item) {
    const int tid = tid_opaque(), lane = tid & 63, wid = tid >> 6;
    const bf16_t* glu = (const bf16_t*)(p.ws + WS_GLU);
    bf16_t* co = (bf16_t*)(p.ws + WS_CO);
    const int t0 = item * 32;
    {
        u32x4 v[8];
#pragma unroll
        for (int i = 0; i < 8; ++i) {
            const int c = tid + i * NT, row = c >> 6, ch = c & 63, g = t0 - 30 + row;
            v[i] = (u32x4){0u, 0u, 0u, 0u};
            if (c < 62 * 64 && g >= 0) v[i] = *(const u32x4*)(glu + (size_t)g * CONVC + ch * 8);
        }
#pragma unroll
        for (int i = 0; i < 8; ++i) {
            const int c = tid + i * NT, row = c >> 6, ch = c & 63;
            if (c < 62 * 64) *(LAS u32x4*)(sm + row * 1024 + ch * 16) = v[i];
        }
    }
    float wa[CONVW];
#pragma unroll
    for (int j = 0; j < CONVW; ++j) wa[j] = p.conv_w[j * CONVC + tid];
    const float bias = p.conv_b[tid];
    float aa[32];
#pragma unroll
    for (int r = 0; r < 32; ++r) aa[r] = bias;
    __syncthreads();
#pragma unroll
    for (int i = 0; i < 62; ++i) {
        const float xa = __uint_as_float((unsigned)(*(LAS unsigned short*)(sm + i * 1024 + tid * 2)) << 16);
#pragma unroll
        for (int r = 0; r < 32; ++r) {
            const int j = i - r;
            if (j >= 0 && j < CONVW) aa[r] += wa[j] * xa;
        }
    }
    __syncthreads();
#pragma unroll
    for (int r = 0; r < 32; ++r) *(LAS float*)(sm + (r * 516 + tid) * 4) = aa[r];
    __syncthreads();
    const f32x4 g0 = *(const f32x4*)(p.conv_ln_g + lane * 4), g1 = *(const f32x4*)(p.conv_ln_g + 256 + lane * 4);
    const f32x4 b0 = *(const f32x4*)(p.conv_ln_b + lane * 4), b1 = *(const f32x4*)(p.conv_ln_b + 256 + lane * 4);
#pragma unroll 1
    for (int rr = 0; rr < 4; ++rr) {
        const int r = wid * 4 + rr;
        f32x4 v0 = *(LAS f32x4*)(sm + (r * 516 + lane * 4) * 4), v1 = *(LAS f32x4*)(sm + (r * 516 + 256 + lane * 4) * 4);
        float s = v0[0] + v0[1] + v0[2] + v0[3] + v1[0] + v1[1] + v1[2] + v1[3];
        s = wave_sum(s);
        const float mu = s * (1.f / CONVC);
        float q = 0.f;
#pragma unroll
        for (int e = 0; e < 4; ++e) { v0[e] -= mu; v1[e] -= mu; q += v0[e] * v0[e] + v1[e] * v1[e]; }
        q = wave_sum(q);
        const float rstd = rsqrtf(q * (1.f / CONVC) + EPS);
        float y0[4], y1[4];
#pragma unroll
        for (int e = 0; e < 4; ++e) {
            float a = v0[e] * rstd * g0[e] + b0[e]; y0[e] = a * sigmoidf_(a);
            float c = v1[e] * rstd * g1[e] + b1[e]; y1[e] = c * sigmoidf_(c);
        }
        const int t = t0 + r;
        u32x2 o; o[0] = pack2bf(y0[0], y0[1]); o[1] = pack2bf(y0[2], y0[3]);
        *(u32x2*)(co + (size_t)t * D + lane * 4) = o;
        o[0] = pack2bf(y1[0], y1[1]); o[1] = pack2bf(y1[2], y1[3]);
        *(u32x2*)(co + (size_t)t * D + 256 + lane * 4) = o;
    }
    __syncthreads();
}

__device__ void attn_item(const Params& p, LAS char* sm, int head, int qb) {
    const int tid = tid_opaque(), lane = tid & 63, w = __builtin_amdgcn_readfirstlane(tid >> 6), fr = lane & 15, fq = lane >> 4;
    const bf16_t* Qh = (const bf16_t*)(p.ws + WS_Q) + (size_t)head * LP2 * DH;
    const bf16_t* Kh = (const bf16_t*)(p.ws + WS_K) + (size_t)head * LP2 * DH;
    const bf16_t* Vth = (const bf16_t*)(p.ws + WS_VT) + (size_t)head * (LP2 / 64) * 4096;
    bf16_t* og = (bf16_t*)(p.ws + WS_CO) + 512;
    LAS char* Ks = sm;
    LAS char* Vs = sm + 8192;
    LAS char* LK = sm + 16384 + w * 8192;
    LAS char* PS = LK + 4096;
    LAS float* flags = (LAS float*)(sm + LDS_MAIN);
    const int trb0 = qb * 256 + 16 * w, trb1 = trb0 + 128;
    bf16x8 qf[2][2];
#pragma unroll
    for (int nt = 0; nt < 2; ++nt)
#pragma unroll
        for (int kh = 0; kh < 2; ++kh) qf[nt][kh] = *(const bf16x8*)(Qh + (size_t)((nt ? trb1 : trb0) + fr) * DH + 32 * kh + 8 * fq);
    f32x4 oT[4][2];
#pragma unroll
    for (int i = 0; i < 4; ++i) { oT[i][0] = (f32x4){0.f, 0.f, 0.f, 0.f}; oT[i][1] = (f32x4){0.f, 0.f, 0.f, 0.f}; }
    float R[2] = {0.f, 0.f};
    const int swz = fr & 7;
    const int prow = tid >> 3, pc = (tid & 7) ^ (prow & 7);
    int kt = 4 * qb + 3;
    u32x4 kv = *(const u32x4*)(Kh + (size_t)(kt * 64 + prow) * DH + pc * 8);
    u32x4 vv = *(const u32x4*)(Vth + (size_t)kt * 4096 + prow * 64 + pc * 8);
    auto tile = [&](auto MASKED_T, auto A0_T, auto A1_T, int s0) {
        constexpr bool MASKED = decltype(MASKED_T)::value, a0 = decltype(A0_T)::value, a1 = decltype(A1_T)::value;
        f32x4 z[4][2];
#pragma unroll
        for (int i = 0; i < 4; ++i) { z[i][0] = (f32x4){0.f, 0.f, 0.f, 0.f}; z[i][1] = (f32x4){0.f, 0.f, 0.f, 0.f}; }
#pragma unroll
        for (int kh = 0; kh < 2; ++kh)
#pragma unroll
            for (int ms = 0; ms < 4; ++ms) {
                const bf16x8 kf = *(LAS bf16x8*)(Ks + (16 * ms + fr) * 128 + (((4 * kh + fq) ^ swz) << 4));
                if constexpr (a0) z[ms][0] = __builtin_amdgcn_mfma_f32_16x16x32_bf16(kf, qf[0][kh], z[ms][0], 0, 0, 0);
                if constexpr (a1) z[ms][1] = __builtin_amdgcn_mfma_f32_16x16x32_bf16(kf, qf[1][kh], z[ms][1], 0, 0, 0);
            }
        float lsum[2] = {0.f, 0.f};
#pragma unroll
        for (int ms = 0; ms < 4; ++ms)
#pragma unroll
            for (int nt = 0; nt < 2; ++nt) {
                if (!(nt ? a1 : a0)) continue;
                const int t = (nt ? trb1 : trb0) + fr;
                float lk[4];
#pragma unroll
                for (int j = 0; j < 4; ++j) {
                    const float zz = z[ms][nt][j];
                    const float sp = fmaxf(zz, 0.f) + __builtin_amdgcn_logf(1.f + __builtin_amdgcn_exp2f(-fabsf(zz)));
                    float l = -sp;
                    if (MASKED) { const int s = s0 + 16 * ms + 4 * fq + j; l = (s < t) ? l : 0.f; }
                    lk[j] = l; lsum[nt] += l;
                    z[ms][nt][j] = zz - sp;
                }
                u32x2 ph; ph[0] = pack2h(lk[0], lk[1]); ph[1] = pack2h(lk[2], lk[3]);
                *(LAS u32x2*)(LK + (16 * nt + fr) * 128 + ((((2 * ms + (fq >> 1)) ^ swz)) << 4) + (fq & 1) * 8) = ph;
            }
        __builtin_amdgcn_wave_barrier();
        asm volatile("s_waitcnt lgkmcnt(0)" ::: "memory");
        f32x4 st[4][2];
#pragma unroll
        for (int i = 0; i < 4; ++i) { st[i][0] = (f32x4){0.f, 0.f, 0.f, 0.f}; st[i][1] = (f32x4){0.f, 0.f, 0.f, 0.f}; }
#pragma unroll
        for (int kh = 0; kh < 2; ++kh) {
            f16x8 bh[2];
#pragma unroll
            for (int nt = 0; nt < 2; ++nt) if (nt ? a1 : a0) bh[nt] = *(LAS f16x8*)(LK + (16 * nt + fr) * 128 + (((4 * kh + fq) ^ swz) << 4));
#pragma unroll
            for (int ms = 0; ms < 4; ++ms) {
                if (32 * kh + 32 <= 16 * ms + 1) continue;
                f16x8 tm;
#pragma unroll
                for (int e = 0; e < 8; ++e) tm[e] = (32 * kh + 8 * fq + e > 16 * ms + fr) ? (_Float16)1.0f : (_Float16)0.0f;
                if constexpr (a0) st[ms][0] = __builtin_amdgcn_mfma_f32_16x16x32_f16(tm, bh[0], st[ms][0], 0, 0, 0);
                if constexpr (a1) st[ms][1] = __builtin_amdgcn_mfma_f32_16x16x32_f16(tm, bh[1], st[ms][1], 0, 0, 0);
            }
        }
#pragma unroll
        for (int ms = 0; ms < 4; ++ms)
#pragma unroll
            for (int nt = 0; nt < 2; ++nt) {
                if (!(nt ? a1 : a0)) continue;
                const int t = (nt ? trb1 : trb0) + fr;
                float wv[4];
#pragma unroll
                for (int j = 0; j < 4; ++j) {
                    float wj = __builtin_amdgcn_exp2f(z[ms][nt][j] + R[nt] + st[ms][nt][j]);
                    if (MASKED) { const int s = s0 + 16 * ms + 4 * fq + j; wj = (s < t) ? wj : 0.f; }
                    wv[j] = wj;
                }
                u32x2 pw; pw[0] = pack2h(wv[0], wv[1]); pw[1] = pack2h(wv[2], wv[3]);
                *(LAS u32x2*)(PS + (16 * nt + fr) * 128 + ((((2 * ms + (fq >> 1)) ^ swz)) << 4) + (fq & 1) * 8) = pw;
            }
#pragma unroll
        for (int nt = 0; nt < 2; ++nt) {
            if (!(nt ? a1 : a0)) continue;
            float tsum = lsum[nt];
            tsum += __shfl_xor(tsum, 16);
            tsum += __shfl_xor(tsum, 32);
            R[nt] += tsum;
        }
        __builtin_amdgcn_wave_barrier();
        asm volatile("s_waitcnt lgkmcnt(0)" ::: "memory");
#pragma unroll
        for (int kh = 0; kh < 2; ++kh) {
            f16x8 pf[2];
#pragma unroll
            for (int nt = 0; nt < 2; ++nt) if (nt ? a1 : a0) pf[nt] = *(LAS f16x8*)(PS + (16 * nt + fr) * 128 + (((4 * kh + fq) ^ swz) << 4));
#pragma unroll
            for (int md = 0; md < 4; ++md) {
                const f16x8 vf = *(LAS f16x8*)(Vs + (16 * md + fr) * 128 + (((4 * kh + fq) ^ swz) << 4));
                if constexpr (a0) oT[md][0] = __builtin_amdgcn_mfma_f32_16x16x32_f16(vf, pf[0], oT[md][0], 0, 0, 0);
                if constexpr (a1) oT[md][1] = __builtin_amdgcn_mfma_f32_16x16x32_f16(vf, pf[1], oT[md][1], 0, 0, 0);
            }
        }
    };
    bool done0 = false, done1 = false;
    for (; kt >= 0; --kt) {
        *(LAS u32x4*)(Ks + tid * 16) = kv;
        *(LAS u32x4*)(Vs + tid * 16) = vv;
        __syncthreads();
        if (kt > 0) {
            kv = *(const u32x4*)(Kh + (size_t)((kt - 1) * 64 + prow) * DH + pc * 8);
            vv = *(const u32x4*)(Vth + (size_t)(kt - 1) * 4096 + prow * 64 + pc * 8);
        }
        {
            const int s0 = kt * 64;
            const bool a0 = !done0 && s0 <= trb0, a1 = !done1 && s0 <= trb1;
            if (a0 || a1) {
                const bool mk = (a0 && s0 + 63 >= trb0) || (a1 && s0 + 63 >= trb1);
                if (a0 && a1) { if (mk) tile(std::true_type{}, std::true_type{}, std::true_type{}, s0); else tile(std::false_type{}, std::true_type{}, std::true_type{}, s0); }
                else if (a0) { if (mk) tile(std::true_type{}, std::true_type{}, std::false_type{}, s0); else tile(std::false_type{}, std::true_type{}, std::false_type{}, s0); }
                else { if (mk) tile(std::true_type{}, std::false_type{}, std::true_type{}, s0); else tile(std::false_type{}, std::false_type{}, std::true_type{}, s0); }
                if (a0) done0 = __int_as_float(__builtin_amdgcn_readfirstlane(__float_as_int(wave_max(R[0])))) < -127.f;
                if (a1) done1 = __int_as_float(__builtin_amdgcn_readfirstlane(__float_as_int(wave_max(R[1])))) < -127.f;
            }
        }
        const float wm = wave_max(fmaxf(R[0], R[1]));
        if (lane == 0) flags[(kt & 1) * 8 + w] = wm;
        __syncthreads();
        float m8 = flags[(kt & 1) * 8];
#pragma unroll
        for (int i = 1; i < 8; ++i) m8 = fmaxf(m8, flags[(kt & 1) * 8 + i]);
        if (m8 < -127.f) break;
    }
#pragma unroll
    for (int md = 0; md < 4; ++md)
#pragma unroll
        for (int nt = 0; nt < 2; ++nt) {
            const int t = (nt ? trb1 : trb0) + fr;
            u32x2 o; o[0] = pack2bf(oT[md][nt][0], oT[md][nt][1]); o[1] = pack2bf(oT[md][nt][2], oT[md][nt][3]);
            *(u32x2*)(og + (size_t)t * D + head * 64 + 16 * md + 4 * fq) = o;
        }
    __syncthreads();
}

__device__ void phase_mixers(const Params& p, LAS char* sm) {
    constexpr int NQB = LP2 / 256, NATT = NH * NQB, NCONV = (LTOK + 31) / 32;
    unsigned* ctr = (unsigned*)p.ws + CTR_MIX;
    LAS int* slot = (LAS int*)(sm + LDS_MAIN + 128);
    if (threadIdx.x == 0) *slot = (int)atomicAdd(ctr, 1u);
    __syncthreads();
    for (;;) {
        const int it = *slot;
        __syncthreads();
        if (it >= NATT + NCONV) break;
        unsigned nx = 0u;
        if (threadIdx.x == 0) nx = atomicAdd(ctr, 1u);
        if (it < NATT) { const int qb = NQB - 1 - it / NH, head = it % NH; attn_item(p, sm, head, qb); }
        else conv_item(p, sm, it - NATT);
        if (threadIdx.x == 0) *slot = (int)nx;
        __syncthreads();
    }
}

struct OrderMN : pg8::LinearOrder {
    __device__ __forceinline__ bool next(int i, pg8::Unit& u) const {
        const int L = unit_id(i);
        if (L >= 64 * n) return false;
        u.pm = L / n; u.pn = L % n; return true;
    }
};
struct EpiP3 {
    static constexpr bool HAS_MID = true;
    const bf16_t* gate; bf16_t* mixed;
    __device__ __forceinline__ void scale(f32x4 (&acc)[2][2][4][2], const pg8::Unit& u, int wr, int wc, int fr_, int fq_, int goff, bool store) const {
        int fr = fr_, fq = fq_; asm volatile("" : "+v"(fr), "+v"(fq));
        const int row0 = NMETA + 256 * u.pm + 64 * wr + fr, col0 = 256 * u.pn + 32 * wc + 8 * fq;
        u32x4 gv[2][4][2];
#pragma unroll
        for (int ai = 0; ai < 2; ++ai)
#pragma unroll
            for (int m = 0; m < 4; ++m)
#pragma unroll
                for (int bj = 0; bj < 2; ++bj) gv[ai][m][bj] = *(const u32x4*)(gate + (size_t)(row0 + 128 * ai + 16 * m) * 2048 + goff + col0 + 128 * bj);
        asm volatile("s_waitcnt vmcnt(0)" ::: "memory");
#pragma unroll
        for (int ai = 0; ai < 2; ++ai)
#pragma unroll
            for (int m = 0; m < 4; ++m)
#pragma unroll
                for (int bj = 0; bj < 2; ++bj) {
                    const u32x4 g = gv[ai][m][bj];
                    u32x4 o;
#pragma unroll
                    for (int n = 0; n < 2; ++n) {
                        f32x4 y = acc[ai][bj][m][n];
                        y[0] *= bflo(g[2 * n]); y[1] *= bfhi(g[2 * n]); y[2] *= bflo(g[2 * n + 1]); y[3] *= bfhi(g[2 * n + 1]);
                        if (store) { o[2 * n] = pack2bf(y[0], y[1]); o[2 * n + 1] = pack2bf(y[2], y[3]); }
                        else acc[ai][bj][m][n] = y;
                    }
                    if (store) *(u32x4*)(mixed + (size_t)(row0 + 128 * ai + 16 * m) * D + col0 + 128 * bj) = o;
                }
    }
    __device__ __forceinline__ void mid(f32x4 (&acc)[2][2][4][2], const pg8::Unit& u, int wr, int wc, int fr, int fq) const { scale(acc, u, wr, wc, fr, fq, 0, false); }
    __device__ __forceinline__ void operator()(const f32x4 (&acc)[2][2][4][2], const pg8::Unit& u, int wr, int wc, int fr, int fq) const {
        scale(const_cast<f32x4 (&)[2][2][4][2]>(acc), u, wr, wc, fr, fq, 1024, true);
    }
};
__device__ void phase_gemm2(const Params& p, LAS char* sm) {
    OrderMN S; S.c = blockIdx.x; S.G = gridDim.x; S.n = 4;
    EpiP3 E{(const bf16_t*)(p.ws + WS_GATE), (bf16_t*)(p.ws + WS_MIXED)};
    pg8::Gemm g{(const bf16_t*)(p.ws + WS_CO) + (size_t)NMETA * D, (const bf16_t*)(p.ws + WS_W2), D};
    pg8::gemm_phase((LAS unsigned char*)sm, g, S, E);
}

struct EpiP4 {
    static constexpr bool HAS_MID = false;
    const bf16_t* hb; bf16_t* h2b; float* ssp;
    __device__ __forceinline__ void operator()(const f32x4 (&acc)[2][2][4][2], const pg8::Unit& u, int wr, int wc, int fr_, int fq_) const {
        int fr = fr_, fq = fq_; asm volatile("" : "+v"(fr), "+v"(fq));
        const int col0 = 256 * u.pn + 32 * wc + 8 * fq;
        const int tok0 = 256 * u.pm + 64 * wr + fr;
#pragma unroll
        for (int ai = 0; ai < 2; ++ai) {
            u32x4 hv[4][2];
#pragma unroll
            for (int m = 0; m < 4; ++m)
#pragma unroll
                for (int bj = 0; bj < 2; ++bj) hv[m][bj] = *(const u32x4*)(hb + (size_t)(NMETA + tok0 + 128 * ai + 16 * m) * D + col0 + 128 * bj);
            asm volatile("s_waitcnt vmcnt(0)" ::: "memory");
#pragma unroll
            for (int m = 0; m < 4; ++m) {
                const int tok = tok0 + 128 * ai + 16 * m;
                float ssq = 0.f;
#pragma unroll
                for (int bj = 0; bj < 2; ++bj) {
                    const u32x4 h = hv[m][bj];
                    u32x4 o;
#pragma unroll
                    for (int n = 0; n < 2; ++n) {
                        const f32x4 a = acc[ai][bj][m][n];
                        o[2 * n] = pack2bf(bflo(h[2 * n]) + a[0], bfhi(h[2 * n]) + a[1]); o[2 * n + 1] = pack2bf(bflo(h[2 * n + 1]) + a[2], bfhi(h[2 * n + 1]) + a[3]);
                    }
                    *(u32x4*)(h2b + (size_t)tok * D + col0 + 128 * bj) = o;
#pragma unroll
                    for (int e = 0; e < 4; ++e) { const float r0 = bflo(o[e]), r1 = bfhi(o[e]); ssq += r0 * r0 + r1 * r1; }
                }
                ssq += __shfl_xor(ssq, 16); ssq += __shfl_xor(ssq, 32);
                if (fq == 0) ssp[(size_t)tok * 16 + u.pn * 4 + wc] = ssq;
            }
        }
    }
};
__device__ void phase_gemm3(const Params& p, LAS char* sm) {
    OrderMN S; S.c = blockIdx.x; S.G = gridDim.x; S.n = 4;
    EpiP4 E{(const bf16_t*)(p.ws + WS_HB), (bf16_t*)(p.ws + WS_H2B), (float*)(p.ws + WS_SSP)};
    pg8::Gemm g{(const bf16_t*)(p.ws + WS_MIXED) + (size_t)NMETA * D, (const bf16_t*)(p.ws + WS_WO), D};
    pg8::gemm_phase((LAS unsigned char*)sm, g, S, E);
}

__device__ __forceinline__ float vmaxf(float a, float b) { float r; asm("v_max_f32 %0, %1, %2" : "=v"(r) : "v"(a), "v"(b)); return r; }
__device__ __forceinline__ float vminf(float a, float b) { float r; asm("v_min_f32 %0, %1, %2" : "=v"(r) : "v"(a), "v"(b)); return r; }
__device__ __forceinline__ void bitonic_sort16_desc(float (&a)[16]) {
#pragma unroll
    for (int k = 2; k <= 16; k <<= 1)
#pragma unroll
        for (int j = k >> 1; j > 0; j >>= 1)
#pragma unroll
            for (int i = 0; i < 16; ++i) {
                const int l = i ^ j;
                if (l > i) {
                    const bool desc = ((i & k) == 0);
                    const float x = vmaxf(a[i], a[l]), y = vminf(a[i], a[l]);
                    a[i] = desc ? x : y; a[l] = desc ? y : x;
                }
            }
}
__device__ __forceinline__ void merge_top16_desc(float (&r)[16], const float (&g)[16]) {
#pragma unroll
    for (int i = 0; i < 16; ++i) r[i] = vmaxf(r[i], g[15 - i]);
#pragma unroll
    for (int j = 8; j > 0; j >>= 1)
#pragma unroll
        for (int i = 0; i < 16; ++i) {
            const int l = i ^ j;
            if (l > i) { const float x = vmaxf(r[i], r[l]), y = vminf(r[i], r[l]); r[i] = x; r[l] = y; }
        }
}
__device__ __forceinline__ float mkkey(float f, int low, int mask) { return __int_as_float((__float_as_int(f) & ~mask) | low); }
__device__ __forceinline__ int keylow(float k, int mask) { return __float_as_int(k) & mask; }
__device__ __forceinline__ float keyval(float k, int mask) { return __int_as_float(__float_as_int(k) & ~mask); }

struct EpiP5 {
    static constexpr bool HAS_MID = false;
    bf16_t* qp;
    __device__ __forceinline__ void operator()(const f32x4 (&acc)[2][2][4][2], const pg8::Unit& u, int wr, int wc, int fr_, int fq_) const {
        int fr = fr_, fq = fq_; asm volatile("" : "+v"(fr), "+v"(fq));
#pragma unroll
        for (int ai = 0; ai < 2; ++ai)
#pragma unroll
            for (int m = 0; m < 4; ++m) {
                const int tok = 256 * u.pm + 128 * ai + 64 * wr + 16 * m + fr;
#pragma unroll
                for (int bj = 0; bj < 2; ++bj) {
                    const f32x4 v0 = acc[ai][bj][m][0], v1 = acc[ai][bj][m][1];
                    u32x4 o; o[0] = pack2h(v0[0], v0[1]); o[1] = pack2h(v0[2], v0[3]); o[2] = pack2h(v1[0], v1[1]); o[3] = pack2h(v1[2], v1[3]);
                    *(u32x4*)(qp + (size_t)tok * 2048 + 256 * u.pn + 128 * bj + 32 * wc + 8 * fq) = o;
                }
            }
    }
};

__device__ void route_unit(const Params& p, LAS char* sm, int pm, int head) {
    const int tid = tid_opaque();
    const bf16_t* sc = (const bf16_t*)(p.ws + WS_QP);
    int* pidx = (int*)(p.ws + WS_PIDX);
    float* pgate = (float*)(p.ws + WS_PGATE);
    const int row = tid & 255, part = tid >> 8;
    u32x4 sv[2][8];
#pragma unroll
    for (int half = 0; half < 2; ++half)
#pragma unroll
        for (int q = 0; q < 8; ++q) sv[half][q] = *(const u32x4*)(sc + (size_t)(256 * pm + row) * 2048 + head * 256 + half * 128 + part * 64 + 8 * q);
    f32x4 ssv[4];
    { const float* sp = (const float*)(p.ws + WS_SSP) + (size_t)(256 * pm + row) * 16;
#pragma unroll
      for (int q = 0; q < 4; ++q) ssv[q] = *(const f32x4*)(sp + 4 * q); }
    float keep0[16];
#pragma unroll
    for (int half = 0; half < 2; ++half) {
        float run[16];
#pragma unroll
        for (int g = 0; g < 4; ++g) {
            float grp[16];
#pragma unroll
            for (int q = 0; q < 2; ++q)
#pragma unroll
                for (int e = 0; e < 4; ++e) {
                    const unsigned w = sv[half][2 * g + q][e];
                    const int c0 = part * 64 + 16 * g + 8 * q + 2 * e;
                    grp[8 * q + 2 * e] = mkkey((float)__builtin_bit_cast(_Float16, (unsigned short)(w & 0xFFFFu)), c0, 127);
                    grp[8 * q + 2 * e + 1] = mkkey((float)__builtin_bit_cast(_Float16, (unsigned short)(w >> 16)), c0 + 1, 127);
                }
            bitonic_sort16_desc(grp);
            if (g == 0) {
#pragma unroll
                for (int i = 0; i < 16; ++i) run[i] = grp[i];
            } else merge_top16_desc(run, grp);
        }
        LAS float* myrow = (LAS float*)(sm + row * 512);
        if (part == 1) {
#pragma unroll
            for (int i = 0; i < 16; ++i) myrow[i] = run[i];
        }
        __syncthreads();
        if (part == 0) {
            float oth[16];
#pragma unroll
            for (int i = 0; i < 16; ++i) oth[i] = myrow[i];
            merge_top16_desc(run, oth);
            if (half == 0) {
#pragma unroll
                for (int i = 0; i < 16; ++i) keep0[i] = run[i];
            } else {
#pragma unroll
                for (int i = 0; i < 16; ++i) { myrow[32 + i] = keep0[i]; myrow[48 + i] = run[i]; }
            }
        }
        if (half == 1) {
            __syncthreads();
            float v1[16], v2[16];
#pragma unroll
            for (int i = 0; i < 16; ++i) { v1[i] = keyval(myrow[32 + i], 127); v2[i] = keyval(myrow[48 + i], 127); }
#define CKEY(I, J) mkkey(v1[I] + v2[J], 16 * (I) + (J), 255)
            float res[16];
            if (part == 0) {
#pragma unroll
                for (int j = 0; j < 16; ++j) res[j] = CKEY(0, j);
                float g1[16];
#pragma unroll
                for (int j = 0; j < 8; ++j) g1[j] = CKEY(1, j);
#pragma unroll
                for (int j = 0; j < 5; ++j) g1[8 + j] = CKEY(2, j);
#pragma unroll
                for (int j = 0; j < 3; ++j) g1[13 + j] = CKEY(3, j);
                bitonic_sort16_desc(g1);
                merge_top16_desc(res, g1);
            } else {
                res[0] = CKEY(3, 3);
#pragma unroll
                for (int j = 0; j < 3; ++j) res[1 + j] = CKEY(4, j);
#pragma unroll
                for (int i = 5; i < 8; ++i) { res[4 + 2 * (i - 5)] = CKEY(i, 0); res[5 + 2 * (i - 5)] = CKEY(i, 1); }
#pragma unroll
                for (int i = 8; i < 14; ++i) res[10 + (i - 8)] = CKEY(i, 0);
                bitonic_sort16_desc(res);
                float g2[16];
                const float c14 = CKEY(14, 0), c15 = CKEY(15, 0);
                g2[0] = vmaxf(c14, c15); g2[1] = vminf(c14, c15);
#pragma unroll
                for (int i = 2; i < 16; ++i) g2[i] = -3.0e38f;
                merge_top16_desc(res, g2);
#pragma unroll
                for (int i = 0; i < 16; ++i) myrow[16 + i] = res[i];
            }
#undef CKEY
            __syncthreads();
            if (part == 0) {
                float oth2[16];
#pragma unroll
                for (int i = 0; i < 16; ++i) oth2[i] = myrow[16 + i];
                merge_top16_desc(res, oth2);
                float sc2;
                {
                    const f32x4 st = (ssv[0] + ssv[1]) + (ssv[2] + ssv[3]);
                    sc2 = rsqrtf((st[0] + st[1] + st[2] + st[3]) * (1.f / D) + EPS);
                    if (head == 0) ((float*)(p.ws + WS_RSTD2))[256 * pm + row] = sc2;
                }
                float bv[16]; float mx = -3.0e38f;
#pragma unroll
                for (int k = 0; k < 16; ++k) { bv[k] = keyval(res[k], 255) * sc2; mx = fmaxf(mx, bv[k]); }
                float se = 0.f;
#pragma unroll
                for (int k = 0; k < 16; ++k) { bv[k] = __expf(bv[k] - mx); se += bv[k]; }
                const float inv = 1.f / se;
                const size_t ob = ((size_t)(256 * pm + row)) * 128 + head * 16;
#pragma unroll
                for (int k4 = 0; k4 < 4; ++k4) {
                    i32x4 id; f32x4 gv;
#pragma unroll
                    for (int e = 0; e < 4; ++e) {
                        const int code = keylow(res[k4 * 4 + e], 255);
                        id[e] = keylow(myrow[32 + (code >> 4)], 127) * NKEYS + keylow(myrow[48 + (code & 15)], 127);
                        gv[e] = bv[k4 * 4 + e] * inv;
                    }
                    *(i32x4*)(pidx + ob + k4 * 4) = id;
                    *(f32x4*)(pgate + ob + k4 * 4) = gv;
                }
            }
        }
        __syncthreads();
    }
}
__device__ void phase_route(const Params& p, LAS char* sm) {
    OrderMN S; S.c = blockIdx.x; S.G = gridDim.x; S.n = 8;
    EpiP5 E{(bf16_t*)(p.ws + WS_QP)};
    pg8::Gemm g{(const bf16_t*)(p.ws + WS_H2B), (const bf16_t*)(p.ws + WS_WQ), D};
    pg8::gemm_phase((LAS unsigned char*)sm, g, S, E);
    asm volatile("s_waitcnt vmcnt(0)" ::: "memory");
    __syncthreads();
    pg8::Unit u;
    for (int i = 0; S.next(i, u); ++i) route_unit(p, sm, u.pm, u.pn);
}

__device__ __forceinline__ float gelu_exact(float x) { return 0.5f * x * (1.f + erff(x * 0.70710678118654752f)); }

__device__ void phase_peer_u(const Params& p, LAS char* sm) {
    const int tid = tid_opaque(), lane = tid & 63, wid = tid >> 6, g = lane >> 3, l7 = lane & 7;
    const int sl = blockIdx.x & 7, gw = (blockIdx.x >> 3) * NWV + wid, nw = (gridDim.x >> 3) * NWV;
    const int* pidx = (const int*)(p.ws + WS_PIDX);
    const unsigned char* ub = p.ws + WS_UB;
    const bf16_t* h2b = (const bf16_t*)(p.ws + WS_H2B);
    float* part = (float*)(p.ws + WS_PART);
    const int colbase = 128 * sl + 16 * l7;
    const unsigned char* ubs = ub + (size_t)sl * 16384 * 128 + 16 * l7;
    const bool b4 = l7 & 4, b2 = l7 & 2, b1 = l7 & 1;
    const int K = SEQ / nw;
#define PU_LOAD_IDS(T) { idsN2 = *(const i32x2*)(pidx + (size_t)(T) * 128 + 2 * lane); xN = *(const unsigned*)(h2b + (size_t)(T) * D + 128 * sl + 2 * lane); }
#define PU_GATHER(UR, XH, XH2, T) { i32x4 idsN[4]; *(LAS i32x2*)(wslot + 8 * lane) = idsN2; *(LAS unsigned*)(wslot + 512 + 4 * lane) = xN; __builtin_amdgcn_wave_barrier(); asm volatile("s_waitcnt lgkmcnt(0)" ::: "memory"); \
        _Pragma("unroll") for (int q = 0; q < 4; ++q) idsN[q] = *(LAS i32x4*)(wslot + 64 * g + 16 * q); \
        XH = *(LAS u32x4*)(wslot + 512 + 32 * l7); XH2 = *(LAS u32x4*)(wslot + 512 + 32 * l7 + 16); \
        asm volatile("s_waitcnt lgkmcnt(0)" ::: "memory"); __builtin_amdgcn_wave_barrier(); \
        _Pragma("unroll") for (int i = 0; i < 16; ++i) UR[i] = *(const u32x4*)(ubs + (size_t)idsN[i >> 2][i & 3] * 128); \
        }
#define PU_COMPUTE(UR, XH, XH2, T) { \
        float xf[16]; \
        _Pragma("unroll") for (int c = 0; c < 4; ++c) { xf[2 * c] = bflo(XH[c]); xf[2 * c + 1] = bfhi(XH[c]); xf[8 + 2 * c] = bflo(XH2[c]); xf[8 + 2 * c + 1] = bfhi(XH2[c]); } \
        float am = 0.f; \
        _Pragma("unroll") for (int c = 0; c < 16; ++c) am = fmaxf(am, fabsf(xf[c])); \
        am = fmaxf(am, __shfl_xor(am, 1)); am = fmaxf(am, __shfl_xor(am, 2)); am = fmaxf(am, __shfl_xor(am, 4)); \
        const float sx = am > 0.f ? 127.f / am : 0.f, isx = am * (1.f / 127.f); \
        int xq[4]; \
        _Pragma("unroll") for (int c = 0; c < 4; ++c) { \
            const int q0 = __float2int_rn(xf[4 * c] * sx), q1 = __float2int_rn(xf[4 * c + 1] * sx), q2 = __float2int_rn(xf[4 * c + 2] * sx), q3 = __float2int_rn(xf[4 * c + 3] * sx); \
            xq[c] = (int)((unsigned)(q0 & 255) | ((unsigned)(q1 & 255) << 8) | ((unsigned)(q2 & 255) << 16) | ((unsigned)q3 << 24)); } \
        int a[16]; \
        _Pragma("unroll") for (int i = 0; i < 16; ++i) { int s4 = 0; \
            _Pragma("unroll") for (int c = 0; c < 4; ++c) s4 = __builtin_amdgcn_sdot4((int)UR[i][c], xq[c], s4, false); \
            a[i] = s4; } \
        int r8[8], r4[4], r2[2]; \
        _Pragma("unroll") for (int q = 0; q < 8; ++q) { const int keep = b4 ? a[q + 8] : a[q], send = b4 ? a[q] : a[q + 8]; r8[q] = keep + __shfl_xor(send, 4); } \
        _Pragma("unroll") for (int q = 0; q < 4; ++q) { const int keep = b2 ? r8[q + 4] : r8[q], send = b2 ? r8[q] : r8[q + 4]; r4[q] = keep + __shfl_xor(send, 2); } \
        _Pragma("unroll") for (int q = 0; q < 2; ++q) { const int keep = b1 ? r4[q + 2] : r4[q], send = b1 ? r4[q] : r4[q + 2]; r2[q] = keep + __shfl_xor(send, 1); } \
        f32x2 o; o[0] = (float)r2[0] * isx; o[1] = (float)r2[1] * isx; \
        *(f32x2*)(part + ((size_t)sl * SEQ + (T)) * 128 + 2 * lane) = o; }
    i32x2 idsN2; unsigned xN; u32x4 urA[16], urB[16]; u32x4 xA, xA2, xB, xB2;
    LAS char* wslot = sm + wid * 1024;
    PU_LOAD_IDS(gw);
    PU_GATHER(urA, xA, xA2, gw);
    PU_LOAD_IDS(gw + nw);
#pragma unroll 1
    for (int k = 0; k < K; k += 2) {
        const int t0 = gw + k * nw, t1 = t0 + nw, t2 = t1 + nw, t3 = t2 + nw;
        PU_GATHER(urB, xB, xB2, t1);
        if (k + 2 < K) PU_LOAD_IDS(t2);
        PU_COMPUTE(urA, xA, xA2, t0);
        if (k + 2 < K) { PU_GATHER(urA, xA, xA2, t2); PU_LOAD_IDS(t3); }
        PU_COMPUTE(urB, xB, xB2, t1);
    }
#undef PU_LOAD_IDS
#undef PU_GATHER
#undef PU_COMPUTE
}

__device__ void phase_peer_coef(const Params& p) {
    const int tid = tid_opaque();
    const int* pidx = (const int*)(p.ws + WS_PIDX);
    const float* pgate = (const float*)(p.ws + WS_PGATE);
    const float* scu = (const float*)(p.ws + WS_SCU);
    const float* scv = (const float*)(p.ws + WS_SCV);
    const float* part = (const float*)(p.ws + WS_PART);
    const float* rstd2 = (const float*)(p.ws + WS_RSTD2);
    float* coef = (float*)(p.ws + WS_COEF);
    const size_t stride = (size_t)gridDim.x * NT, total = (size_t)SEQ * 64;
    for (size_t i0 = (size_t)blockIdx.x * NT + tid; i0 < total; i0 += 4 * stride) {
        i32x2 id2[4]; f32x2 gt[4], s[4]; float rs[4], su[4][2], sv[4][2];
#pragma unroll
        for (int j = 0; j < 4; ++j) {
            const size_t i = i0 + j * stride;
            if (i < total) {
                id2[j] = *(const i32x2*)(pidx + i * 2); gt[j] = *(const f32x2*)(pgate + i * 2); rs[j] = rstd2[i >> 6];
                f32x2 acc = (f32x2){0.f, 0.f};
#pragma unroll
                for (int q = 0; q < 8; ++q) acc += *(const f32x2*)(part + (size_t)q * SEQ * 128 + i * 2);
                s[j] = acc;
            } else { id2[j] = (i32x2){0, 0}; gt[j] = (f32x2){0.f, 0.f}; s[j] = (f32x2){0.f, 0.f}; rs[j] = 0.f; }
        }
#pragma unroll
        for (int j = 0; j < 4; ++j) { su[j][0] = scu[id2[j][0]]; su[j][1] = scu[id2[j][1]]; sv[j][0] = scv[id2[j][0]]; sv[j][1] = scv[id2[j][1]]; }
#pragma unroll
        for (int j = 0; j < 4; ++j) {
            const size_t i = i0 + j * stride;
            if (i < total) {
                f32x2 c2; c2[0] = gt[j][0] * sv[j][0] * gelu_exact(s[j][0] * su[j][0] * rs[j]); c2[1] = gt[j][1] * sv[j][1] * gelu_exact(s[j][1] * su[j][1] * rs[j]);
                *(f32x2*)(coef + i * 2) = c2;
            }
        }
    }
}

__device__ void phase_peer_v(const Params& p, LAS char* sm) {
    const int tid = tid_opaque(), lane = tid & 63, wid = tid >> 6, g = lane >> 3, l7 = lane & 7;
    const int sl = blockIdx.x & 7, gw = (blockIdx.x >> 3) * NWV + wid, nw = (gridDim.x >> 3) * NWV;
    const int* pidx = (const int*)(p.ws + WS_PIDX);
    const float* coef = (const float*)(p.ws + WS_COEF);
    const unsigned char* vb = p.ws + WS_VB;
    const bf16_t* h2b = (const bf16_t*)(p.ws + WS_H2B);
    const int colbase = 128 * sl + 16 * l7;
    const unsigned char* vbs = vb + (size_t)sl * 16384 * 128 + 16 * l7;
    const bool h32 = lane & 32, h16 = lane & 16, h8 = lane & 8;
    const int K = SEQ / nw;
#define PV_LOAD_IDS(T) { idsN2 = *(const i32x2*)(pidx + (size_t)(T) * 128 + 2 * lane); cfN2 = *(const f32x2*)(coef + (size_t)(T) * 128 + 2 * lane); }
#define PV_GATHER(VR, HV, CF, IS, T) { i32x4 idsN[4]; \
        const float amx = wave_max(fmaxf(fabsf(cfN2[0]), fabsf(cfN2[1]))); const int eb = (__float_as_int(amx) >> 23) & 255; \
        const float S = __int_as_float((254 - eb) << 23); IS = __int_as_float(eb << 23); \
        u32x2 cd; cd[0] = pack2h(cfN2[0] * S, cfN2[0] * S); cd[1] = pack2h(cfN2[1] * S, cfN2[1] * S); \
        *(LAS i32x2*)(wslot + 8 * lane) = idsN2; *(LAS u32x2*)(wslot + 512 + 8 * lane) = cd; __builtin_amdgcn_wave_barrier(); asm volatile("s_waitcnt lgkmcnt(0)" ::: "memory"); \
        _Pragma("unroll") for (int q = 0; q < 4; ++q) { idsN[q] = *(LAS i32x4*)(wslot + 64 * g + 16 * q); CF[q] = *(LAS u32x4*)(wslot + 512 + 64 * g + 16 * q); } \
        asm volatile("s_waitcnt lgkmcnt(0)" ::: "memory"); __builtin_amdgcn_wave_barrier(); \
        _Pragma("unroll") for (int i = 0; i < 16; ++i) VR[i] = *(const u32x4*)(vbs + (size_t)idsN[i >> 2][i & 3] * 128); \
        HV = *(const unsigned*)(h2b + (size_t)(T) * D + colbase + 2 * g); }
#define PV_COMPUTE(VR, HV, CF, IS, T) { \
        pk_f16x2 o2[8]; _Pragma("unroll") for (int c = 0; c < 8; ++c) o2[c] = (pk_f16x2){(_Float16)0.f, (_Float16)0.f}; \
        _Pragma("unroll") for (int i = 0; i < 16; ++i) { const unsigned cw = CF[i >> 2][i & 3]; const pk_f16x2 cv = __builtin_bit_cast(pk_f16x2, cw);     \
            _Pragma("unroll") for (int c = 0; c < 4; ++c) { \
                const unsigned vw = VR[i][c]; const pk_f16x2 lo = __builtin_amdgcn_cvt_scalef32_pk_f16_fp8(vw, 1.0f, false), hi = __builtin_amdgcn_cvt_scalef32_pk_f16_fp8(vw, 1.0f, true); \
                o2[2 * c] = __builtin_elementwise_fma(lo, cv, o2[2 * c]); o2[2 * c + 1] = __builtin_elementwise_fma(hi, cv, o2[2 * c + 1]); } } \
        float a[16]; _Pragma("unroll") for (int c = 0; c < 8; ++c) { a[2 * c] = (float)o2[c][0]; a[2 * c + 1] = (float)o2[c][1]; } \
        float r8[8], r4[4], r2[2]; \
        _Pragma("unroll") for (int q = 0; q < 8; ++q) { const float keep = h32 ? a[q + 8] : a[q], send = h32 ? a[q] : a[q + 8]; r8[q] = keep + __shfl_xor(send, 32); } \
        _Pragma("unroll") for (int q = 0; q < 4; ++q) { const float keep = h16 ? r8[q + 4] : r8[q], send = h16 ? r8[q] : r8[q + 4]; r4[q] = keep + __shfl_xor(send, 16); } \
        _Pragma("unroll") for (int q = 0; q < 2; ++q) { const float keep = h8 ? r4[q + 2] : r4[q], send = h8 ? r4[q] : r4[q + 2]; r2[q] = keep + __shfl_xor(send, 8); } \
        f32x2 hv; hv[0] = bflo(HV) + r2[0] * IS; hv[1] = bfhi(HV) + r2[1] * IS; \
        *(f32x2*)(p.out + (size_t)(T) * D + colbase + 2 * g) = hv; }
    i32x2 idsN2; f32x2 cfN2; u32x4 cfA[4], cfB[4]; u32x4 vrA[16], vrB[16]; unsigned hA, hB; float isA, isB;
    LAS char* wslot = sm + wid * 1024;
    PV_LOAD_IDS(gw);
    PV_GATHER(vrA, hA, cfA, isA, gw);
    PV_LOAD_IDS(gw + nw);
#pragma unroll 1
    for (int k = 0; k < K; k += 2) {
        const int t0 = gw + k * nw, t1 = t0 + nw, t2 = t1 + nw, t3 = t2 + nw;
        PV_GATHER(vrB, hB, cfB, isB, t1);
        if (k + 2 < K) PV_LOAD_IDS(t2);
        PV_COMPUTE(vrA, hA, cfA, isA, t0);
        if (k + 2 < K) { PV_GATHER(vrA, hA, cfA, isA, t2); PV_LOAD_IDS(t3); }
        PV_COMPUTE(vrB, hB, cfB, isB, t1);
    }
#undef PV_LOAD_IDS
#undef PV_GATHER
#undef PV_COMPUTE
}

__global__ void __launch_bounds__(NT, 2) fwd_kernel(Params p) {
    __shared__ __attribute__((aligned(16))) char smem[LDS_BYTES + 16];
    LAS char* sm = (LAS char*)smem;
    volatile LAS unsigned* st = (volatile LAS unsigned*)(sm + LDS_BYTES);
    if (threadIdx.x == 0) { st[0] = 0u; st[1] = 0u; st[2] = 0u; st[3] = 0u; }
    __syncthreads();
    const XcdBarrier xb = xcd_barrier_post((unsigned*)p.ws, st);
#ifndef PROBE_DOUBLE
#define PROBE_DOUBLE 0
#endif
#define RUN_PHASE(K, CALL) \
    if (p.ph_lo <= (K) && (K) < p.ph_hi) { \
        const int nrep = 1 + ((PROBE_DOUBLE >> (K)) & 1); \
        _Pragma("unroll 1") for (int rep = 0; rep < nrep; ++rep) { \
            if (rep > 0) { xcd_barrier(xb); if (blockIdx.x == 0 && threadIdx.x == 0) __hip_atomic_store((unsigned*)p.ws + CTR_MIX, 0u, __ATOMIC_RELAXED, __HIP_MEMORY_SCOPE_AGENT); xcd_barrier(xb); } \
            CALL; \
        } \
        if ((K) + 1 < p.ph_hi) { xcd_barrier(xb); } \
    }
    RUN_PHASE(0, phase_prep(p, sm))
    RUN_PHASE(1, phase_gemm1(p, sm))
    RUN_PHASE(2, phase_mixers(p, sm))
    RUN_PHASE(3, phase_gemm2(p, sm))
    RUN_PHASE(4, phase_gemm3(p, sm))
    RUN_PHASE(5, phase_route(p, sm))
    RUN_PHASE(6, phase_peer_u(p, sm))
    RUN_PHASE(7, phase_peer_coef(p))
    RUN_PHASE(8, phase_peer_v(p, sm))
#undef RUN_PHASE
}

extern "C" void kernel_launch(void* const* d_in, const int* in_sizes, int n_in, void* d_out, int out_size, void* d_ws, size_t ws_size, hipStream_t stream) {
    static int grid = 0;
    if (grid == 0) {
        int dev = 0, cus = 0, per_cu = 0;
        (void)hipGetDevice(&dev);
        (void)hipDeviceGetAttribute(&cus, hipDeviceAttributeMultiprocessorCount, dev);
        (void)hipOccupancyMaxActiveBlocksPerMultiprocessor(&per_cu, (const void*)fwd_kernel, NT, 0);
        grid = (per_cu >= 1) ? (cus / 8) * 8 : -1;
        if (grid <= 0) fprintf(stderr, "kernel_launch: occupancy query says the kernel does not fit (%d)\n", per_cu);
        if (ws_size < WS_END) { fprintf(stderr, "kernel_launch: workspace too small: %zu < %zu\n", ws_size, (size_t)WS_END); grid = -1; }
    }
    if (grid < 0) return;
    Params p{};
    const float* const* in = (const float* const*)d_in;
    p.x = in[0]; p.meta = in[1]; p.norm1_g = in[2]; p.w_in = in[3]; p.conv_w = in[4]; p.conv_b = in[5]; p.conv_ln_g = in[6]; p.conv_ln_b = in[7];
    p.w_conv_out = in[8]; p.q_norm_g = in[9]; p.k_norm_g = in[10]; p.w_sb_out = in[11]; p.w_gate = in[12]; p.b_gate = in[13]; p.w_o = in[14];
    p.norm2_g = in[15]; p.peer_wq = in[16]; p.peer_k1 = in[17]; p.peer_k2 = in[18]; p.peer_u = in[19]; p.peer_v = in[20];
    p.out = (float*)d_out; p.ws = (unsigned char*)d_ws;
    (void)hipMemsetAsync(d_ws, 0, 16384, stream);
#if MULTI_LAUNCH
    for (int ph = 0; ph < 9; ++ph) {
        p.ph_lo = ph; p.ph_hi = ph + 1;
        hipLaunchKernelGGL(fwd_kernel, dim3(grid), dim3(NT), 0, stream, p);
    }
#else
    p.ph_lo = 0; p.ph_hi = 9;
    void* args[] = {&p};
    hipError_t e = hipLaunchCooperativeKernel((const void*)fwd_kernel, dim3(grid), dim3(NT), args, 0, stream);
    if (e != hipSuccess) fprintf(stderr, "cooperative launch failed: %s (grid %d)\n", hipGetErrorString(e), grid);
#endif
}
```

```cpp
#include <hip/hip_runtime.h>
#include <hip/hip_cooperative_groups.h>
#include <cstdio>
#include <cstdint>
#include <type_traits>
namespace cg = cooperative_groups;

#ifndef MULTI_LAUNCH
#define MULTI_LAUNCH 0
#endif

#define LAS __attribute__((address_space(3)))
#define GAS __attribute__((address_space(1)))
typedef unsigned short bf16_t;
typedef short bf16x8 __attribute__((ext_vector_type(8)));
typedef _Float16 f16x8 __attribute__((ext_vector_type(8)));
typedef float f32x4 __attribute__((ext_vector_type(4)));
typedef float f32x2 __attribute__((ext_vector_type(2)));
typedef unsigned u32x4 __attribute__((ext_vector_type(4)));
typedef unsigned u32x2 __attribute__((ext_vector_type(2)));
typedef int i32x4 __attribute__((ext_vector_type(4)));
typedef int i32x2 __attribute__((ext_vector_type(2)));

constexpr int D = 1024, SEQ = 16384, NMETA = 16, LTOK = SEQ + NMETA, LP2 = 16640;
constexpr int CONVC = 512, CONVW = 31, NH = 8, DH = 64, INC = 2560;
constexpr int PH = 8, NKEYS = 128;
constexpr float EPS = 1e-6f;
constexpr int NT = 512, NWV = 8;
constexpr int LDS_MAIN = 131072, LDS_BYTES = LDS_MAIN + 4096;

constexpr size_t TS = 524288;
constexpr size_t WS_RSTD1 = 16384;
constexpr size_t WS_RSTD2 = WS_RSTD1 + 131072;
constexpr size_t WS_SCU   = WS_RSTD2 + 65536;
constexpr size_t WS_SCV   = WS_SCU + 65536;
constexpr size_t WS_K1    = WS_SCV + 65536;
constexpr size_t WS_K2    = WS_K1 + 262144;
constexpr size_t WS_SSP   = WS_K2 + 262144;
constexpr size_t WS_WCAT  = 4 * TS;
constexpr size_t WS_WVT   = WS_WCAT + 16 * TS;
constexpr size_t WS_W2    = WS_WVT + 2 * TS;
constexpr size_t WS_WO    = WS_W2 + 4 * TS;
constexpr size_t WS_WQ    = WS_WO + 4 * TS;
constexpr size_t WS_HB    = WS_WQ + 8 * TS;
constexpr size_t WS_GATE  = WS_HB + 65 * TS;
constexpr size_t WS_GLU   = WS_GATE + 130 * TS;
constexpr size_t WS_Q     = WS_GLU + (size_t)LP2 * 512 * 2;
constexpr size_t WS_K     = WS_Q + (size_t)LP2 * 512 * 2;
constexpr size_t WS_VT    = WS_K + (size_t)LP2 * 512 * 2;
constexpr size_t WS_CO    = WS_VT + (size_t)LP2 * 512 * 2;
constexpr size_t WS_MIXED = WS_K;
constexpr size_t WS_H2B   = WS_GLU;
constexpr size_t WS_QP    = WS_K;
constexpr size_t WS_PART  = WS_K;
constexpr size_t WS_COEF  = WS_HB;
constexpr size_t WS_PIDX  = WS_GATE;
constexpr size_t WS_PGATE = WS_PIDX + (size_t)SEQ * 128 * 4;
constexpr size_t WS_UB    = WS_CO + (size_t)LP2 * 1024 * 2;
constexpr size_t WS_VB    = WS_UB + (size_t)16384 * 1024;
constexpr size_t WS_END   = WS_VB + (size_t)16384 * 1024;
static_assert(WS_SSP + (size_t)SEQ * 16 * 4 <= WS_WCAT, "small region overflow");
static_assert((size_t)SEQ * 2048 * 2 <= (size_t)LP2 * 512 * 2 * 2 + (size_t)LP2 * 1024 * 2, "qp does not fit");
static_assert((size_t)8 * SEQ * 128 * 4 <= (size_t)LP2 * 512 * 2 * 4, "part does not fit");
constexpr int TILE_WCAT = (int)(WS_WCAT / TS), TILE_WVT = (int)(WS_WVT / TS), TILE_HB = (int)(WS_HB / TS);
constexpr int CTR_MIX = 8, CTR_CONV = 9;

struct Params {
    const float* x; const float* meta; const float* norm1_g; const float* w_in; const float* conv_w; const float* conv_b;
    const float* conv_ln_g; const float* conv_ln_b; const float* w_conv_out; const float* q_norm_g; const float* k_norm_g;
    const float* w_sb_out; const float* w_gate; const float* b_gate; const float* w_o; const float* norm2_g;
    const float* peer_wq; const float* peer_k1; const float* peer_k2; const float* peer_u; const float* peer_v;
    float* out; unsigned char* ws;
    int ph_lo, ph_hi;
};

typedef float pk_f32x2 __attribute__((ext_vector_type(2)));
typedef __bf16 pk_bf16x2 __attribute__((ext_vector_type(2)));
typedef _Float16 pk_f16x2 __attribute__((ext_vector_type(2)));
__device__ __forceinline__ unsigned pack2bf(float lo, float hi) { pk_f32x2 v = {lo, hi}; return __builtin_bit_cast(unsigned, __builtin_convertvector(v, pk_bf16x2)); }
__device__ __forceinline__ unsigned pack2h(float lo, float hi) { pk_f32x2 v = {lo, hi}; return __builtin_bit_cast(unsigned, __builtin_convertvector(v, pk_f16x2)); }
__device__ __forceinline__ float bflo(unsigned u) { return __uint_as_float(u << 16); }
__device__ __forceinline__ float bfhi(unsigned u) { return __uint_as_float(u & 0xFFFF0000u); }
__device__ __forceinline__ float wave_sum(float v) {
#pragma unroll
    for (int o = 32; o > 0; o >>= 1) v += __shfl_xor(v, o);
    return v;
}
__device__ __forceinline__ float wave_max(float v) {
#pragma unroll
    for (int o = 32; o > 0; o >>= 1) v = fmaxf(v, __shfl_xor(v, o));
    return v;
}
__device__ __forceinline__ float sigmoidf_(float x) { return 1.f / (1.f + __expf(-x)); }
__device__ __forceinline__ int tid_opaque() { int t = threadIdx.x; asm volatile("" : "+v"(t)); return t; }
__device__ __forceinline__ int tswz(int r, int c) { return r * 512 + ((((c >> 2) ^ r) & 31) << 4) + ((c & 3) << 2); }

#define XB_TMO      128
#define XB_XCNT(j)  (256  + 64 * (j))
#define XB_XSUB(j)  (1280 + 64 * (j))
#define XB_XGEN(j)  (2304 + 64 * (j))
#define XB_TOP      3328
#define XB_TOPGEN   3392
#define XCD_BAR_WORDS 3456
#define XB_SPIN_CAP (1u << 20)
__device__ __forceinline__ unsigned xb_ld(unsigned* p)              { return __hip_atomic_load(p, __ATOMIC_RELAXED, __HIP_MEMORY_SCOPE_AGENT); }
__device__ __forceinline__ unsigned xb_add(unsigned* p, unsigned v) { return __hip_atomic_fetch_add(p, v, __ATOMIC_RELAXED, __HIP_MEMORY_SCOPE_AGENT); }
__device__ __forceinline__ unsigned xb_xcc_id() { return (unsigned)__builtin_amdgcn_s_getreg((3 << 11) | 20) & 0xFu; }
#define XB_SPIN(cond, bar) do { unsigned _sp = 0; while (cond) { __builtin_amdgcn_s_sleep(1); \
    if ((++_sp & 255u) == 0u) { if (xb_ld(&(bar)[XB_TMO])) break; if (_sp > XB_SPIN_CAP) { atomicAdd(&(bar)[XB_TMO], 1u); break; } } } } while (0)
struct XcdBarrier { unsigned* bar; unsigned x; volatile LAS unsigned* st; };
__device__ __forceinline__ XcdBarrier xcd_barrier_post(unsigned* bar, volatile LAS unsigned* st) {
    XcdBarrier b; b.bar = bar; b.x = xb_xcc_id(); b.st = st;
    if (threadIdx.x == 0) (void)xb_add(&bar[XB_XCNT(b.x)], 1u);
    return b;
}
__device__ __forceinline__ void xcd_barrier_complete(unsigned* bar, unsigned x, unsigned& nloc, unsigned& nx) {
    const unsigned G = gridDim.x * gridDim.y * gridDim.z;
    unsigned sum, cnt, mine, sp = 0u;
    for (;;) {
        sum = 0u; cnt = 0u; mine = 0u;
#pragma unroll
        for (unsigned j = 0; j < 16; ++j) { const unsigned c = xb_ld(&bar[XB_XCNT(j)]); sum += c; cnt += (c > 0u) ? 1u : 0u; mine = (j == x) ? c : mine; }
        if (sum == G) break;
        __builtin_amdgcn_s_sleep(1);
        if ((++sp & 255u) == 0u) { if (xb_ld(&bar[XB_TMO])) break; if (sp > XB_SPIN_CAP) { atomicAdd(&bar[XB_TMO], 1u); break; } }
    }
    nloc = mine > 0u ? mine : 1u; nx = cnt > 0u ? cnt : 1u;
}
__device__ __forceinline__ void xcd_barrier(const XcdBarrier& b) {
    asm volatile("s_waitcnt vmcnt(0)" ::: "memory");
    __syncthreads();
    if (threadIdx.x == 0) {
        unsigned* bar = b.bar;
        __builtin_amdgcn_s_waitcnt(0);
        unsigned nloc = b.st[0], nx = b.st[1];
        if (nloc == 0u) { xcd_barrier_complete(bar, b.x, nloc, nx); b.st[0] = nloc; b.st[1] = nx; }
        const unsigned old = xb_add(&bar[XB_XSUB(b.x)], 1u);
        const unsigned gen = old / nloc;
        if (old + 1u == (gen + 1u) * nloc) {
            __builtin_amdgcn_fence(__ATOMIC_RELEASE, "agent");
            asm volatile("s_waitcnt vmcnt(0)" ::: "memory");
            const unsigned og = xb_add(&bar[XB_TOP], 1u);
            const unsigned tg = og / nx;
            if (og + 1u == (tg + 1u) * nx) xb_add(&bar[XB_TOPGEN], 1u);
            else XB_SPIN(xb_ld(&bar[XB_TOPGEN]) == tg, bar);
            __builtin_amdgcn_fence(__ATOMIC_ACQUIRE, "agent");
            xb_add(&bar[XB_XGEN(b.x)], 1u);
            asm volatile("s_waitcnt vmcnt(0)" ::: "memory");
        } else {
            XB_SPIN(xb_ld(&bar[XB_XGEN(b.x)]) == gen, bar);
            __builtin_amdgcn_fence(__ATOMIC_ACQUIRE, "agent");
            asm volatile("s_waitcnt vmcnt(0)" ::: "memory");
        }
    }
    __syncthreads();
}

namespace pg8 {
constexpr int BM = 256, BK = 64, HALF = 128, HTB = HALF * BK * 2, STAGE_BYTES = 8 * HTB;
__host__ __device__ __forceinline__ int lds_byte(int r, int c) { const int st = (r >> 4) * 2 + (c >> 5), rr = r & 15, cc = c & 31, ob = rr * 64 + cc * 2; return st * 1024 + (ob ^ (((ob >> 9) & 1) << 5)); }
__host__ __device__ __forceinline__ void stage_rc(int b, int& R, int& C) { const int st = b / 1024, sb = b % 1024, swz = sb ^ (((sb >> 9) & 1) << 5); R = (st >> 1) * 16 + swz / 64; C = (st & 1) * 32 + (swz % 64) / 2; }
__host__ __device__ __forceinline__ int perm32(int rho) { const int n = rho >> 4, i = rho & 15; return 8 * (i >> 2) + 4 * n + (i & 3); }
struct Unit { int pm, pn; };
struct Gemm { const bf16_t* A; const bf16_t* Bt; int K; };

template <class Epi, class Sched>
__device__ __forceinline__ void gemm_phase(LAS unsigned char* lds, const Gemm g, const Sched& S, const Epi& E) {
    const int tid = threadIdx.x, wid = __builtin_amdgcn_readfirstlane(tid >> 6), lane = tid & 63, wr = wid >> 2, wc = wid & 3, fr = lane & 15, fq = lane >> 4;
    const int K = g.K, nt = K / BK;
    unsigned voffA[2], voffB[2];
#pragma unroll
    for (int i = 0; i < 2; ++i) { int R, C; stage_rc(tid * 16 + i * 8192, R, C); const int Rb = (R & ~31) + perm32(R & 31);
        voffA[i] = (unsigned)(R * K + C) * 2u; voffB[i] = (unsigned)(Rb * K + C) * 2u; }
    const size_t kstep = (size_t)(BK * 2);
    const size_t hstep = (size_t)HALF * K * 2;
    const size_t tstep = 2 * hstep;
    const unsigned ldsw = (unsigned)wid * 1024u;
    const int aoff = lds_byte(wr * 64 + fr, fq * 8), boff = lds_byte(wc * 32 + fr, fq * 8);
#define PG8_SA(b, h) (((b) * 2 + (h)) * HTB)
#define PG8_SB(b, h) ((4 + (b) * 2 + (h)) * HTB)
#define PG8_STAGE(bufoff, gbase, voff) do { _Pragma("unroll") for (int _i = 0; _i < 2; ++_i) \
        __builtin_amdgcn_global_load_lds((const GAS unsigned*)((const char*)(gbase) + (voff)[_i]), (LAS unsigned*)(lds + (bufoff) + ldsw + _i * 8192), 16, 0, 0); } while (0)
#define PG8_LDA(dst, b, h) do { _Pragma("unroll") for (int m = 0; m < 4; ++m) _Pragma("unroll") for (int k = 0; k < 2; ++k) dst[m][k] = *(const LAS bf16x8*)(lds + PG8_SA(b, h) + aoff + m * 2048 + k * 1024); } while (0)
#define PG8_LDB(dst, b, h) do { _Pragma("unroll") for (int n = 0; n < 2; ++n) _Pragma("unroll") for (int k = 0; k < 2; ++k) dst[n][k] = *(const LAS bf16x8*)(lds + PG8_SB(b, h) + boff + n * 2048 + k * 1024); } while (0)
#define PG8_MMA(ai, bj, At, Bt) do { __builtin_amdgcn_s_setprio(1); _Pragma("unroll") for (int m = 0; m < 4; ++m) _Pragma("unroll") for (int n = 0; n < 2; ++n) _Pragma("unroll") for (int k = 0; k < 2; ++k) \
        acc[ai][bj][m][n] = __builtin_amdgcn_mfma_f32_16x16x32_bf16(Bt[n][k], At[m][k], acc[ai][bj][m][n], 0, 0, 0); __builtin_amdgcn_s_setprio(0); } while (0)
#define PG8_WAIT_V(n) asm volatile("s_waitcnt vmcnt(" #n ")" ::: "memory")
#define PG8_WAIT_L(n) asm volatile("s_waitcnt lgkmcnt(" #n ")" ::: "memory")
#define PG8_BAR __builtin_amdgcn_s_barrier()
#define PG8_SCHED __builtin_amdgcn_sched_barrier(0)
    Unit cur, nxt; int ui = 0;
    if (!S.next(0, cur)) return;
    f32x4 acc[2][2][4][2];
#pragma unroll
    for (int a = 0; a < 2; ++a)
#pragma unroll
        for (int b = 0; b < 2; ++b)
#pragma unroll
            for (int m = 0; m < 4; ++m)
#pragma unroll
                for (int n = 0; n < 2; ++n) acc[a][b][m][n] = (f32x4){0.f, 0.f, 0.f, 0.f};
    bf16x8 At[4][2], B0[2][2], B1[2][2];
    const char* cA = (const char*)g.A + (size_t)cur.pm * tstep; const char* cB = (const char*)g.Bt + (size_t)cur.pn * tstep;
    PG8_STAGE(PG8_SB(0, 0), cB, voffB); PG8_STAGE(PG8_SA(0, 0), cA, voffA); PG8_STAGE(PG8_SB(0, 1), cB + hstep, voffB); PG8_STAGE(PG8_SA(0, 1), cA + hstep, voffA);
    if (wr == 1) PG8_BAR;
    PG8_WAIT_V(4); PG8_BAR;
    PG8_STAGE(PG8_SB(1, 0), cB + kstep, voffB); PG8_STAGE(PG8_SA(1, 0), cA + kstep, voffA); PG8_STAGE(PG8_SB(1, 1), cB + hstep + kstep, voffB);
    PG8_WAIT_V(6); PG8_BAR;
    for (;;) {
        const bool has_next = S.next(ui + 1, nxt);
        const char* nA = has_next ? (const char*)g.A + (size_t)nxt.pm * tstep : cA; const char* nB = has_next ? (const char*)g.Bt + (size_t)nxt.pn * tstep : cB;
        for (int t = 0; t < nt; t += 2) {
            const bool last = (t == nt - 2);
            const char* a1 = cA + (size_t)(t + 1) * kstep;
            const char* a2 = last ? nA : cA + (size_t)(t + 2) * kstep; const char* b2 = last ? nB : cB + (size_t)(t + 2) * kstep;
            const char* a3 = a2 + kstep; const char* b3 = b2 + kstep;
            if constexpr (Epi::HAS_MID) { if (t == nt / 2) E.mid(acc, cur, wr, wc, fr, fq); }
            PG8_LDB(B0, 0, 0); PG8_SCHED; PG8_LDA(At, 0, 0); PG8_STAGE(PG8_SA(1, 1), a1 + hstep, voffA);
            PG8_WAIT_L(8); PG8_BAR; PG8_WAIT_L(0); PG8_MMA(0, 0, At, B0); PG8_BAR; PG8_SCHED;
            PG8_LDB(B1, 0, 1); PG8_STAGE(PG8_SB(0, 0), b2, voffB);
            PG8_BAR; PG8_WAIT_L(0); PG8_MMA(0, 1, At, B1); PG8_BAR;
            PG8_LDA(At, 0, 1); PG8_STAGE(PG8_SA(0, 0), a2, voffA);
            PG8_BAR; PG8_WAIT_L(0); PG8_MMA(1, 0, At, B0); PG8_BAR; PG8_SCHED;
            PG8_STAGE(PG8_SB(0, 1), b2 + hstep, voffB);
            PG8_WAIT_V(6); PG8_BAR; PG8_MMA(1, 1, At, B1); PG8_BAR;
            PG8_LDB(B0, 1, 0); PG8_SCHED; PG8_LDA(At, 1, 0); PG8_STAGE(PG8_SA(0, 1), a2 + hstep, voffA);
            PG8_WAIT_L(8); PG8_BAR; PG8_WAIT_L(0); PG8_MMA(0, 0, At, B0); PG8_BAR; PG8_SCHED;
            PG8_LDB(B1, 1, 1); PG8_STAGE(PG8_SB(1, 0), b3, voffB);
            PG8_BAR; PG8_WAIT_L(0); PG8_MMA(0, 1, At, B1); PG8_BAR;
            PG8_LDA(At, 1, 1); PG8_STAGE(PG8_SA(1, 0), a3, voffA);
            PG8_BAR; PG8_WAIT_L(0); PG8_MMA(1, 0, At, B0); PG8_BAR; PG8_SCHED;
            PG8_STAGE(PG8_SB(1, 1), b3 + hstep, voffB);
            PG8_WAIT_V(6); PG8_BAR; PG8_MMA(1, 1, At, B1); PG8_BAR;
        }
        E(acc, cur, wr, wc, fr, fq);
        if (!has_next) break;
#pragma unroll
        for (int a = 0; a < 2; ++a)
#pragma unroll
            for (int b = 0; b < 2; ++b)
#pragma unroll
                for (int m = 0; m < 4; ++m)
#pragma unroll
                    for (int n = 0; n < 2; ++n) acc[a][b][m][n] = (f32x4){0.f, 0.f, 0.f, 0.f};
        cur = nxt; cA = nA; cB = nB; ++ui;
    }
    PG8_WAIT_V(0);
    if (wr == 0) PG8_BAR;
    PG8_BAR;
#undef PG8_SA
#undef PG8_SB
#undef PG8_STAGE
#undef PG8_LDA
#undef PG8_LDB
#undef PG8_MMA
#undef PG8_WAIT_V
#undef PG8_WAIT_L
#undef PG8_BAR
#undef PG8_SCHED
}
struct LinearOrder {
    int c, G, n;
    __device__ __forceinline__ int unit_id(int i) const { return ((i * 8 + (c & 7)) * (G >> 3)) + (c >> 3); }
};
}

__device__ void convert_tables(const Params& p, LAS char* sm) {
    const int tid = tid_opaque(), lane = tid & 63, wid = tid >> 6;
    unsigned char* ub = p.ws + WS_UB; unsigned char* vb = p.ws + WS_VB;
    float* scu = (float*)(p.ws + WS_SCU); float* scv = (float*)(p.ws + WS_SCV);
    unsigned* ctr = (unsigned*)p.ws + CTR_CONV;
    LAS int* slot = (LAS int*)(sm + LDS_MAIN + 128);
    for (;;) {
        if (threadIdx.x == 0) *slot = (int)atomicAdd(ctr, 1u);
        __syncthreads();
        const int chunk = *slot;
        __syncthreads();
        if (chunk >= 2 * 16384 / 64) break;
        const int r8 = chunk * 8 + wid;
        const int row0 = r8 * 8;
        const bool isv = row0 >= 16384; const int e0 = isv ? row0 - 16384 : row0;
        const float* src = (isv ? p.peer_v : p.peer_u) + (size_t)e0 * D + 16 * lane;
        f32x4 a[8][4];
#pragma unroll
        for (int r = 0; r < 8; ++r)
#pragma unroll
            for (int i = 0; i < 4; ++i) a[r][i] = *(const f32x4*)(src + (size_t)r * D + 4 * i);
        if (!isv) {
#pragma unroll
            for (int i = 0; i < 4; ++i) { const f32x4 gg = *(const f32x4*)(p.norm2_g + 16 * lane + 4 * i);
#pragma unroll
                for (int r = 0; r < 8; ++r) a[r][i] = a[r][i] * gg; }
        }
#pragma unroll
        for (int r = 0; r < 8; ++r) {
            float am = 0.f;
#pragma unroll
            for (int i = 0; i < 4; ++i) am = fmaxf(am, fmaxf(fmaxf(fabsf(a[r][i][0]), fabsf(a[r][i][1])), fmaxf(fabsf(a[r][i][2]), fabsf(a[r][i][3]))));
            am = wave_max(am);
            u32x4 o;
            if (isv) {
                const float sc = am > 0.f ? 448.f / am : 1.f;
#pragma unroll
                for (int i = 0; i < 4; ++i) {
                    int w = 0;
                    w = __builtin_amdgcn_cvt_pk_fp8_f32(a[r][i][0] * sc, a[r][i][1] * sc, w, false);
                    w = __builtin_amdgcn_cvt_pk_fp8_f32(a[r][i][2] * sc, a[r][i][3] * sc, w, true);
                    o[i] = (unsigned)w;
                }
                *(u32x4*)(vb + ((size_t)(lane >> 3) * 16384 + (e0 + r)) * 128 + 16 * (lane & 7)) = o;
                if (lane == 0) scv[e0 + r] = am > 0.f ? am * (1.f / 448.f) : 1.f;
            } else {
                const float sc = am > 0.f ? 127.f / am : 0.f;
#pragma unroll
                for (int i = 0; i < 4; ++i) {
                    const int q0 = __float2int_rn(a[r][i][0] * sc), q1 = __float2int_rn(a[r][i][1] * sc), q2 = __float2int_rn(a[r][i][2] * sc), q3 = __float2int_rn(a[r][i][3] * sc);
                    o[i] = (unsigned)(q0 & 255) | ((unsigned)(q1 & 255) << 8) | ((unsigned)(q2 & 255) << 16) | ((unsigned)q3 << 24);
                }
                *(u32x4*)(ub + ((size_t)(lane >> 3) * 16384 + (e0 + r)) * 128 + 16 * (lane & 7)) = o;
                if (lane == 0) scu[e0 + r] = am * (1.f / 127.f);
            }
        }
    }
}
__device__ void phase_prep(const Params& p, LAS char* sm) {
    const int tid = tid_opaque(), lane = tid & 63, wid = tid >> 6;
    const int G = gridDim.x, b = blockIdx.x;
    const int gwv = b * NWV + wid, nwv = G * NWV;
    bf16_t* hb = (bf16_t*)(p.ws + WS_HB);
    float* rstd1 = (float*)(p.ws + WS_RSTD1);
    constexpr int J0 = 64 * 16, J1 = J0 + 8 * 16, J2 = J1 + 16 * 16, J3 = J2 + 16 * 16, J4 = J3;
    LAS float* T = (LAS float*)(sm + wid * 16640);
    for (int it = gwv; it < J4; it += nwv) {
        const float* src; int N, col, kt, rt, koff = 0; bf16_t* dst; const float* g = nullptr;
        if (it < J0) {
            kt = it >> 6; rt = it & 63; g = p.norm1_g; dst = (bf16_t*)(p.ws + WS_WCAT);
            const int R = rt * 64 + lane, u = R >> 8, t = R & 255;
            if (u < 4) { src = p.w_in; N = INC; col = t < 128 ? (128 * u + t) : (512 + 128 * u + t - 128); }
            else if (u < 8) { src = p.w_in; N = INC; const int head = 4 * ((u - 4) & 1) + ((t >> 5) & 3), d = 32 * (t >> 7) + 16 * ((t >> 4) & 1) + (t & 15); col = (u < 6 ? 1024 : 1536) + 64 * head + d; }
            else { src = p.w_gate; N = 2048; col = t < 128 ? (128 * (u - 8) + t) : (1024 + 128 * (u - 8) + t - 128); }
        } else if (it < J1) { const int q = it - J0; kt = q >> 3; rt = q & 7; g = p.norm1_g; dst = (bf16_t*)(p.ws + WS_WVT); src = p.w_in; N = INC; col = 2048 + rt * 64 + lane; }
        else if (it < J2) {
            const int q = it - J1; kt = q >> 4; rt = q & 15; dst = (bf16_t*)(p.ws + WS_W2); N = 1024; col = rt * 64 + lane;
            if (kt < 8) src = p.w_conv_out; else { src = p.w_sb_out; koff = -512; }
        } else if (it < J3) { const int q = it - J2; kt = q >> 4; rt = q & 15; dst = (bf16_t*)(p.ws + WS_WO); src = p.w_o; N = 1024; col = rt * 64 + lane; }
        else break;
        const int k0 = kt * 64;
        {
            float v[64];
#pragma unroll
            for (int k = 0; k < 64; ++k) v[k] = src[(size_t)(k0 + k + koff) * N + col];
#pragma unroll
            for (int k = 0; k < 64; ++k) T[k * 65 + lane] = v[k];
            __builtin_amdgcn_wave_barrier();
            asm volatile("s_waitcnt lgkmcnt(0)" ::: "memory");
            const int ko = lane & 7, nl = lane >> 3;
            f32x4 g0 = (f32x4){1.f, 1.f, 1.f, 1.f}, g1 = g0;
            if (g) { g0 = *(const f32x4*)(g + k0 + 8 * ko); g1 = *(const f32x4*)(g + k0 + 8 * ko + 4); }
#pragma unroll
            for (int nb = 0; nb < 8; ++nb) {
                const int n = nb * 8 + nl;
                float t[8];
#pragma unroll
                for (int j = 0; j < 8; ++j) t[j] = T[(8 * ko + j) * 65 + n];
                u32x4 o; o[0] = pack2bf(t[0] * g0[0], t[1] * g0[1]); o[1] = pack2bf(t[2] * g0[2], t[3] * g0[3]); o[2] = pack2bf(t[4] * g1[0], t[5] * g1[1]); o[3] = pack2bf(t[6] * g1[2], t[7] * g1[3]);
                *(u32x4*)(dst + (size_t)(rt * 64 + n) * D + k0 + 8 * ko) = o;
            }
            __builtin_amdgcn_wave_barrier();
            asm volatile("s_waitcnt lgkmcnt(0)" ::: "memory");
        }
    }
    {
        bf16_t* wf = (bf16_t*)(p.ws + WS_WQ);
        const int fr = lane & 15, fq = lane >> 4;
        for (int it = gwv; it < 128 * 64; it += nwv) {
            const int nt16 = it >> 6, kt16 = it & 63;
            const int hh = nt16 >> 3, key0 = (nt16 & 7) * 16, k0 = kt16 * 16;
            const float* ka = ((hh & 1) ? p.peer_k2 : p.peer_k1) + ((size_t)(hh >> 1) * 128 + key0 + fr) * 128 + 32 * fq;
            const float* wb = p.peer_wq + (size_t)(k0 + fr) * 2048 + hh * 128 + 32 * fq;
            f32x4 av[8], bv[8];
#pragma unroll
            for (int c = 0; c < 8; ++c) { av[c] = *(const f32x4*)(ka + 4 * c); bv[c] = *(const f32x4*)(wb + 4 * c); }
            f32x4 acc = (f32x4){0.f, 0.f, 0.f, 0.f};
#pragma unroll
            for (int st = 0; st < 32; ++st) acc = __builtin_amdgcn_mfma_f32_16x16x4f32(bv[st >> 2][st & 3], av[st >> 2][st & 3], acc, 0, 0, 0);
            const f32x4 gk = *(const f32x4*)(p.norm2_g + k0 + 4 * fq);
            u32x2 o; o[0] = pack2bf(acc[0] * gk[0], acc[1] * gk[1]); o[1] = pack2bf(acc[2] * gk[2], acc[3] * gk[3]);
            *(u32x2*)(wf + (size_t)(hh * 128 + key0 + fr) * D + k0 + 4 * fq) = o;
        }
    }
    for (int r0 = gwv; r0 < LP2; r0 += 4 * nwv) {
        f32x4 v[4][4];
#pragma unroll
        for (int r = 0; r < 4; ++r) {
            const int row = r0 + r * nwv;
            const float* src = row < NMETA ? p.meta + (size_t)row * D : (row < LTOK ? p.x + (size_t)(row - NMETA) * D : nullptr);
#pragma unroll
            for (int i = 0; i < 4; ++i) { v[r][i] = (f32x4){0.f, 0.f, 0.f, 0.f}; if (src) v[r][i] = *(const f32x4*)(src + lane * 4 + 256 * i); }
        }
#pragma unroll
        for (int r = 0; r < 4; ++r) {
            const int row = r0 + r * nwv;
            if (row < LP2) {
                float ss = 0.f;
#pragma unroll
                for (int i = 0; i < 4; ++i) {
                    ss += v[r][i][0] * v[r][i][0] + v[r][i][1] * v[r][i][1] + v[r][i][2] * v[r][i][2] + v[r][i][3] * v[r][i][3];
                    u32x2 o; o[0] = pack2bf(v[r][i][0], v[r][i][1]); o[1] = pack2bf(v[r][i][2], v[r][i][3]);
                    *(u32x2*)(hb + (size_t)row * D + lane * 4 + 256 * i) = o;
                }
                ss = wave_sum(ss);
                if (lane == 0) rstd1[row] = rsqrtf(ss * (1.f / D) + EPS);
            }
        }
    }
}

struct OrderP1 : pg8::LinearOrder {
    __device__ __forceinline__ bool next(int i, pg8::Unit& u) const {
        const int L = unit_id(i);
        if (L >= 1040 + 130) return false;
        if (L < 1040) { u.pm = TILE_HB + (L >> 4); u.pn = TILE_WCAT + (L & 15); }
        else { const int q = L - 1040; u.pm = TILE_WVT + (q & 1); u.pn = TILE_HB + (q >> 1); }
        return true;
    }
};
struct EpiP1 {
    static constexpr bool HAS_MID = false;
    const float* rstd1; bf16_t* glu; bf16_t* qo; bf16_t* ko; bf16_t* vt; bf16_t* gate; const float* qg; const float* kg; const float* bgate;
    __device__ __forceinline__ void operator()(const f32x4 (&acc)[2][2][4][2], const pg8::Unit& u, int wr, int wc, int fr_, int fq_) const {
        int fr = fr_, fq = fq_; asm volatile("" : "+v"(fr), "+v"(fq));
        if (u.pm >= TILE_WVT && u.pm < TILE_WVT + 2) {
            const int s0 = 256 * (u.pn - TILE_HB);
            f32x4 rs[2][2];
#pragma unroll
            for (int bj = 0; bj < 2; ++bj)
#pragma unroll
                for (int n = 0; n < 2; ++n) rs[bj][n] = *(const f32x4*)(rstd1 + s0 + 128 * bj + 32 * wc + 8 * fq + 4 * n);
            asm volatile("s_waitcnt vmcnt(0)" ::: "memory");
#pragma unroll
            for (int bj = 0; bj < 2; ++bj) {
                const int s = s0 + 128 * bj + 32 * wc + 8 * fq;
#pragma unroll
                for (int ai = 0; ai < 2; ++ai)
#pragma unroll
                    for (int m = 0; m < 4; ++m) {
                        const int rv = 256 * (u.pm - TILE_WVT) + 128 * ai + 64 * wr + 16 * m + fr, head = rv >> 6, d = rv & 63;
                        const f32x4 v0 = acc[ai][bj][m][0] * rs[bj][0], v1 = acc[ai][bj][m][1] * rs[bj][1];
                        u32x4 o; o[0] = pack2h(v0[0], v0[1]); o[1] = pack2h(v0[2], v0[3]); o[2] = pack2h(v1[0], v1[1]); o[3] = pack2h(v1[2], v1[3]);
                        *(u32x4*)(vt + (((size_t)head * (LP2 / 64) + (s >> 6)) * 64 + d) * 64 + (s & 63)) = o;
                    }
            }
            return;
        }
        const int pmr = u.pm - TILE_HB, un = u.pn - TILE_WCAT;
        const int row0 = 256 * pmr + 64 * wr + fr;
        float scv[2][4];
#pragma unroll
        for (int ai = 0; ai < 2; ++ai)
#pragma unroll
            for (int m = 0; m < 4; ++m) scv[ai][m] = rstd1[row0 + 128 * ai + 16 * m];
        f32x4 aux[2][2];
        if (un >= 4) {
            const bool isq = un < 6;
            const float* ap = un < 8 ? (isq ? qg : kg) : (bgate + 128 * (un - 8) + 32 * wc);
#pragma unroll
            for (int bj = 0; bj < 2; ++bj)
#pragma unroll
                for (int n = 0; n < 2; ++n) aux[bj][n] = *(const f32x4*)(ap + (un < 8 ? 32 : 1024) * bj + 8 * fq + 4 * n);
        }
        asm volatile("s_waitcnt vmcnt(0)" ::: "memory");
#pragma unroll
        for (int ai = 0; ai < 2; ++ai)
#pragma unroll
            for (int m = 0; m < 4; ++m) {
                const int row = row0 + 128 * ai + 16 * m;
                const float sc = scv[ai][m];
                if (un < 4) {
                    u32x4 o;
#pragma unroll
                    for (int n = 0; n < 2; ++n) {
                        const f32x4 a = acc[ai][0][m][n] * sc, gt = acc[ai][1][m][n] * sc;
                        o[2 * n] = pack2bf(a[0] * sigmoidf_(gt[0]), a[1] * sigmoidf_(gt[1])); o[2 * n + 1] = pack2bf(a[2] * sigmoidf_(gt[2]), a[3] * sigmoidf_(gt[3]));
                    }
                    *(u32x4*)(glu + (size_t)row * CONVC + 128 * un + 32 * wc + 8 * fq) = o;
                } else if (un < 8) {
                    const bool isq = un < 6;
                    const int head = 4 * ((un - 4) & 1) + wc;
                    float ss = 0.f;
#pragma unroll
                    for (int bj = 0; bj < 2; ++bj)
#pragma unroll
                        for (int n = 0; n < 2; ++n) { const f32x4 v = acc[ai][bj][m][n]; ss += v[0] * v[0] + v[1] * v[1] + v[2] * v[2] + v[3] * v[3]; }
                    ss += __shfl_xor(ss, 16); ss += __shfl_xor(ss, 32);
                    const float r2 = rsqrtf(ss * sc * sc * (1.f / 64.f) + EPS) * (isq ? 0.125f * 1.44269504088896341f : 1.f) * sc;
                    bf16_t* dst = (isq ? qo : ko) + ((size_t)head * LP2 + row) * DH;
#pragma unroll
                    for (int bj = 0; bj < 2; ++bj) {
                        const f32x4 v0 = acc[ai][bj][m][0] * aux[bj][0] * r2, v1 = acc[ai][bj][m][1] * aux[bj][1] * r2;
                        u32x4 o; o[0] = pack2bf(v0[0], v0[1]); o[1] = pack2bf(v0[2], v0[3]); o[2] = pack2bf(v1[0], v1[1]); o[3] = pack2bf(v1[2], v1[3]);
                        *(u32x4*)(dst + 32 * bj + 8 * fq) = o;
                    }
                } else {
                    const int col = 128 * (un - 8) + 32 * wc + 8 * fq;
                    u32x4 orat, ogs;
#pragma unroll
                    for (int n = 0; n < 2; ++n) {
                        const f32x4 vc = acc[ai][0][m][n] * sc + aux[0][n], vs = acc[ai][1][m][n] * sc + aux[1][n];
                        float rt_[4], gs_[4];
#pragma unroll
                        for (int e = 0; e < 4; ++e) { const float ec = __expf(-vc[e]), es = __expf(-vs[e]); gs_[e] = 1.f / (1.f + es); rt_[e] = (1.f + es) / (1.f + ec); }
                        orat[2 * n] = pack2bf(rt_[0], rt_[1]); orat[2 * n + 1] = pack2bf(rt_[2], rt_[3]);
                        ogs[2 * n] = pack2bf(gs_[0], gs_[1]); ogs[2 * n + 1] = pack2bf(gs_[2], gs_[3]);
                    }
                    *(u32x4*)(gate + (size_t)row * 2048 + col) = orat;
                    *(u32x4*)(gate + (size_t)row * 2048 + 1024 + col) = ogs;
                }
            }
    }
};
__device__ void phase_gemm1(const Params& p, LAS char* sm) {
    OrderP1 S; S.c = blockIdx.x; S.G = gridDim.x; S.n = 0;
    EpiP1 E{(const float*)(p.ws + WS_RSTD1), (bf16_t*)(p.ws + WS_GLU), (bf16_t*)(p.ws + WS_Q), (bf16_t*)(p.ws + WS_K), (bf16_t*)(p.ws + WS_VT), (bf16_t*)(p.ws + WS_GATE),
            p.q_norm_g, p.k_norm_g, p.b_gate};
    pg8::Gemm g{(const bf16_t*)p.ws, (const bf16_t*)p.ws, D};
    pg8::gemm_phase((LAS unsigned char*)sm, g, S, E);
    convert_tables(p, sm);
}

__device__ void conv_item(const Params& p, LAS char* sm, int item) {
    const int tid = tid_opaque(), lane = tid & 63, wid = tid >> 6;
    const bf16_t* glu = (const bf16_t*)(p.ws + WS_GLU);
    bf16_t* co = (bf16_t*)(p.ws + WS_CO);
    const int t0 = item * 32;
    {
        u32x4 v[8];
#pragma unroll
        for (int i = 0; i < 8; ++i) {
            const int c = tid + i * NT, row = c >> 6, ch = c & 63, g = t0 - 30 + row;
            v[i] = (u32x4){0u, 0u, 0u, 0u};
            if (c < 62 * 64 && g >= 0) v[i] = *(const u32x4*)(glu + (size_t)g * CONVC + ch * 8);
        }
#pragma unroll
        for (int i = 0; i < 8; ++i) {
            const int c = tid + i * NT, row = c >> 6, ch = c & 63;
            if (c < 62 * 64) *(LAS u32x4*)(sm + row * 1024 + ch * 16) = v[i];
        }
    }
    float wa[CONVW];
#pragma unroll
    for (int j = 0; j < CONVW; ++j) wa[j] = p.conv_w[j * CONVC + tid];
    const float bias = p.conv_b[tid];
    float aa[32];
#pragma unroll
    for (int r = 0; r < 32; ++r) aa[r] = bias;
    __syncthreads();
#pragma unroll
    for (int i = 0; i < 62; ++i) {
        const float xa = __uint_as_float((unsigned)(*(LAS unsigned short*)(sm + i * 1024 + tid * 2)) << 16);
#pragma unroll
        for (int r = 0; r < 32; ++r) {
            const int j = i - r;
            if (j >= 0 && j < CONVW) aa[r] += wa[j] * xa;
        }
    }
    __syncthreads();
#pragma unroll
    for (int r = 0; r < 32; ++r) *(LAS float*)(sm + (r * 516 + tid) * 4) = aa[r];
    __syncthreads();
    const f32x4 g0 = *(const f32x4*)(p.conv_ln_g + lane * 4), g1 = *(const f32x4*)(p.conv_ln_g + 256 + lane * 4);
    const f32x4 b0 = *(const f32x4*)(p.conv_ln_b + lane * 4), b1 = *(const f32x4*)(p.conv_ln_b + 256 + lane * 4);
#pragma unroll 1
    for (int rr = 0; rr < 4; ++rr) {
        const int r = wid * 4 + rr;
        f32x4 v0 = *(LAS f32x4*)(sm + (r * 516 + lane * 4) * 4), v1 = *(LAS f32x4*)(sm + (r * 516 + 256 + lane * 4) * 4);
        float s = v0[0] + v0[1] + v0[2] + v0[3] + v1[0] + v1[1] + v1[2] + v1[3];
        s = wave_sum(s);
        const float mu = s * (1.f / CONVC);
        float q = 0.f;
#pragma unroll
        for (int e = 0; e < 4; ++e) { v0[e] -= mu; v1[e] -= mu; q += v0[e] * v0[e] + v1[e] * v1[e]; }
        q = wave_sum(q);
        const float rstd = rsqrtf(q * (1.f / CONVC) + EPS);
        float y0[4], y1[4];
#pragma unroll
        for (int e = 0; e < 4; ++e) {
            float a = v0[e] * rstd * g0[e] + b0[e]; y0[e] = a * sigmoidf_(a);
            float c = v1[e] * rstd * g1[e] + b1[e]; y1[e] = c * sigmoidf_(c);
        }
        const int t = t0 + r;
        u32x2 o; o[0] = pack2bf(y0[0], y0[1]); o[1] = pack2bf(y0[2], y0[3]);
        *(u32x2*)(co + (size_t)t * D + lane * 4) = o;
        o[0] = pack2bf(y1[0], y1[1]); o[1] = pack2bf(y1[2], y1[3]);
        *(u32x2*)(co + (size_t)t * D + 256 + lane * 4) = o;
    }
    __syncthreads();
}

__device__ void attn_item(const Params& p, LAS char* sm, int head, int qb) {
    const int tid = tid_opaque(), lane = tid & 63, w = __builtin_amdgcn_readfirstlane(tid >> 6), fr = lane & 15, fq = lane >> 4;
    const bf16_t* Qh = (const bf16_t*)(p.ws + WS_Q) + (size_t)head * LP2 * DH;
    const bf16_t* Kh = (const bf16_t*)(p.ws + WS_K) + (size_t)head * LP2 * DH;
    const bf16_t* Vth = (const bf16_t*)(p.ws + WS_VT) + (size_t)head * (LP2 / 64) * 4096;
    bf16_t* og = (bf16_t*)(p.ws + WS_CO) + 512;
    LAS char* Ks = sm;
    LAS char* Vs = sm + 8192;
    LAS char* LK = sm + 16384 + w * 8192;
    LAS char* PS = LK + 4096;
    LAS float* flags = (LAS float*)(sm + LDS_MAIN);
    const int trb0 = qb * 256 + 16 * w, trb1 = trb0 + 128;
    bf16x8 qf[2][2];
#pragma unroll
    for (int nt = 0; nt < 2; ++nt)
#pragma unroll
        for (int kh = 0; kh < 2; ++kh) qf[nt][kh] = *(const bf16x8*)(Qh + (size_t)((nt ? trb1 : trb0) + fr) * DH + 32 * kh + 8 * fq);
    f32x4 oT[4][2];
#pragma unroll
    for (int i = 0; i < 4; ++i) { oT[i][0] = (f32x4){0.f, 0.f, 0.f, 0.f}; oT[i][1] = (f32x4){0.f, 0.f, 0.f, 0.f}; }
    float R[2] = {0.f, 0.f};
    const int swz = fr & 7;
    const int prow = tid >> 3, pc = (tid & 7) ^ (prow & 7);
    int kt = 4 * qb + 3;
    u32x4 kv = *(const u32x4*)(Kh + (size_t)(kt * 64 + prow) * DH + pc * 8);
    u32x4 vv = *(const u32x4*)(Vth + (size_t)kt * 4096 + prow * 64 + pc * 8);
    auto tile = [&](auto MASKED_T, auto A0_T, auto A1_T, int s0) {
        constexpr bool MASKED = decltype(MASKED_T)::value, a0 = decltype(A0_T)::value, a1 = decltype(A1_T)::value;
        f32x4 z[4][2];
#pragma unroll
        for (int i = 0; i < 4; ++i) { z[i][0] = (f32x4){0.f, 0.f, 0.f, 0.f}; z[i][1] = (f32x4){0.f, 0.f, 0.f, 0.f}; }
#pragma unroll
        for (int kh = 0; kh < 2; ++kh)
#pragma unroll
            for (int ms = 0; ms < 4; ++ms) {
                const bf16x8 kf = *(LAS bf16x8*)(Ks + (16 * ms + fr) * 128 + (((4 * kh + fq) ^ swz) << 4));
                if constexpr (a0) z[ms][0] = __builtin_amdgcn_mfma_f32_16x16x32_bf16(kf, qf[0][kh], z[ms][0], 0, 0, 0);
                if constexpr (a1) z[ms][1] = __builtin_amdgcn_mfma_f32_16x16x32_bf16(kf, qf[1][kh], z[ms][1], 0, 0, 0);
            }
        float lsum[2] = {0.f, 0.f};
#pragma unroll
        for (int ms = 0; ms < 4; ++ms)
#pragma unroll
            for (int nt = 0; nt < 2; ++nt) {
                if (!(nt ? a1 : a0)) continue;
                const int t = (nt ? trb1 : trb0) + fr;
                float lk[4];
#pragma unroll
                for (int j = 0; j < 4; ++j) {
                    const float zz = z[ms][nt][j];
                    const float sp = fmaxf(zz, 0.f) + __builtin_amdgcn_logf(1.f + __builtin_amdgcn_exp2f(-fabsf(zz)));
                    float l = -sp;
                    if (MASKED) { const int s = s0 + 16 * ms + 4 * fq + j; l = (s < t) ? l : 0.f; }
                    lk[j] = l; lsum[nt] += l;
                    z[ms][nt][j] = zz - sp;
                }
                u32x2 ph; ph[0] = pack2h(lk[0], lk[1]); ph[1] = pack2h(lk[2], lk[3]);
                *(LAS u32x2*)(LK + (16 * nt + fr) * 128 + ((((2 * ms + (fq >> 1)) ^ swz)) << 4) + (fq & 1) * 8) = ph;
            }
        __builtin_amdgcn_wave_barrier();
        asm volatile("s_waitcnt lgkmcnt(0)" ::: "memory");
        f32x4 st[4][2];
#pragma unroll
        for (int i = 0; i < 4; ++i) { st[i][0] = (f32x4){0.f, 0.f, 0.f, 0.f}; st[i][1] = (f32x4){0.f, 0.f, 0.f, 0.f}; }
#pragma unroll
        for (int kh = 0; kh < 2; ++kh) {
            f16x8 bh[2];
#pragma unroll
            for (int nt = 0; nt < 2; ++nt) if (nt ? a1 : a0) bh[nt] = *(LAS f16x8*)(LK + (16 * nt + fr) * 128 + (((4 * kh + fq) ^ swz) << 4));
#pragma unroll
            for (int ms = 0; ms < 4; ++ms) {
                if (32 * kh + 32 <= 16 * ms + 1) continue;
                f16x8 tm;
#pragma unroll
                for (int e = 0; e < 8; ++e) tm[e] = (32 * kh + 8 * fq + e > 16 * ms + fr) ? (_Float16)1.0f : (_Float16)0.0f;
                if constexpr (a0) st[ms][0] = __builtin_amdgcn_mfma_f32_16x16x32_f16(tm, bh[0], st[ms][0], 0, 0, 0);
                if constexpr (a1) st[ms][1] = __builtin_amdgcn_mfma_f32_16x16x32_f16(tm, bh[1], st[ms][1], 0, 0, 0);
            }
        }
#pragma unroll
        for (int ms = 0; ms < 4; ++ms)
#pragma unroll
            for (int nt = 0; nt < 2; ++nt) {
                if (!(nt ? a1 : a0)) continue;
                const int t = (nt ? trb1 : trb0) + fr;
                float wv[4];
#pragma unroll
                for (int j = 0; j < 4; ++j) {
                    float wj = __builtin_amdgcn_exp2f(z[ms][nt][j] + R[nt] + st[ms][nt][j]);
                    if (MASKED) { const int s = s0 + 16 * ms + 4 * fq + j; wj = (s < t) ? wj : 0.f; }
                    wv[j] = wj;
                }
                u32x2 pw; pw[0] = pack2h(wv[0], wv[1]); pw[1] = pack2h(wv[2], wv[3]);
                *(LAS u32x2*)(PS + (16 * nt + fr) * 128 + ((((2 * ms + (fq >> 1)) ^ swz)) << 4) + (fq & 1) * 8) = pw;
            }
#pragma unroll
        for (int nt = 0; nt < 2; ++nt) {
            if (!(nt ? a1 : a0)) continue;
            float tsum = lsum[nt];
            tsum += __shfl_xor(tsum, 16);
            tsum += __shfl_xor(tsum, 32);
            R[nt] += tsum;
        }
        __builtin_amdgcn_wave_barrier();
        asm volatile("s_waitcnt lgkmcnt(0)" ::: "memory");
#pragma unroll
        for (int kh = 0; kh < 2; ++kh) {
            f16x8 pf[2];
#pragma unroll
            for (int nt = 0; nt < 2; ++nt) if (nt ? a1 : a0) pf[nt] = *(LAS f16x8*)(PS + (16 * nt + fr) * 128 + (((4 * kh + fq) ^ swz) << 4));
#pragma unroll
            for (int md = 0; md < 4; ++md) {
                const f16x8 vf = *(LAS f16x8*)(Vs + (16 * md + fr) * 128 + (((4 * kh + fq) ^ swz) << 4));
                if constexpr (a0) oT[md][0] = __builtin_amdgcn_mfma_f32_16x16x32_f16(vf, pf[0], oT[md][0], 0, 0, 0);
                if constexpr (a1) oT[md][1] = __builtin_amdgcn_mfma_f32_16x16x32_f16(vf, pf[1], oT[md][1], 0, 0, 0);
            }
        }
    };
    bool done0 = false, done1 = false;
    for (; kt >= 0; --kt) {
        *(LAS u32x4*)(Ks + tid * 16) = kv;
        *(LAS u32x4*)(Vs + tid * 16) = vv;
        __syncthreads();
        if (kt > 0) {
            kv = *(const u32x4*)(Kh + (size_t)((kt - 1) * 64 + prow) * DH + pc * 8);
            vv = *(const u32x4*)(Vth + (size_t)(kt - 1) * 4096 + prow * 64 + pc * 8);
        }
        {
            const int s0 = kt * 64;
            const bool a0 = !done0 && s0 <= trb0, a1 = !done1 && s0 <= trb1;
            if (a0 || a1) {
                const bool mk = (a0 && s0 + 63 >= trb0) || (a1 && s0 + 63 >= trb1);
                if (a0 && a1) { if (mk) tile(std::true_type{}, std::true_type{}, std::true_type{}, s0); else tile(std::false_type{}, std::true_type{}, std::true_type{}, s0); }
                else if (a0) { if (mk) tile(std::true_type{}, std::true_type{}, std::false_type{}, s0); else tile(std::false_type{}, std::true_type{}, std::false_type{}, s0); }
                else { if (mk) tile(std::true_type{}, std::false_type{}, std::true_type{}, s0); else tile(std::false_type{}, std::false_type{}, std::true_type{}, s0); }
                if (a0) done0 = __int_as_float(__builtin_amdgcn_readfirstlane(__float_as_int(wave_max(R[0])))) < -127.f;
                if (a1) done1 = __int_as_float(__builtin_amdgcn_readfirstlane(__float_as_int(wave_max(R[1])))) < -127.f;
            }
        }
        const float wm = wave_max(fmaxf(R[0], R[1]));
        if (lane == 0) flags[(kt & 1) * 8 + w] = wm;
        __syncthreads();
        float m8 = flags[(kt & 1) * 8];
#pragma unroll
        for (int i = 1; i < 8; ++i) m8 = fmaxf(m8, flags[(kt & 1) * 8 + i]);
        if (m8 < -127.f) break;
    }
#pragma unroll
    for (int md = 0; md < 4; ++md)
#pragma unroll
        for (int nt = 0; nt < 2; ++nt) {
            const int t = (nt ? trb1 : trb0) + fr;
            u32x2 o; o[0] = pack2bf(oT[md][nt][0], oT[md][nt][1]); o[1] = pack2bf(oT[md][nt][2], oT[md][nt][3]);
            *(u32x2*)(og + (size_t)t * D + head * 64 + 16 * md + 4 * fq) = o;
        }
    __syncthreads();
}

__device__ void phase_mixers(const Params& p, LAS char* sm) {
    constexpr int NQB = LP2 / 256, NATT = NH * NQB, NCONV = (LTOK + 31) / 32;
    unsigned* ctr = (unsigned*)p.ws + CTR_MIX;
    LAS int* slot = (LAS int*)(sm + LDS_MAIN + 128);
    if (threadIdx.x == 0) *slot = (int)atomicAdd(ctr, 1u);
    __syncthreads();
    for (;;) {
        const int it = *slot;
        __syncthreads();
        if (it >= NATT + NCONV) break;
        unsigned nx = 0u;
        if (threadIdx.x == 0) nx = atomicAdd(ctr, 1u);
        if (it < NATT) { const int qb = NQB - 1 - it / NH, head = it % NH; attn_item(p, sm, head, qb); }
        else conv_item(p, sm, it - NATT);
        if (threadIdx.x == 0) *slot = (int)nx;
        __syncthreads();
    }
}

struct OrderMN : pg8::LinearOrder {
    __device__ __forceinline__ bool next(int i, pg8::Unit& u) const {
        const int L = unit_id(i);
        if (L >= 64 * n) return false;
        u.pm = L / n; u.pn = L % n; return true;
    }
};
struct EpiP3 {
    static constexpr bool HAS_MID = true;
    const bf16_t* gate; bf16_t* mixed;
    __device__ __forceinline__ void scale(f32x4 (&acc)[2][2][4][2], const pg8::Unit& u, int wr, int wc, int fr_, int fq_, int goff, bool store) const {
        int fr = fr_, fq = fq_; asm volatile("" : "+v"(fr), "+v"(fq));
        const int row0 = NMETA + 256 * u.pm + 64 * wr + fr, col0 = 256 * u.pn + 32 * wc + 8 * fq;
        u32x4 gv[2][4][2];
#pragma unroll
        for (int ai = 0; ai < 2; ++ai)
#pragma unroll
            for (int m = 0; m < 4; ++m)
#pragma unroll
                for (int bj = 0; bj < 2; ++bj) gv[ai][m][bj] = *(const u32x4*)(gate + (size_t)(row0 + 128 * ai + 16 * m) * 2048 + goff + col0 + 128 * bj);
        asm volatile("s_waitcnt vmcnt(0)" ::: "memory");
#pragma unroll
        for (int ai = 0; ai < 2; ++ai)
#pragma unroll
            for (int m = 0; m < 4; ++m)
#pragma unroll
                for (int bj = 0; bj < 2; ++bj) {
                    const u32x4 g = gv[ai][m][bj];
                    u32x4 o;
#pragma unroll
                    for (int n = 0; n < 2; ++n) {
                        f32x4 y = acc[ai][bj][m][n];
                        y[0] *= bflo(g[2 * n]); y[1] *= bfhi(g[2 * n]); y[2] *= bflo(g[2 * n + 1]); y[3] *= bfhi(g[2 * n + 1]);
                        if (store) { o[2 * n] = pack2bf(y[0], y[1]); o[2 * n + 1] = pack2bf(y[2], y[3]); }
                        else acc[ai][bj][m][n] = y;
                    }
                    if (store) *(u32x4*)(mixed + (size_t)(row0 + 128 * ai + 16 * m) * D + col0 + 128 * bj) = o;
                }
    }
    __device__ __forceinline__ void mid(f32x4 (&acc)[2][2][4][2], const pg8::Unit& u, int wr, int wc, int fr, int fq) const { scale(acc, u, wr, wc, fr, fq, 0, false); }
    __device__ __forceinline__ void operator()(const f32x4 (&acc)[2][2][4][2], const pg8::Unit& u, int wr, int wc, int fr, int fq) const {
        scale(const_cast<f32x4 (&)[2][2][4][2]>(acc), u, wr, wc, fr, fq, 1024, true);
    }
};
__device__ void phase_gemm2(const Params& p, LAS char* sm) {
    OrderMN S; S.c = blockIdx.x; S.G = gridDim.x; S.n = 4;
    EpiP3 E{(const bf16_t*)(p.ws + WS_GATE), (bf16_t*)(p.ws + WS_MIXED)};
    pg8::Gemm g{(const bf16_t*)(p.ws + WS_CO) + (size_t)NMETA * D, (const bf16_t*)(p.ws + WS_W2), D};
    pg8::gemm_phase((LAS unsigned char*)sm, g, S, E);
}

struct EpiP4 {
    static constexpr bool HAS_MID = false;
    const bf16_t* hb; bf16_t* h2b; float* ssp;
    __device__ __forceinline__ void operator()(const f32x4 (&acc)[2][2][4][2], const pg8::Unit& u, int wr, int wc, int fr_, int fq_) const {
        int fr = fr_, fq = fq_; asm volatile("" : "+v"(fr), "+v"(fq));
        const int col0 = 256 * u.pn + 32 * wc + 8 * fq;
        const int tok0 = 256 * u.pm + 64 * wr + fr;
#pragma unroll
        for (int ai = 0; ai < 2; ++ai) {
            u32x4 hv[4][2];
#pragma unroll
            for (int m = 0; m < 4; ++m)
#pragma unroll
                for (int bj = 0; bj < 2; ++bj) hv[m][bj] = *(const u32x4*)(hb + (size_t)(NMETA + tok0 + 128 * ai + 16 * m) * D + col0 + 128 * bj);
            asm volatile("s_waitcnt vmcnt(0)" ::: "memory");
#pragma unroll
            for (int m = 0; m < 4; ++m) {
                const int tok = tok0 + 128 * ai + 16 * m;
                float ssq = 0.f;
#pragma unroll
                for (int bj = 0; bj < 2; ++bj) {
                    const u32x4 h = hv[m][bj];
                    u32x4 o;
#pragma unroll
                    for (int n = 0; n < 2; ++n) {
                        const f32x4 a = acc[ai][bj][m][n];
                        o[2 * n] = pack2bf(bflo(h[2 * n]) + a[0], bfhi(h[2 * n]) + a[1]); o[2 * n + 1] = pack2bf(bflo(h[2 * n + 1]) + a[2], bfhi(h[2 * n + 1]) + a[3]);
                    }
                    *(u32x4*)(h2b + (size_t)tok * D + col0 + 128 * bj) = o;
#pragma unroll
                    for (int e = 0; e < 4; ++e) { const float r0 = bflo(o[e]), r1 = bfhi(o[e]); ssq += r0 * r0 + r1 * r1; }
                }
                ssq += __shfl_xor(ssq, 16); ssq += __shfl_xor(ssq, 32);
                if (fq == 0) ssp[(size_t)tok * 16 + u.pn * 4 + wc] = ssq;
            }
        }
    }
};
__device__ void phase_gemm3(const Params& p, LAS char* sm) {
    OrderMN S; S.c = blockIdx.x; S.G = gridDim.x; S.n = 4;
    EpiP4 E{(const bf16_t*)(p.ws + WS_HB), (bf16_t*)(p.ws + WS_H2B), (float*)(p.ws + WS_SSP)};
    pg8::Gemm g{(const bf16_t*)(p.ws + WS_MIXED) + (size_t)NMETA * D, (const bf16_t*)(p.ws + WS_WO), D};
    pg8::gemm_phase((LAS unsigned char*)sm, g, S, E);
}

__device__ __forceinline__ float vmaxf(float a, float b) { float r; asm("v_max_f32 %0, %1, %2" : "=v"(r) : "v"(a), "v"(b)); return r; }
__device__ __forceinline__ float vminf(float a, float b) { float r; asm("v_min_f32 %0, %1, %2" : "=v"(r) : "v"(a), "v"(b)); return r; }
__device__ __forceinline__ void bitonic_sort16_desc(float (&a)[16]) {
#pragma unroll
    for (int k = 2; k <= 16; k <<= 1)
#pragma unroll
        for (int j = k >> 1; j > 0; j >>= 1)
#pragma unroll
            for (int i = 0; i < 16; ++i) {
                const int l = i ^ j;
                if (l > i) {
                    const bool desc = ((i & k) == 0);
                    const float x = vmaxf(a[i], a[l]), y = vminf(a[i], a[l]);
                    a[i] = desc ? x : y; a[l] = desc ? y : x;
                }
            }
}
__device__ __forceinline__ void merge_top16_desc(float (&r)[16], const float (&g)[16]) {
#pragma unroll
    for (int i = 0; i < 16; ++i) r[i] = vmaxf(r[i], g[15 - i]);
#pragma unroll
    for (int j = 8; j > 0; j >>= 1)
#pragma unroll
        for (int i = 0; i < 16; ++i) {
            const int l = i ^ j;
            if (l > i) { const float x = vmaxf(r[i], r[l]), y = vminf(r[i], r[l]); r[i] = x; r[l] = y; }
        }
}
__device__ __forceinline__ float mkkey(float f, int low, int mask) { return __int_as_float((__float_as_int(f) & ~mask) | low); }
__device__ __forceinline__ int keylow(float k, int mask) { return __float_as_int(k) & mask; }
__device__ __forceinline__ float keyval(float k, int mask) { return __int_as_float(__float_as_int(k) & ~mask); }

struct EpiP5 {
    static constexpr bool HAS_MID = false;
    bf16_t* qp;
    __device__ __forceinline__ void operator()(const f32x4 (&acc)[2][2][4][2], const pg8::Unit& u, int wr, int wc, int fr_, int fq_) const {
        int fr = fr_, fq = fq_; asm volatile("" : "+v"(fr), "+v"(fq));
#pragma unroll
        for (int ai = 0; ai < 2; ++ai)
#pragma unroll
            for (int m = 0; m < 4; ++m) {
                const int tok = 256 * u.pm + 128 * ai + 64 * wr + 16 * m + fr;
#pragma unroll
                for (int bj = 0; bj < 2; ++bj) {
                    const f32x4 v0 = acc[ai][bj][m][0], v1 = acc[ai][bj][m][1];
                    u32x4 o; o[0] = pack2h(v0[0], v0[1]); o[1] = pack2h(v0[2], v0[3]); o[2] = pack2h(v1[0], v1[1]); o[3] = pack2h(v1[2], v1[3]);
                    *(u32x4*)(qp + (size_t)tok * 2048 + 256 * u.pn + 128 * bj + 32 * wc + 8 * fq) = o;
                }
            }
    }
};

__device__ void route_unit(const Params& p, LAS char* sm, int pm, int head) {
    const int tid = tid_opaque();
    const bf16_t* sc = (const bf16_t*)(p.ws + WS_QP);
    int* pidx = (int*)(p.ws + WS_PIDX);
    float* pgate = (float*)(p.ws + WS_PGATE);
    const int row = tid & 255, part = tid >> 8;
    u32x4 sv[2][8];
#pragma unroll
    for (int half = 0; half < 2; ++half)
#pragma unroll
        for (int q = 0; q < 8; ++q) sv[half][q] = *(const u32x4*)(sc + (size_t)(256 * pm + row) * 2048 + head * 256 + half * 128 + part * 64 + 8 * q);
    f32x4 ssv[4];
    { const float* sp = (const float*)(p.ws + WS_SSP) + (size_t)(256 * pm + row) * 16;
#pragma unroll
      for (int q = 0; q < 4; ++q) ssv[q] = *(const f32x4*)(sp + 4 * q); }
    float keep0[16];
#pragma unroll
    for (int half = 0; half < 2; ++half) {
        float run[16];
#pragma unroll
        for (int g = 0; g < 4; ++g) {
            float grp[16];
#pragma unroll
            for (int q = 0; q < 2; ++q)
#pragma unroll
                for (int e = 0; e < 4; ++e) {
                    const unsigned w = sv[half][2 * g + q][e];
                    const int c0 = part * 64 + 16 * g + 8 * q + 2 * e;
                    grp[8 * q + 2 * e] = mkkey((float)__builtin_bit_cast(_Float16, (unsigned short)(w & 0xFFFFu)), c0, 127);
                    grp[8 * q + 2 * e + 1] = mkkey((float)__builtin_bit_cast(_Float16, (unsigned short)(w >> 16)), c0 + 1, 127);
                }
            bitonic_sort16_desc(grp);
            if (g == 0) {
#pragma unroll
                for (int i = 0; i < 16; ++i) run[i] = grp[i];
            } else merge_top16_desc(run, grp);
        }
        LAS float* myrow = (LAS float*)(sm + row * 512);
        if (part == 1) {
#pragma unroll
            for (int i = 0; i < 16; ++i) myrow[i] = run[i];
        }
        __syncthreads();
        if (part == 0) {
            float oth[16];
#pragma unroll
            for (int i = 0; i < 16; ++i) oth[i] = myrow[i];
            merge_top16_desc(run, oth);
            if (half == 0) {
#pragma unroll
                for (int i = 0; i < 16; ++i) keep0[i] = run[i];
            } else {
#pragma unroll
                for (int i = 0; i < 16; ++i) { myrow[32 + i] = keep0[i]; myrow[48 + i] = run[i]; }
            }
        }
        if (half == 1) {
            __syncthreads();
            float v1[16], v2[16];
#pragma unroll
            for (int i = 0; i < 16; ++i) { v1[i] = keyval(myrow[32 + i], 127); v2[i] = keyval(myrow[48 + i], 127); }
#define CKEY(I, J) mkkey(v1[I] + v2[J], 16 * (I) + (J), 255)
            float res[16];
            if (part == 0) {
#pragma unroll
                for (int j = 0; j < 16; ++j) res[j] = CKEY(0, j);
                float g1[16];
#pragma unroll
                for (int j = 0; j < 8; ++j) g1[j] = CKEY(1, j);
#pragma unroll
                for (int j = 0; j < 5; ++j) g1[8 + j] = CKEY(2, j);
#pragma unroll
                for (int j = 0; j < 3; ++j) g1[13 + j] = CKEY(3, j);
                bitonic_sort16_desc(g1);
                merge_top16_desc(res, g1);
            } else {
                res[0] = CKEY(3, 3);
#pragma unroll
                for (int j = 0; j < 3; ++j) res[1 + j] = CKEY(4, j);
#pragma unroll
                for (int i = 5; i < 8; ++i) { res[4 + 2 * (i - 5)] = CKEY(i, 0); res[5 + 2 * (i - 5)] = CKEY(i, 1); }
#pragma unroll
                for (int i = 8; i < 14; ++i) res[10 + (i - 8)] = CKEY(i, 0);
                bitonic_sort16_desc(res);
                float g2[16];
                const float c14 = CKEY(14, 0), c15 = CKEY(15, 0);
                g2[0] = vmaxf(c14, c15); g2[1] = vminf(c14, c15);
#pragma unroll
                for (int i = 2; i < 16; ++i) g2[i] = -3.0e38f;
                merge_top16_desc(res, g2);
#pragma unroll
                for (int i = 0; i < 16; ++i) myrow[16 + i] = res[i];
            }
#undef CKEY
            __syncthreads();
            if (part == 0) {
                float oth2[16];
#pragma unroll
                for (int i = 0; i < 16; ++i) oth2[i] = myrow[16 + i];
                merge_top16_desc(res, oth2);
                float sc2;
                {
                    const f32x4 st = (ssv[0] + ssv[1]) + (ssv[2] + ssv[3]);
                    sc2 = rsqrtf((st[0] + st[1] + st[2] + st[3]) * (1.f / D) + EPS);
                    if (head == 0) ((float*)(p.ws + WS_RSTD2))[256 * pm + row] = sc2;
                }
                float bv[16]; float mx = -3.0e38f;
#pragma unroll
                for (int k = 0; k < 16; ++k) { bv[k] = keyval(res[k], 255) * sc2; mx = fmaxf(mx, bv[k]); }
                float se = 0.f;
#pragma unroll
                for (int k = 0; k < 16; ++k) { bv[k] = __expf(bv[k] - mx); se += bv[k]; }
                const float inv = 1.f / se;
                const size_t ob = ((size_t)(256 * pm + row)) * 128 + head * 16;
#pragma unroll
                for (int k4 = 0; k4 < 4; ++k4) {
                    i32x4 id; f32x4 gv;
#pragma unroll
                    for (int e = 0; e < 4; ++e) {
                        const int code = keylow(res[k4 * 4 + e], 255);
                        id[e] = keylow(myrow[32 + (code >> 4)], 127) * NKEYS + keylow(myrow[48 + (code & 15)], 127);
                        gv[e] = bv[k4 * 4 + e] * inv;
                    }
                    *(i32x4*)(pidx + ob + k4 * 4) = id;
                    *(f32x4*)(pgate + ob + k4 * 4) = gv;
                }
            }
        }
        __syncthreads();
    }
}
__device__ void phase_route(const Params& p, LAS char* sm) {
    OrderMN S; S.c = blockIdx.x; S.G = gridDim.x; S.n = 8;
    EpiP5 E{(bf16_t*)(p.ws + WS_QP)};
    pg8::Gemm g{(const bf16_t*)(p.ws + WS_H2B), (const bf16_t*)(p.ws + WS_WQ), D};
    pg8::gemm_phase((LAS unsigned char*)sm, g, S, E);
    asm volatile("s_waitcnt vmcnt(0)" ::: "memory");
    __syncthreads();
    pg8::Unit u;
    for (int i = 0; S.next(i, u); ++i) route_unit(p, sm, u.pm, u.pn);
}

__device__ __forceinline__ float gelu_exact(float x) { return 0.5f * x * (1.f + erff(x * 0.70710678118654752f)); }

template <int CTRL> __device__ __forceinline__ float dpp_maxf(float v) { return fmaxf(v, __int_as_float(__builtin_amdgcn_update_dpp(0, __float_as_int(v), CTRL, 0xF, 0xF, true))); }
template <int CTRL> __device__ __forceinline__ int dpp_i(int v) { return __builtin_amdgcn_update_dpp(0, v, CTRL, 0xF, 0xF, true); }
__device__ void phase_peer_u(const Params& p, LAS char* sm) {
    const int tid = tid_opaque(), lane = tid & 63, wid = tid >> 6, g = lane >> 3, l7 = lane & 7;
    const int sl = blockIdx.x & 7, gw = (blockIdx.x >> 3) * NWV + wid, nw = (gridDim.x >> 3) * NWV;
    const int* pidx = (const int*)(p.ws + WS_PIDX);
    const unsigned char* ubase = p.ws + WS_UB + (size_t)sl * 16384 * 128;
    const bf16_t* h2b = (const bf16_t*)(p.ws + WS_H2B);
    float* part = (float*)(p.ws + WS_PART);
    const unsigned cofs = 16 * l7;
    const bool b4 = l7 & 4, b2 = l7 & 2, b1 = l7 & 1;
    const int K = SEQ / nw;
#define PU_LOAD_IDS(T) { idsN2 = *(const i32x2*)(pidx + (size_t)(T) * 128 + 2 * lane); xN = *(const unsigned*)(h2b + (size_t)(T) * D + 128 * sl + 2 * lane); }
#define PU_GATHER(UR, XQ, ISX, T) { i32x4 idsN[4]; \
        const float x0 = bflo(xN), x1 = bfhi(xN); \
        float am = fmaxf(fabsf(x0), fabsf(x1)); \
        am = dpp_maxf<0xB1>(am); am = dpp_maxf<0x4E>(am); am = dpp_maxf<0x124>(am); am = dpp_maxf<0x128>(am); \
        { const int ai = __float_as_int(am); am = fmaxf(fmaxf(__int_as_float(__builtin_amdgcn_readlane(ai, 0)), __int_as_float(__builtin_amdgcn_readlane(ai, 16))), fmaxf(__int_as_float(__builtin_amdgcn_readlane(ai, 32)), __int_as_float(__builtin_amdgcn_readlane(ai, 48)))); } \
        const float sx = am > 0.f ? 127.f * __builtin_amdgcn_rcpf(am) : 0.f; ISX = am * (1.f / 127.f); \
        const int q0 = __float2int_rn(x0 * sx), q1 = __float2int_rn(x1 * sx); \
        *(LAS i32x2*)(wslot + 8 * lane) = idsN2; *(LAS unsigned short*)(wslot + 512 + 2 * lane) = (unsigned short)((q0 & 255) | ((q1 & 255) << 8)); \
        __builtin_amdgcn_wave_barrier(); asm volatile("s_waitcnt lgkmcnt(0)" ::: "memory"); \
        _Pragma("unroll") for (int q = 0; q < 4; ++q) idsN[q] = *(LAS i32x4*)(wslot + 64 * g + 16 * q); \
        XQ = *(LAS u32x4*)(wslot + 512 + 16 * l7); \
        asm volatile("s_waitcnt lgkmcnt(0)" ::: "memory"); __builtin_amdgcn_wave_barrier(); \
        _Pragma("unroll") for (int i = 0; i < 16; ++i) UR[i] = *(const u32x4*)(ubase + (size_t)(((unsigned)idsN[i >> 2][i & 3] << 7) + cofs)); \
        }
#define PU_COMPUTE(UR, XQ, ISX, T) { \
        int a[16]; \
        _Pragma("unroll") for (int i = 0; i < 16; ++i) { int s4 = 0; \
            _Pragma("unroll") for (int c = 0; c < 4; ++c) s4 = __builtin_amdgcn_sdot4((int)UR[i][c], (int)XQ[c], s4, false); \
            a[i] = s4; } \
        int r8[8], r4[4], r2[2]; \
        _Pragma("unroll") for (int q = 0; q < 8; ++q) { const int keep = b4 ? a[q + 8] : a[q], send = b4 ? a[q] : a[q + 8]; r8[q] = keep + dpp_i<0x141>(send); }     \
        _Pragma("unroll") for (int q = 0; q < 4; ++q) { const int keep = b2 ? r8[q + 4] : r8[q], send = b2 ? r8[q] : r8[q + 4]; r4[q] = keep + dpp_i<0x4E>(send); }     \
        _Pragma("unroll") for (int q = 0; q < 2; ++q) { const int keep = b1 ? r4[q + 2] : r4[q], send = b1 ? r4[q] : r4[q + 2]; r2[q] = keep + dpp_i<0xB1>(send); }     \
        f32x2 o; o[0] = (float)r2[0] * ISX; o[1] = (float)r2[1] * ISX; \
        *(f32x2*)(part + ((size_t)sl * SEQ + (T)) * 128 + 2 * lane) = o; }
    i32x2 idsN2; unsigned xN; u32x4 urA[16], urB[16]; u32x4 xqA, xqB; float isA, isB;
    LAS char* wslot = sm + wid * 1024;
    PU_LOAD_IDS(gw);
    PU_GATHER(urA, xqA, isA, gw);
    PU_LOAD_IDS(gw + nw);
#pragma unroll 1
    for (int k = 0; k < K; k += 2) {
        const int t0 = gw + k * nw, t1 = t0 + nw, t2 = t1 + nw, t3 = t2 + nw;
        PU_GATHER(urB, xqB, isB, t1);
        if (k + 2 < K) PU_LOAD_IDS(t2);
        PU_COMPUTE(urA, xqA, isA, t0);
        if (k + 2 < K) { PU_GATHER(urA, xqA, isA, t2); PU_LOAD_IDS(t3); }
        PU_COMPUTE(urB, xqB, isB, t1);
    }
#undef PU_LOAD_IDS
#undef PU_GATHER
#undef PU_COMPUTE
}

__device__ void phase_peer_coef(const Params& p) {
    const int tid = tid_opaque();
    const int* pidx = (const int*)(p.ws + WS_PIDX);
    const float* pgate = (const float*)(p.ws + WS_PGATE);
    const float* scu = (const float*)(p.ws + WS_SCU);
    const float* scv = (const float*)(p.ws + WS_SCV);
    const float* part = (const float*)(p.ws + WS_PART);
    const float* rstd2 = (const float*)(p.ws + WS_RSTD2);
    float* coef = (float*)(p.ws + WS_COEF);
    const size_t stride = (size_t)gridDim.x * NT, total = (size_t)SEQ * 64;
    for (size_t i0 = (size_t)blockIdx.x * NT + tid; i0 < total; i0 += 4 * stride) {
        i32x2 id2[4]; f32x2 gt[4], s[4]; float rs[4], su[4][2], sv[4][2];
#pragma unroll
        for (int j = 0; j < 4; ++j) {
            const size_t i = i0 + j * stride;
            if (i < total) {
                id2[j] = *(const i32x2*)(pidx + i * 2); gt[j] = *(const f32x2*)(pgate + i * 2); rs[j] = rstd2[i >> 6];
                f32x2 acc = (f32x2){0.f, 0.f};
#pragma unroll
                for (int q = 0; q < 8; ++q) acc += *(const f32x2*)(part + (size_t)q * SEQ * 128 + i * 2);
                s[j] = acc;
            } else { id2[j] = (i32x2){0, 0}; gt[j] = (f32x2){0.f, 0.f}; s[j] = (f32x2){0.f, 0.f}; rs[j] = 0.f; }
        }
#pragma unroll
        for (int j = 0; j < 4; ++j) { su[j][0] = scu[id2[j][0]]; su[j][1] = scu[id2[j][1]]; sv[j][0] = scv[id2[j][0]]; sv[j][1] = scv[id2[j][1]]; }
#pragma unroll
        for (int j = 0; j < 4; ++j) {
            const size_t i = i0 + j * stride;
            if (i < total) {
                f32x2 c2; c2[0] = gt[j][0] * sv[j][0] * gelu_exact(s[j][0] * su[j][0] * rs[j]); c2[1] = gt[j][1] * sv[j][1] * gelu_exact(s[j][1] * su[j][1] * rs[j]);
                *(f32x2*)(coef + i * 2) = c2;
            }
        }
    }
}

__device__ void phase_peer_v(const Params& p, LAS char* sm) {
    const int tid = tid_opaque(), lane = tid & 63, wid = tid >> 6, g = lane >> 3, l7 = lane & 7;
    const int sl = blockIdx.x & 7, gw = (blockIdx.x >> 3) * NWV + wid, nw = (gridDim.x >> 3) * NWV;
    const int* pidx = (const int*)(p.ws + WS_PIDX);
    const float* coef = (const float*)(p.ws + WS_COEF);
    const unsigned char* vb = p.ws + WS_VB;
    const bf16_t* h2b = (const bf16_t*)(p.ws + WS_H2B);
    const int colbase = 128 * sl + 16 * l7;
    const unsigned char* vbs = vb + (size_t)sl * 16384 * 128 + 16 * l7;
    const bool h32 = lane & 32, h16 = lane & 16, h8 = lane & 8;
    const int K = SEQ / nw;
#define PV_LOAD_IDS(T) { idsN2 = *(const i32x2*)(pidx + (size_t)(T) * 128 + 2 * lane); cfN2 = *(const f32x2*)(coef + (size_t)(T) * 128 + 2 * lane); }
#define PV_GATHER(VR, HV, CF, T) { i32x4 idsN[4]; *(LAS i32x2*)(wslot + 8 * lane) = idsN2; *(LAS f32x2*)(wslot + 512 + 8 * lane) = cfN2; __builtin_amdgcn_wave_barrier(); asm volatile("s_waitcnt lgkmcnt(0)" ::: "memory"); \
        _Pragma("unroll") for (int q = 0; q < 4; ++q) { idsN[q] = *(LAS i32x4*)(wslot + 64 * g + 16 * q); CF[q] = *(LAS f32x4*)(wslot + 512 + 64 * g + 16 * q); } \
        asm volatile("s_waitcnt lgkmcnt(0)" ::: "memory"); __builtin_amdgcn_wave_barrier(); \
        _Pragma("unroll") for (int i = 0; i < 16; ++i) VR[i] = *(const u32x4*)(vbs + (size_t)idsN[i >> 2][i & 3] * 128); \
        HV = *(const unsigned*)(h2b + (size_t)(T) * D + colbase + 2 * g); }
#define PV_COMPUTE(VR, HV, CF, T) { \
        f32x2 o2[8]; _Pragma("unroll") for (int c = 0; c < 8; ++c) o2[c] = (f32x2){0.f, 0.f}; \
        _Pragma("unroll") for (int i = 0; i < 16; ++i) { const f32x2 cv = (f32x2){CF[i >> 2][i & 3], CF[i >> 2][i & 3]}; \
            _Pragma("unroll") for (int c = 0; c < 4; ++c) { const f32x2 lo = __builtin_amdgcn_cvt_pk_f32_fp8((int)VR[i][c], false), hi = __builtin_amdgcn_cvt_pk_f32_fp8((int)VR[i][c], true); \
                o2[2 * c] += cv * lo; o2[2 * c + 1] += cv * hi; } } \
        float a[16]; _Pragma("unroll") for (int c = 0; c < 8; ++c) { a[2 * c] = o2[c][0]; a[2 * c + 1] = o2[c][1]; } \
        float r8[8], r4[4], r2[2]; \
        _Pragma("unroll") for (int q = 0; q < 8; ++q) { const float keep = h32 ? a[q + 8] : a[q], send = h32 ? a[q] : a[q + 8]; r8[q] = keep + __shfl_xor(send, 32); } \
        _Pragma("unroll") for (int q = 0; q < 4; ++q) { const float keep = h16 ? r8[q + 4] : r8[q], send = h16 ? r8[q] : r8[q + 4]; r4[q] = keep + __shfl_xor(send, 16); } \
        _Pragma("unroll") for (int q = 0; q < 2; ++q) { const float keep = h8 ? r4[q + 2] : r4[q], send = h8 ? r4[q] : r4[q + 2]; r2[q] = keep + __shfl_xor(send, 8); } \
        f32x2 hv; hv[0] = bflo(HV) + r2[0]; hv[1] = bfhi(HV) + r2[1]; \
        *(f32x2*)(p.out + (size_t)(T) * D + colbase + 2 * g) = hv; }
    i32x2 idsN2; f32x2 cfN2; f32x4 cfA[4], cfB[4]; u32x4 vrA[16], vrB[16]; unsigned hA, hB;
    LAS char* wslot = sm + wid * 1024;
    PV_LOAD_IDS(gw);
    PV_GATHER(vrA, hA, cfA, gw);
    PV_LOAD_IDS(gw + nw);
#pragma unroll 1
    for (int k = 0; k < K; k += 2) {
        const int t0 = gw + k * nw, t1 = t0 + nw, t2 = t1 + nw, t3 = t2 + nw;
        PV_GATHER(vrB, hB, cfB, t1);
        if (k + 2 < K) PV_LOAD_IDS(t2);
        PV_COMPUTE(vrA, hA, cfA, t0);
        if (k + 2 < K) { PV_GATHER(vrA, hA, cfA, t2); PV_LOAD_IDS(t3); }
        PV_COMPUTE(vrB, hB, cfB, t1);
    }
#undef PV_LOAD_IDS
#undef PV_GATHER
#undef PV_COMPUTE
}

__global__ void __launch_bounds__(NT, 2) fwd_kernel(Params p) {
    __shared__ __attribute__((aligned(16))) char smem[LDS_BYTES + 16];
    LAS char* sm = (LAS char*)smem;
    volatile LAS unsigned* st = (volatile LAS unsigned*)(sm + LDS_BYTES);
    if (threadIdx.x == 0) { st[0] = 0u; st[1] = 0u; st[2] = 0u; st[3] = 0u; }
    __syncthreads();
    const XcdBarrier xb = xcd_barrier_post((unsigned*)p.ws, st);
#ifndef PROBE_DOUBLE
#define PROBE_DOUBLE 0
#endif
#define RUN_PHASE(K, CALL) \
    if (p.ph_lo <= (K) && (K) < p.ph_hi) { \
        const int nrep = 1 + ((PROBE_DOUBLE >> (K)) & 1); \
        _Pragma("unroll 1") for (int rep = 0; rep < nrep; ++rep) { \
            if (rep > 0) { xcd_barrier(xb); if (blockIdx.x == 0 && threadIdx.x == 0) __hip_atomic_store((unsigned*)p.ws + CTR_MIX, 0u, __ATOMIC_RELAXED, __HIP_MEMORY_SCOPE_AGENT); xcd_barrier(xb); } \
            CALL; \
        } \
        if ((K) + 1 < p.ph_hi) { xcd_barrier(xb); } \
    }
    RUN_PHASE(0, phase_prep(p, sm))
    RUN_PHASE(1, phase_gemm1(p, sm))
    RUN_PHASE(2, phase_mixers(p, sm))
    RUN_PHASE(3, phase_gemm2(p, sm))
    RUN_PHASE(4, phase_gemm3(p, sm))
    RUN_PHASE(5, phase_route(p, sm))
    RUN_PHASE(6, phase_peer_u(p, sm))
    RUN_PHASE(7, phase_peer_coef(p))
    RUN_PHASE(8, phase_peer_v(p, sm))
#undef RUN_PHASE
}

extern "C" void kernel_launch(void* const* d_in, const int* in_sizes, int n_in, void* d_out, int out_size, void* d_ws, size_t ws_size, hipStream_t stream) {
    static int grid = 0;
    if (grid == 0) {
        int dev = 0, cus = 0, per_cu = 0;
        (void)hipGetDevice(&dev);
        (void)hipDeviceGetAttribute(&cus, hipDeviceAttributeMultiprocessorCount, dev);
        (void)hipOccupancyMaxActiveBlocksPerMultiprocessor(&per_cu, (const void*)fwd_kernel, NT, 0);
        grid = (per_cu >= 1) ? (cus / 8) * 8 : -1;
        if (grid <= 0) fprintf(stderr, "kernel_launch: occupancy query says the kernel does not fit (%d)\n", per_cu);
        if (ws_size < WS_END) { fprintf(stderr, "kernel_launch: workspace too small: %zu < %zu\n", ws_size, (size_t)WS_END); grid = -1; }
    }
    if (grid < 0) return;
    Params p{};
    const float* const* in = (const float* const*)d_in;
    p.x = in[0]; p.meta = in[1]; p.norm1_g = in[2]; p.w_in = in[3]; p.conv_w = in[4]; p.conv_b = in[5]; p.conv_ln_g = in[6]; p.conv_ln_b = in[7];
    p.w_conv_out = in[8]; p.q_norm_g = in[9]; p.k_norm_g = in[10]; p.w_sb_out = in[11]; p.w_gate = in[12]; p.b_gate = in[13]; p.w_o = in[14];
    p.norm2_g = in[15]; p.peer_wq = in[16]; p.peer_k1 = in[17]; p.peer_k2 = in[18]; p.peer_u = in[19]; p.peer_v = in[20];
    p.out = (float*)d_out; p.ws = (unsigned char*)d_ws;
    (void)hipMemsetAsync(d_ws, 0, 16384, stream);
#if MULTI_LAUNCH
    for (int ph = 0; ph < 9; ++ph) {
        p.ph_lo = ph; p.ph_hi = ph + 1;
        hipLaunchKernelGGL(fwd_kernel, dim3(grid), dim3(NT), 0, stream, p);
    }
#else
    p.ph_lo = 0; p.ph_hi = 9;
    void* args[] = {&p};
    hipError_t e = hipLaunchCooperativeKernel((const void*)fwd_kernel, dim3(grid), dim3(NT), args, 0, stream);
    if (e != hipSuccess) fprintf(stderr, "cooperative launch failed: %s (grid %d)\n", hipGetErrorString(e), grid);
#endif
}
```

```cpp
#include <hip/hip_runtime.h>
#include <hip/hip_cooperative_groups.h>
#include <cstdio>
#include <cstdint>
#include <type_traits>
namespace cg = cooperative_groups;

#ifndef MULTI_LAUNCH
#define MULTI_LAUNCH 0
#endif

#define LAS __attribute__((address_space(3)))
#define GAS __attribute__((address_space(1)))
typedef unsigned short bf16_t;
typedef short bf16x8 __attribute__((ext_vector_type(8)));
typedef _Float16 f16x8 __attribute__((ext_vector_type(8)));
typedef float f32x4 __attribute__((ext_vector_type(4)));
typedef float f32x2 __attribute__((ext_vector_type(2)));
typedef unsigned u32x4 __attribute__((ext_vector_type(4)));
typedef unsigned u32x2 __attribute__((ext_vector_type(2)));
typedef int i32x4 __attribute__((ext_vector_type(4)));
typedef int i32x2 __attribute__((ext_vector_type(2)));

constexpr int D = 1024, SEQ = 16384, NMETA = 16, LTOK = SEQ + NMETA, LP2 = 16640;
constexpr int CONVC = 512, CONVW = 31, NH = 8, DH = 64, INC = 2560;
constexpr int PH = 8, NKEYS = 128;
constexpr float EPS = 1e-6f;
constexpr int NT = 512, NWV = 8;
constexpr int LDS_MAIN = 131072, LDS_BYTES = LDS_MAIN + 4096;

constexpr size_t TS = 524288;
constexpr size_t WS_RSTD1 = 16384;
constexpr size_t WS_RSTD2 = WS_RSTD1 + 131072;
constexpr size_t WS_SCU   = WS_RSTD2 + 65536;
constexpr size_t WS_SCV   = WS_SCU + 65536;
constexpr size_t WS_K1    = WS_SCV + 65536;
constexpr size_t WS_K2    = WS_K1 + 262144;
constexpr size_t WS_SSP   = WS_K2 + 262144;
constexpr size_t WS_WCAT  = 4 * TS;
constexpr size_t WS_WVT   = WS_WCAT + 16 * TS;
constexpr size_t WS_W2    = WS_WVT + 2 * TS;
constexpr size_t WS_WO    = WS_W2 + 4 * TS;
constexpr size_t WS_WQ    = WS_WO + 4 * TS;
constexpr size_t WS_HB    = WS_WQ + 8 * TS;
constexpr size_t WS_GATE  = WS_HB + 65 * TS;
constexpr size_t WS_GLU   = WS_GATE + 130 * TS;
constexpr size_t WS_Q     = WS_GLU + (size_t)LP2 * 512 * 2;
constexpr size_t WS_K     = WS_Q + (size_t)LP2 * 512 * 2;
constexpr size_t WS_VT    = WS_K + (size_t)LP2 * 512 * 2;
constexpr size_t WS_CO    = WS_VT + (size_t)LP2 * 512 * 2;
constexpr size_t WS_MIXED = WS_K;
constexpr size_t WS_H2B   = WS_GLU;
constexpr size_t WS_QP    = WS_K;
constexpr size_t WS_PART  = WS_K;
constexpr size_t WS_COEF  = WS_HB;
constexpr size_t WS_PIDX  = WS_GATE;
constexpr size_t WS_PGATE = WS_PIDX + (size_t)SEQ * 128 * 4;
constexpr size_t WS_UB    = WS_CO + (size_t)LP2 * 1024 * 2;
constexpr size_t WS_VB    = WS_UB + (size_t)16384 * 1024;
constexpr size_t WS_END   = WS_VB + (size_t)16384 * 1024;
static_assert(WS_SSP + (size_t)SEQ * 16 * 4 <= WS_WCAT, "small region overflow");
static_assert((size_t)SEQ * 2048 * 2 <= (size_t)LP2 * 512 * 2 * 2 + (size_t)LP2 * 1024 * 2, "qp does not fit");
static_assert((size_t)8 * SEQ * 128 * 4 <= (size_t)LP2 * 512 * 2 * 4, "part does not fit");
constexpr int TILE_WCAT = (int)(WS_WCAT / TS), TILE_WVT = (int)(WS_WVT / TS), TILE_HB = (int)(WS_HB / TS);
constexpr int CTR_MIX = 8, CTR_CONV = 9;

struct Params {
    const float* x; const float* meta; const float* norm1_g; const float* w_in; const float* conv_w; const float* conv_b;
    const float* conv_ln_g; const float* conv_ln_b; const float* w_conv_out; const float* q_norm_g; const float* k_norm_g;
    const float* w_sb_out; const float* w_gate; const float* b_gate; const float* w_o; const float* norm2_g;
    const float* peer_wq; const float* peer_k1; const float* peer_k2; const float* peer_u; const float* peer_v;
    float* out; unsigned char* ws;
    int ph_lo, ph_hi;
};

typedef float pk_f32x2 __attribute__((ext_vector_type(2)));
typedef __bf16 pk_bf16x2 __attribute__((ext_vector_type(2)));
typedef _Float16 pk_f16x2 __attribute__((ext_vector_type(2)));
__device__ __forceinline__ unsigned pack2bf(float lo, float hi) { pk_f32x2 v = {lo, hi}; return __builtin_bit_cast(unsigned, __builtin_convertvector(v, pk_bf16x2)); }
__device__ __forceinline__ unsigned pack2h(float lo, float hi) { pk_f32x2 v = {lo, hi}; return __builtin_bit_cast(unsigned, __builtin_convertvector(v, pk_f16x2)); }
__device__ __forceinline__ float bflo(unsigned u) { return __uint_as_float(u << 16); }
__device__ __forceinline__ float bfhi(unsigned u) { return __uint_as_float(u & 0xFFFF0000u); }
__device__ __forceinline__ float wave_sum(float v) {
#pragma unroll
    for (int o = 32; o > 0; o >>= 1) v += __shfl_xor(v, o);
    return v;
}
__device__ __forceinline__ float wave_max(float v) {
#pragma unroll
    for (int o = 32; o > 0; o >>= 1) v = fmaxf(v, __shfl_xor(v, o));
    return v;
}
__device__ __forceinline__ float sigmoidf_(float x) { return 1.f / (1.f + __expf(-x)); }
__device__ __forceinline__ int tid_opaque() { int t = threadIdx.x; asm volatile("" : "+v"(t)); return t; }
__device__ __forceinline__ int tswz(int r, int c) { return r * 512 + ((((c >> 2) ^ r) & 31) << 4) + ((c & 3) << 2); }

#define XB_TMO      128
#define XB_XCNT(j)  (256  + 64 * (j))
#define XB_XSUB(j)  (1280 + 64 * (j))
#define XB_XGEN(j)  (2304 + 64 * (j))
#define XB_TOP      3328
#define XB_TOPGEN   3392
#define XCD_BAR_WORDS 3456
#define XB_SPIN_CAP (1u << 20)
__device__ __forceinline__ unsigned xb_ld(unsigned* p)              { return __hip_atomic_load(p, __ATOMIC_RELAXED, __HIP_MEMORY_SCOPE_AGENT); }
__device__ __forceinline__ unsigned xb_add(unsigned* p, unsigned v) { return __hip_atomic_fetch_add(p, v, __ATOMIC_RELAXED, __HIP_MEMORY_SCOPE_AGENT); }
__device__ __forceinline__ unsigned xb_xcc_id() { return (unsigned)__builtin_amdgcn_s_getreg((3 << 11) | 20) & 0xFu; }
#define XB_SPIN(cond, bar) do { unsigned _sp = 0; while (cond) { __builtin_amdgcn_s_sleep(1); \
    if ((++_sp & 255u) == 0u) { if (xb_ld(&(bar)[XB_TMO])) break; if (_sp > XB_SPIN_CAP) { atomicAdd(&(bar)[XB_TMO], 1u); break; } } } } while (0)
struct XcdBarrier { unsigned* bar; unsigned x; volatile LAS unsigned* st; };
__device__ __forceinline__ XcdBarrier xcd_barrier_post(unsigned* bar, volatile LAS unsigned* st) {
    XcdBarrier b; b.bar = bar; b.x = xb_xcc_id(); b.st = st;
    if (threadIdx.x == 0) (void)xb_add(&bar[XB_XCNT(b.x)], 1u);
    return b;
}
__device__ __forceinline__ void xcd_barrier_complete(unsigned* bar, unsigned x, unsigned& nloc, unsigned& nx) {
    const unsigned G = gridDim.x * gridDim.y * gridDim.z;
    unsigned sum, cnt, mine, sp = 0u;
    for (;;) {
        sum = 0u; cnt = 0u; mine = 0u;
#pragma unroll
        for (unsigned j = 0; j < 16; ++j) { const unsigned c = xb_ld(&bar[XB_XCNT(j)]); sum += c; cnt += (c > 0u) ? 1u : 0u; mine = (j == x) ? c : mine; }
        if (sum == G) break;
        __builtin_amdgcn_s_sleep(1);
        if ((++sp & 255u) == 0u) { if (xb_ld(&bar[XB_TMO])) break; if (sp > XB_SPIN_CAP) { atomicAdd(&bar[XB_TMO], 1u); break; } }
    }
    nloc = mine > 0u ? mine : 1u; nx = cnt > 0u ? cnt : 1u;
}
__device__ __forceinline__ void xcd_barrier(const XcdBarrier& b) {
    asm volatile("s_waitcnt vmcnt(0)" ::: "memory");
    __syncthreads();
    if (threadIdx.x == 0) {
        unsigned* bar = b.bar;
        __builtin_amdgcn_s_waitcnt(0);
        unsigned nloc = b.st[0], nx = b.st[1];
        if (nloc == 0u) { xcd_barrier_complete(bar, b.x, nloc, nx); b.st[0] = nloc; b.st[1] = nx; }
        const unsigned old = xb_add(&bar[XB_XSUB(b.x)], 1u);
        const unsigned gen = old / nloc;
        if (old + 1u == (gen + 1u) * nloc) {
            __builtin_amdgcn_fence(__ATOMIC_RELEASE, "agent");
            asm volatile("s_waitcnt vmcnt(0)" ::: "memory");
            const unsigned og = xb_add(&bar[XB_TOP], 1u);
            const unsigned tg = og / nx;
            if (og + 1u == (tg + 1u) * nx) xb_add(&bar[XB_TOPGEN], 1u);
            else XB_SPIN(xb_ld(&bar[XB_TOPGEN]) == tg, bar);
            __builtin_amdgcn_fence(__ATOMIC_ACQUIRE, "agent");
            xb_add(&bar[XB_XGEN(b.x)], 1u);
            asm volatile("s_waitcnt vmcnt(0)" ::: "memory");
        } else {
            XB_SPIN(xb_ld(&bar[XB_XGEN(b.x)]) == gen, bar);
            __builtin_amdgcn_fence(__ATOMIC_ACQUIRE, "agent");
            asm volatile("s_waitcnt vmcnt(0)" ::: "memory");
        }
    }
    __syncthreads();
}

namespace pg8 {
constexpr int BM = 256, BK = 64, HALF = 128, HTB = HALF * BK * 2, STAGE_BYTES = 8 * HTB;
__host__ __device__ __forceinline__ int lds_byte(int r, int c) { const int st = (r >> 4) * 2 + (c >> 5), rr = r & 15, cc = c & 31, ob = rr * 64 + cc * 2; return st * 1024 + (ob ^ (((ob >> 9) & 1) << 5)); }
__host__ __device__ __forceinline__ void stage_rc(int b, int& R, int& C) { const int st = b / 1024, sb = b % 1024, swz = sb ^ (((sb >> 9) & 1) << 5); R = (st >> 1) * 16 + swz / 64; C = (st & 1) * 32 + (swz % 64) / 2; }
__host__ __device__ __forceinline__ int perm32(int rho) { const int n = rho >> 4, i = rho & 15; return 8 * (i >> 2) + 4 * n + (i & 3); }
struct Unit { int pm, pn; };
struct Gemm { const bf16_t* A; const bf16_t* Bt; int K; };

template <class Epi, class Sched>
__device__ __forceinline__ void gemm_phase(LAS unsigned char* lds, const Gemm g, const Sched& S, const Epi& E) {
    const int tid = threadIdx.x, wid = __builtin_amdgcn_readfirstlane(tid >> 6), lane = tid & 63, wr = wid >> 2, wc = wid & 3, fr = lane & 15, fq = lane >> 4;
    const int K = g.K, nt = K / BK;
    unsigned voffA[2], voffB[2];
#pragma unroll
    for (int i = 0; i < 2; ++i) { int R, C; stage_rc(tid * 16 + i * 8192, R, C); const int Rb = (R & ~31) + perm32(R & 31);
        voffA[i] = (unsigned)(R * K + C) * 2u; voffB[i] = (unsigned)(Rb * K + C) * 2u; }
    const size_t kstep = (size_t)(BK * 2);
    const size_t hstep = (size_t)HALF * K * 2;
    const size_t tstep = 2 * hstep;
    const unsigned ldsw = (unsigned)wid * 1024u;
    const int aoff = lds_byte(wr * 64 + fr, fq * 8), boff = lds_byte(wc * 32 + fr, fq * 8);
#define PG8_SA(b, h) (((b) * 2 + (h)) * HTB)
#define PG8_SB(b, h) ((4 + (b) * 2 + (h)) * HTB)
#define PG8_STAGE(bufoff, gbase, voff) do { _Pragma("unroll") for (int _i = 0; _i < 2; ++_i) \
        __builtin_amdgcn_global_load_lds((const GAS unsigned*)((const char*)(gbase) + (voff)[_i]), (LAS unsigned*)(lds + (bufoff) + ldsw + _i * 8192), 16, 0, 0); } while (0)
#define PG8_LDA(dst, b, h) do { _Pragma("unroll") for (int m = 0; m < 4; ++m) _Pragma("unroll") for (int k = 0; k < 2; ++k) dst[m][k] = *(const LAS bf16x8*)(lds + PG8_SA(b, h) + aoff + m * 2048 + k * 1024); } while (0)
#define PG8_LDB(dst, b, h) do { _Pragma("unroll") for (int n = 0; n < 2; ++n) _Pragma("unroll") for (int k = 0; k < 2; ++k) dst[n][k] = *(const LAS bf16x8*)(lds + PG8_SB(b, h) + boff + n * 2048 + k * 1024); } while (0)
#define PG8_MMA(ai, bj, At, Bt) do { __builtin_amdgcn_s_setprio(1); _Pragma("unroll") for (int m = 0; m < 4; ++m) _Pragma("unroll") for (int n = 0; n < 2; ++n) _Pragma("unroll") for (int k = 0; k < 2; ++k) \
        acc[ai][bj][m][n] = __builtin_amdgcn_mfma_f32_16x16x32_bf16(Bt[n][k], At[m][k], acc[ai][bj][m][n], 0, 0, 0); __builtin_amdgcn_s_setprio(0); } while (0)
#define PG8_WAIT_V(n) asm volatile("s_waitcnt vmcnt(" #n ")" ::: "memory")
#define PG8_WAIT_L(n) asm volatile("s_waitcnt lgkmcnt(" #n ")" ::: "memory")
#define PG8_BAR __builtin_amdgcn_s_barrier()
#define PG8_SCHED __builtin_amdgcn_sched_barrier(0)
    Unit cur, nxt; int ui = 0;
    if (!S.next(0, cur)) return;
    f32x4 acc[2][2][4][2];
#pragma unroll
    for (int a = 0; a < 2; ++a)
#pragma unroll
        for (int b = 0; b < 2; ++b)
#pragma unroll
            for (int m = 0; m < 4; ++m)
#pragma unroll
                for (int n = 0; n < 2; ++n) acc[a][b][m][n] = (f32x4){0.f, 0.f, 0.f, 0.f};
    bf16x8 At[4][2], B0[2][2], B1[2][2];
    const char* cA = (const char*)g.A + (size_t)cur.pm * tstep; const char* cB = (const char*)g.Bt + (size_t)cur.pn * tstep;
    PG8_STAGE(PG8_SB(0, 0), cB, voffB); PG8_STAGE(PG8_SA(0, 0), cA, voffA); PG8_STAGE(PG8_SB(0, 1), cB + hstep, voffB); PG8_STAGE(PG8_SA(0, 1), cA + hstep, voffA);
    if (wr == 1) PG8_BAR;
    PG8_WAIT_V(4); PG8_BAR;
    PG8_STAGE(PG8_SB(1, 0), cB + kstep, voffB); PG8_STAGE(PG8_SA(1, 0), cA + kstep, voffA); PG8_STAGE(PG8_SB(1, 1), cB + hstep + kstep, voffB);
    PG8_WAIT_V(6); PG8_BAR;
    for (;;) {
        const bool has_next = S.next(ui + 1, nxt);
        const char* nA = has_next ? (const char*)g.A + (size_t)nxt.pm * tstep : cA; const char* nB = has_next ? (const char*)g.Bt + (size_t)nxt.pn * tstep : cB;
        for (int t = 0; t < nt; t += 2) {
            const bool last = (t == nt - 2);
            const char* a1 = cA + (size_t)(t + 1) * kstep;
            const char* a2 = last ? nA : cA + (size_t)(t + 2) * kstep; const char* b2 = last ? nB : cB + (size_t)(t + 2) * kstep;
            const char* a3 = a2 + kstep; const char* b3 = b2 + kstep;
            if constexpr (Epi::HAS_MID) { if (t == nt / 2) E.mid(acc, cur, wr, wc, fr, fq); }
            PG8_LDB(B0, 0, 0); PG8_SCHED; PG8_LDA(At, 0, 0); PG8_STAGE(PG8_SA(1, 1), a1 + hstep, voffA);
            PG8_WAIT_L(8); PG8_BAR; PG8_WAIT_L(0); PG8_MMA(0, 0, At, B0); PG8_BAR; PG8_SCHED;
            PG8_LDB(B1, 0, 1); PG8_STAGE(PG8_SB(0, 0), b2, voffB);
            PG8_BAR; PG8_WAIT_L(0); PG8_MMA(0, 1, At, B1); PG8_BAR;
            PG8_LDA(At, 0, 1); PG8_STAGE(PG8_SA(0, 0), a2, voffA);
            PG8_BAR; PG8_WAIT_L(0); PG8_MMA(1, 0, At, B0); PG8_BAR; PG8_SCHED;
            PG8_STAGE(PG8_SB(0, 1), b2 + hstep, voffB);
            PG8_WAIT_V(6); PG8_BAR; PG8_MMA(1, 1, At, B1); PG8_BAR;
            PG8_LDB(B0, 1, 0); PG8_SCHED; PG8_LDA(At, 1, 0); PG8_STAGE(PG8_SA(0, 1), a2 + hstep, voffA);
            PG8_WAIT_L(8); PG8_BAR; PG8_WAIT_L(0); PG8_MMA(0, 0, At, B0); PG8_BAR; PG8_SCHED;
            PG8_LDB(B1, 1, 1); PG8_STAGE(PG8_SB(1, 0), b3, voffB);
            PG8_BAR; PG8_WAIT_L(0); PG8_MMA(0, 1, At, B1); PG8_BAR;
            PG8_LDA(At, 1, 1); PG8_STAGE(PG8_SA(1, 0), a3, voffA);
            PG8_BAR; PG8_WAIT_L(0); PG8_MMA(1, 0, At, B0); PG8_BAR; PG8_SCHED;
            PG8_STAGE(PG8_SB(1, 1), b3 + hstep, voffB);
            PG8_WAIT_V(6); PG8_BAR; PG8_MMA(1, 1, At, B1); PG8_BAR;
        }
        E(acc, cur, wr, wc, fr, fq);
        if (!has_next) break;
#pragma unroll
        for (int a = 0; a < 2; ++a)
#pragma unroll
            for (int b = 0; b < 2; ++b)
#pragma unroll
                for (int m = 0; m < 4; ++m)
#pragma unroll
                    for (int n = 0; n < 2; ++n) acc[a][b][m][n] = (f32x4){0.f, 0.f, 0.f, 0.f};
        cur = nxt; cA = nA; cB = nB; ++ui;
    }
    PG8_WAIT_V(0);
    if (wr == 0) PG8_BAR;
    PG8_BAR;
#undef PG8_SA
#undef PG8_SB
#undef PG8_STAGE
#undef PG8_LDA
#undef PG8_LDB
#undef PG8_MMA
#undef PG8_WAIT_V
#undef PG8_WAIT_L
#undef PG8_BAR
#undef PG8_SCHED
}
struct LinearOrder {
    int c, G, n;
    __device__ __forceinline__ int unit_id(int i) const { return ((i * 8 + (c & 7)) * (G >> 3)) + (c >> 3); }
};
}

__device__ void convert_tables(const Params& p, LAS char* sm) {
    const int tid = tid_opaque(), lane = tid & 63, wid = tid >> 6;
    unsigned char* ub = p.ws + WS_UB; unsigned char* vb = p.ws + WS_VB;
    float* scu = (float*)(p.ws + WS_SCU); float* scv = (float*)(p.ws + WS_SCV);
    unsigned* ctr = (unsigned*)p.ws + CTR_CONV;
    LAS int* slot = (LAS int*)(sm + LDS_MAIN + 128);
    for (;;) {
        if (threadIdx.x == 0) *slot = (int)atomicAdd(ctr, 1u);
        __syncthreads();
        const int chunk = *slot;
        __syncthreads();
        if (chunk >= 2 * 16384 / 64) break;
        const int r8 = chunk * 8 + wid;
        const int row0 = r8 * 8;
        const bool isv = row0 >= 16384; const int e0 = isv ? row0 - 16384 : row0;
        const float* src = (isv ? p.peer_v : p.peer_u) + (size_t)e0 * D + 16 * lane;
        f32x4 a[8][4];
#pragma unroll
        for (int r = 0; r < 8; ++r)
#pragma unroll
            for (int i = 0; i < 4; ++i) a[r][i] = *(const f32x4*)(src + (size_t)r * D + 4 * i);
        if (!isv) {
#pragma unroll
            for (int i = 0; i < 4; ++i) { const f32x4 gg = *(const f32x4*)(p.norm2_g + 16 * lane + 4 * i);
#pragma unroll
                for (int r = 0; r < 8; ++r) a[r][i] = a[r][i] * gg; }
        }
#pragma unroll
        for (int r = 0; r < 8; ++r) {
            float am = 0.f;
#pragma unroll
            for (int i = 0; i < 4; ++i) am = fmaxf(am, fmaxf(fmaxf(fabsf(a[r][i][0]), fabsf(a[r][i][1])), fmaxf(fabsf(a[r][i][2]), fabsf(a[r][i][3]))));
            am = wave_max(am);
            u32x4 o;
            if (isv) {
                const float sc = am > 0.f ? 448.f / am : 1.f;
#pragma unroll
                for (int i = 0; i < 4; ++i) {
                    int w = 0;
                    w = __builtin_amdgcn_cvt_pk_fp8_f32(a[r][i][0] * sc, a[r][i][1] * sc, w, false);
                    w = __builtin_amdgcn_cvt_pk_fp8_f32(a[r][i][2] * sc, a[r][i][3] * sc, w, true);
                    o[i] = (unsigned)w;
                }
                *(u32x4*)(vb + ((size_t)(lane >> 3) * 16384 + (e0 + r)) * 128 + 16 * (lane & 7)) = o;
                if (lane == 0) scv[e0 + r] = am > 0.f ? am * (1.f / 448.f) : 1.f;
            } else {
                const float sc = am > 0.f ? 127.f / am : 0.f;
#pragma unroll
                for (int i = 0; i < 4; ++i) {
                    const int q0 = __float2int_rn(a[r][i][0] * sc), q1 = __float2int_rn(a[r][i][1] * sc), q2 = __float2int_rn(a[r][i][2] * sc), q3 = __float2int_rn(a[r][i][3] * sc);
                    o[i] = (unsigned)(q0 & 255) | ((unsigned)(q1 & 255) << 8) | ((unsigned)(q2 & 255) << 16) | ((unsigned)q3 << 24);
                }
                *(u32x4*)(ub + ((size_t)(lane >> 3) * 16384 + (e0 + r)) * 128 + 16 * (lane & 7)) = o;
                if (lane == 0) scu[e0 + r] = am * (1.f / 127.f);
            }
        }
    }
}
__device__ void phase_prep(const Params& p, LAS char* sm) {
    const int tid = tid_opaque(), lane = tid & 63, wid = tid >> 6;
    const int G = gridDim.x, b = blockIdx.x;
    const int gwv = b * NWV + wid, nwv = G * NWV;
    bf16_t* hb = (bf16_t*)(p.ws + WS_HB);
    float* rstd1 = (float*)(p.ws + WS_RSTD1);
    constexpr int J0 = 64 * 16, J1 = J0 + 8 * 16, J2 = J1 + 16 * 16, J3 = J2 + 16 * 16, J4 = J3;
    LAS float* T = (LAS float*)(sm + wid * 16640);
    for (int it = gwv; it < J4; it += nwv) {
        const float* src; int N, col, kt, rt, koff = 0; bf16_t* dst; const float* g = nullptr;
        if (it < J0) {
            kt = it >> 6; rt = it & 63; g = p.norm1_g; dst = (bf16_t*)(p.ws + WS_WCAT);
            const int R = rt * 64 + lane, u = R >> 8, t = R & 255;
            if (u < 4) { src = p.w_in; N = INC; col = t < 128 ? (128 * u + t) : (512 + 128 * u + t - 128); }
            else if (u < 8) { src = p.w_in; N = INC; const int head = 4 * ((u - 4) & 1) + ((t >> 5) & 3), d = 32 * (t >> 7) + 16 * ((t >> 4) & 1) + (t & 15); col = (u < 6 ? 1024 : 1536) + 64 * head + d; }
            else { src = p.w_gate; N = 2048; col = t < 128 ? (128 * (u - 8) + t) : (1024 + 128 * (u - 8) + t - 128); }
        } else if (it < J1) { const int q = it - J0; kt = q >> 3; rt = q & 7; g = p.norm1_g; dst = (bf16_t*)(p.ws + WS_WVT); src = p.w_in; N = INC; col = 2048 + rt * 64 + lane; }
        else if (it < J2) {
            const int q = it - J1; kt = q >> 4; rt = q & 15; dst = (bf16_t*)(p.ws + WS_W2); N = 1024; col = rt * 64 + lane;
            if (kt < 8) src = p.w_conv_out; else { src = p.w_sb_out; koff = -512; }
        } else if (it < J3) { const int q = it - J2; kt = q >> 4; rt = q & 15; dst = (bf16_t*)(p.ws + WS_WO); src = p.w_o; N = 1024; col = rt * 64 + lane; }
        else break;
        const int k0 = kt * 64;
        {
            float v[64];
#pragma unroll
            for (int k = 0; k < 64; ++k) v[k] = src[(size_t)(k0 + k + koff) * N + col];
#pragma unroll
            for (int k = 0; k < 64; ++k) T[k * 65 + lane] = v[k];
            __builtin_amdgcn_wave_barrier();
            asm volatile("s_waitcnt lgkmcnt(0)" ::: "memory");
            const int ko = lane & 7, nl = lane >> 3;
            f32x4 g0 = (f32x4){1.f, 1.f, 1.f, 1.f}, g1 = g0;
            if (g) { g0 = *(const f32x4*)(g + k0 + 8 * ko); g1 = *(const f32x4*)(g + k0 + 8 * ko + 4); }
#pragma unroll
            for (int nb = 0; nb < 8; ++nb) {
                const int n = nb * 8 + nl;
                float t[8];
#pragma unroll
                for (int j = 0; j < 8; ++j) t[j] = T[(8 * ko + j) * 65 + n];
                u32x4 o; o[0] = pack2bf(t[0] * g0[0], t[1] * g0[1]); o[1] = pack2bf(t[2] * g0[2], t[3] * g0[3]); o[2] = pack2bf(t[4] * g1[0], t[5] * g1[1]); o[3] = pack2bf(t[6] * g1[2], t[7] * g1[3]);
                *(u32x4*)(dst + (size_t)(rt * 64 + n) * D + k0 + 8 * ko) = o;
            }
            __builtin_amdgcn_wave_barrier();
            asm volatile("s_waitcnt lgkmcnt(0)" ::: "memory");
        }
    }
    {
        bf16_t* wf = (bf16_t*)(p.ws + WS_WQ);
        const int fr = lane & 15, fq = lane >> 4;
        for (int it = gwv; it < 128 * 64; it += nwv) {
            const int nt16 = it >> 6, kt16 = it & 63;
            const int hh = nt16 >> 3, key0 = (nt16 & 7) * 16, k0 = kt16 * 16;
            const float* ka = ((hh & 1) ? p.peer_k2 : p.peer_k1) + ((size_t)(hh >> 1) * 128 + key0 + fr) * 128 + 32 * fq;
            const float* wb = p.peer_wq + (size_t)(k0 + fr) * 2048 + hh * 128 + 32 * fq;
            f32x4 av[8], bv[8];
#pragma unroll
            for (int c = 0; c < 8; ++c) { av[c] = *(const f32x4*)(ka + 4 * c); bv[c] = *(const f32x4*)(wb + 4 * c); }
            f32x4 acc = (f32x4){0.f, 0.f, 0.f, 0.f};
#pragma unroll
            for (int st = 0; st < 32; ++st) acc = __builtin_amdgcn_mfma_f32_16x16x4f32(bv[st >> 2][st & 3], av[st >> 2][st & 3], acc, 0, 0, 0);
            const f32x4 gk = *(const f32x4*)(p.norm2_g + k0 + 4 * fq);
            u32x2 o; o[0] = pack2bf(acc[0] * gk[0], acc[1] * gk[1]); o[1] = pack2bf(acc[2] * gk[2], acc[3] * gk[3]);
            *(u32x2*)(wf + (size_t)(hh * 128 + key0 + fr) * D + k0 + 4 * fq) = o;
        }
    }
    for (int r0 = gwv; r0 < LP2; r0 += 4 * nwv) {
        f32x4 v[4][4];
#pragma unroll
        for (int r = 0; r < 4; ++r) {
            const int row = r0 + r * nwv;
            const float* src = row < NMETA ? p.meta + (size_t)row * D : (row < LTOK ? p.x + (size_t)(row - NMETA) * D : nullptr);
#pragma unroll
            for (int i = 0; i < 4; ++i) { v[r][i] = (f32x4){0.f, 0.f, 0.f, 0.f}; if (src) v[r][i] = *(const f32x4*)(src + lane * 4 + 256 * i); }
        }
#pragma unroll
        for (int r = 0; r < 4; ++r) {
            const int row = r0 + r * nwv;
            if (row < LP2) {
                float ss = 0.f;
#pragma unroll
                for (int i = 0; i < 4; ++i) {
                    ss += v[r][i][0] * v[r][i][0] + v[r][i][1] * v[r][i][1] + v[r][i][2] * v[r][i][2] + v[r][i][3] * v[r][i][3];
                    u32x2 o; o[0] = pack2bf(v[r][i][0], v[r][i][1]); o[1] = pack2bf(v[r][i][2], v[r][i][3]);
                    *(u32x2*)(hb + (size_t)row * D + lane * 4 + 256 * i) = o;
                }
                ss = wave_sum(ss);
                if (lane == 0) rstd1[row] = rsqrtf(ss * (1.f / D) + EPS);
            }
        }
    }
}

struct OrderP1 : pg8::LinearOrder {
    __device__ __forceinline__ bool next(int i, pg8::Unit& u) const {
        const int L = unit_id(i);
        if (L >= 1040 + 130) return false;
        if (L < 1040) { u.pm = TILE_HB + (L >> 4); u.pn = TILE_WCAT + (L & 15); }
        else { const int q = L - 1040; u.pm = TILE_WVT + (q & 1); u.pn = TILE_HB + (q >> 1); }
        return true;
    }
};
struct EpiP1 {
    static constexpr bool HAS_MID = false;
    const float* rstd1; bf16_t* glu; bf16_t* qo; bf16_t* ko; bf16_t* vt; bf16_t* gate; const float* qg; const float* kg; const float* bgate;
    __device__ __forceinline__ void operator()(const f32x4 (&acc)[2][2][4][2], const pg8::Unit& u, int wr, int wc, int fr_, int fq_) const {
        int fr = fr_, fq = fq_; asm volatile("" : "+v"(fr), "+v"(fq));
        if (u.pm >= TILE_WVT && u.pm < TILE_WVT + 2) {
            const int s0 = 256 * (u.pn - TILE_HB);
            f32x4 rs[2][2];
#pragma unroll
            for (int bj = 0; bj < 2; ++bj)
#pragma unroll
                for (int n = 0; n < 2; ++n) rs[bj][n] = *(const f32x4*)(rstd1 + s0 + 128 * bj + 32 * wc + 8 * fq + 4 * n);
            asm volatile("s_waitcnt vmcnt(0)" ::: "memory");
#pragma unroll
            for (int bj = 0; bj < 2; ++bj) {
                const int s = s0 + 128 * bj + 32 * wc + 8 * fq;
#pragma unroll
                for (int ai = 0; ai < 2; ++ai)
#pragma unroll
                    for (int m = 0; m < 4; ++m) {
                        const int rv = 256 * (u.pm - TILE_WVT) + 128 * ai + 64 * wr + 16 * m + fr, head = rv >> 6, d = rv & 63;
                        const f32x4 v0 = acc[ai][bj][m][0] * rs[bj][0], v1 = acc[ai][bj][m][1] * rs[bj][1];
                        u32x4 o; o[0] = pack2h(v0[0], v0[1]); o[1] = pack2h(v0[2], v0[3]); o[2] = pack2h(v1[0], v1[1]); o[3] = pack2h(v1[2], v1[3]);
                        *(u32x4*)(vt + (((size_t)head * (LP2 / 64) + (s >> 6)) * 64 + d) * 64 + (s & 63)) = o;
                    }
            }
            return;
        }
        const int pmr = u.pm - TILE_HB, un = u.pn - TILE_WCAT;
        const int row0 = 256 * pmr + 64 * wr + fr;
        float scv[2][4];
#pragma unroll
        for (int ai = 0; ai < 2; ++ai)
#pragma unroll
            for (int m = 0; m < 4; ++m) scv[ai][m] = rstd1[row0 + 128 * ai + 16 * m];
        f32x4 aux[2][2];
        if (un >= 4) {
            const bool isq = un < 6;
            const float* ap = un < 8 ? (isq ? qg : kg) : (bgate + 128 * (un - 8) + 32 * wc);
#pragma unroll
            for (int bj = 0; bj < 2; ++bj)
#pragma unroll
                for (int n = 0; n < 2; ++n) aux[bj][n] = *(const f32x4*)(ap + (un < 8 ? 32 : 1024) * bj + 8 * fq + 4 * n);
        }
        asm volatile("s_waitcnt vmcnt(0)" ::: "memory");
#pragma unroll
        for (int ai = 0; ai < 2; ++ai)
#pragma unroll
            for (int m = 0; m < 4; ++m) {
                const int row = row0 + 128 * ai + 16 * m;
                const float sc = scv[ai][m];
                if (un < 4) {
                    u32x4 o;
#pragma unroll
                    for (int n = 0; n < 2; ++n) {
                        const f32x4 a = acc[ai][0][m][n] * sc, gt = acc[ai][1][m][n] * sc;
                        o[2 * n] = pack2bf(a[0] * sigmoidf_(gt[0]), a[1] * sigmoidf_(gt[1])); o[2 * n + 1] = pack2bf(a[2] * sigmoidf_(gt[2]), a[3] * sigmoidf_(gt[3]));
                    }
                    *(u32x4*)(glu + (size_t)row * CONVC + 128 * un + 32 * wc + 8 * fq) = o;
                } else if (un < 8) {
                    const bool isq = un < 6;
                    const int head = 4 * ((un - 4) & 1) + wc;
                    float ss = 0.f;
#pragma unroll
                    for (int bj = 0; bj < 2; ++bj)
#pragma unroll
                        for (int n = 0; n < 2; ++n) { const f32x4 v = acc[ai][bj][m][n]; ss += v[0] * v[0] + v[1] * v[1] + v[2] * v[2] + v[3] * v[3]; }
                    ss += __shfl_xor(ss, 16); ss += __shfl_xor(ss, 32);
                    const float r2 = rsqrtf(ss * sc * sc * (1.f / 64.f) + EPS) * (isq ? 0.125f * 1.44269504088896341f : 1.f) * sc;
                    bf16_t* dst = (isq ? qo : ko) + ((size_t)head * LP2 + row) * DH;
#pragma unroll
                    for (int bj = 0; bj < 2; ++bj) {
                        const f32x4 v0 = acc[ai][bj][m][0] * aux[bj][0] * r2, v1 = acc[ai][bj][m][1] * aux[bj][1] * r2;
                        u32x4 o; o[0] = pack2bf(v0[0], v0[1]); o[1] = pack2bf(v0[2], v0[3]); o[2] = pack2bf(v1[0], v1[1]); o[3] = pack2bf(v1[2], v1[3]);
                        *(u32x4*)(dst + 32 * bj + 8 * fq) = o;
                    }
                } else {
                    const int col = 128 * (un - 8) + 32 * wc + 8 * fq;
                    u32x4 orat, ogs;
#pragma unroll
                    for (int n = 0; n < 2; ++n) {
                        const f32x4 vc = acc[ai][0][m][n] * sc + aux[0][n], vs = acc[ai][1][m][n] * sc + aux[1][n];
                        float rt_[4], gs_[4];
#pragma unroll
                        for (int e = 0; e < 4; ++e) { const float ec = __expf(-vc[e]), es = __expf(-vs[e]); gs_[e] = 1.f / (1.f + es); rt_[e] = (1.f + es) / (1.f + ec); }
                        orat[2 * n] = pack2bf(rt_[0], rt_[1]); orat[2 * n + 1] = pack2bf(rt_[2], rt_[3]);
                        ogs[2 * n] = pack2bf(gs_[0], gs_[1]); ogs[2 * n + 1] = pack2bf(gs_[2], gs_[3]);
                    }
                    *(u32x4*)(gate + (size_t)row * 2048 + col) = orat;
                    *(u32x4*)(gate + (size_t)row * 2048 + 1024 + col) = ogs;
                }
            }
    }
};
__device__ void phase_gemm1(const Params& p, LAS char* sm) {
    OrderP1 S; S.c = blockIdx.x; S.G = gridDim.x; S.n = 0;
    EpiP1 E{(const float*)(p.ws + WS_RSTD1), (bf16_t*)(p.ws + WS_GLU), (bf16_t*)(p.ws + WS_Q), (bf16_t*)(p.ws + WS_K), (bf16_t*)(p.ws + WS_VT), (bf16_t*)(p.ws + WS_GATE),
            p.q_norm_g, p.k_norm_g, p.b_gate};
    pg8::Gemm g{(const bf16_t*)p.ws, (const bf16_t*)p.ws, D};
    pg8::gemm_phase((LAS unsigned char*)sm, g, S, E);
    convert_tables(p, sm);
}

__device__ void conv_item(const Params& p, LAS char* sm, int item) {
    const int tid = tid_opaque(), lane = tid & 63, wid = tid >> 6;
    const bf16_t* glu = (const bf16_t*)(p.ws + WS_GLU);
    bf16_t* co = (bf16_t*)(p.ws + WS_CO);
    const int t0 = item * 32;
    {
        u32x4 v[8];
#pragma unroll
        for (int i = 0; i < 8; ++i) {
            const int c = tid + i * NT, row = c >> 6, ch = c & 63, g = t0 - 30 + row;
            v[i] = (u32x4){0u, 0u, 0u, 0u};
            if (c < 62 * 64 && g >= 0) v[i] = *(const u32x4*)(glu + (size_t)g * CONVC + ch * 8);
        }
#pragma unroll
        for (int i = 0; i < 8; ++i) {
            const int c = tid + i * NT, row = c >> 6, ch = c & 63;
            if (c < 62 * 64) *(LAS u32x4*)(sm + row * 1024 + ch * 16) = v[i];
        }
    }
    float wa[CONVW];
#pragma unroll
    for (int j = 0; j < CONVW; ++j) wa[j] = p.conv_w[j * CONVC + tid];
    const float bias = p.conv_b[tid];
    float aa[32];
#pragma unroll
    for (int r = 0; r < 32; ++r) aa[r] = bias;
    __syncthreads();
#pragma unroll
    for (int i = 0; i < 62; ++i) {
        const float xa = __uint_as_float((unsigned)(*(LAS unsigned short*)(sm + i * 1024 + tid * 2)) << 16);
#pragma unroll
        for (int r = 0; r < 32; ++r) {
            const int j = i - r;
            if (j >= 0 && j < CONVW) aa[r] += wa[j] * xa;
        }
    }
    __syncthreads();
#pragma unroll
    for (int r = 0; r < 32; ++r) *(LAS float*)(sm + (r * 516 + tid) * 4) = aa[r];
    __syncthreads();
    const f32x4 g0 = *(const f32x4*)(p.conv_ln_g + lane * 4), g1 = *(const f32x4*)(p.conv_ln_g + 256 + lane * 4);
    const f32x4 b0 = *(const f32x4*)(p.conv_ln_b + lane * 4), b1 = *(const f32x4*)(p.conv_ln_b + 256 + lane * 4);
#pragma unroll 1
    for (int rr = 0; rr < 4; ++rr) {
        const int r = wid * 4 + rr;
        f32x4 v0 = *(LAS f32x4*)(sm + (r * 516 + lane * 4) * 4), v1 = *(LAS f32x4*)(sm + (r * 516 + 256 + lane * 4) * 4);
        float s = v0[0] + v0[1] + v0[2] + v0[3] + v1[0] + v1[1] + v1[2] + v1[3];
        s = wave_sum(s);
        const float mu = s * (1.f / CONVC);
        float q = 0.f;
#pragma unroll
        for (int e = 0; e < 4; ++e) { v0[e] -= mu; v1[e] -= mu; q += v0[e] * v0[e] + v1[e] * v1[e]; }
        q = wave_sum(q);
        const float rstd = rsqrtf(q * (1.f / CONVC) + EPS);
        float y0[4], y1[4];
#pragma unroll
        for (int e = 0; e < 4; ++e) {
            float a = v0[e] * rstd * g0[e] + b0[e]; y0[e] = a * sigmoidf_(a);
            float c = v1[e] * rstd * g1[e] + b1[e]; y1[e] = c * sigmoidf_(c);
        }
        const int t = t0 + r;
        u32x2 o; o[0] = pack2bf(y0[0], y0[1]); o[1] = pack2bf(y0[2], y0[3]);
        *(u32x2*)(co + (size_t)t * D + lane * 4) = o;
        o[0] = pack2bf(y1[0], y1[1]); o[1] = pack2bf(y1[2], y1[3]);
        *(u32x2*)(co + (size_t)t * D + 256 + lane * 4) = o;
    }
    __syncthreads();
}

__device__ void attn_item(const Params& p, LAS char* sm, int head, int qb) {
    const int tid = tid_opaque(), lane = tid & 63, w = __builtin_amdgcn_readfirstlane(tid >> 6), fr = lane & 15, fq = lane >> 4;
    const bf16_t* Qh = (const bf16_t*)(p.ws + WS_Q) + (size_t)head * LP2 * DH;
    const bf16_t* Kh = (const bf16_t*)(p.ws + WS_K) + (size_t)head * LP2 * DH;
    const bf16_t* Vth = (const bf16_t*)(p.ws + WS_VT) + (size_t)head * (LP2 / 64) * 4096;
    bf16_t* og = (bf16_t*)(p.ws + WS_CO) + 512;
    LAS char* Ks = sm;
    LAS char* Vs = sm + 8192;
    LAS char* LK = sm + 16384 + w * 8192;
    LAS char* PS = LK + 4096;
    LAS float* flags = (LAS float*)(sm + LDS_MAIN);
    const int trb0 = qb * 256 + 16 * w, trb1 = trb0 + 128;
    bf16x8 qf[2][2];
#pragma unroll
    for (int nt = 0; nt < 2; ++nt)
#pragma unroll
        for (int kh = 0; kh < 2; ++kh) qf[nt][kh] = *(const bf16x8*)(Qh + (size_t)((nt ? trb1 : trb0) + fr) * DH + 32 * kh + 8 * fq);
    f32x4 oT[4][2];
#pragma unroll
    for (int i = 0; i < 4; ++i) { oT[i][0] = (f32x4){0.f, 0.f, 0.f, 0.f}; oT[i][1] = (f32x4){0.f, 0.f, 0.f, 0.f}; }
    float R[2] = {0.f, 0.f};
    const int swz = fr & 7;
    const int prow = tid >> 3, pc = (tid & 7) ^ (prow & 7);
    int kt = 4 * qb + 3;
    u32x4 kv = *(const u32x4*)(Kh + (size_t)(kt * 64 + prow) * DH + pc * 8);
    u32x4 vv = *(const u32x4*)(Vth + (size_t)kt * 4096 + prow * 64 + pc * 8);
    auto tile = [&](auto MASKED_T, auto A0_T, auto A1_T, int s0) {
        constexpr bool MASKED = decltype(MASKED_T)::value, a0 = decltype(A0_T)::value, a1 = decltype(A1_T)::value;
        f32x4 z[4][2];
#pragma unroll
        for (int i = 0; i < 4; ++i) { z[i][0] = (f32x4){0.f, 0.f, 0.f, 0.f}; z[i][1] = (f32x4){0.f, 0.f, 0.f, 0.f}; }
#pragma unroll
        for (int kh = 0; kh < 2; ++kh)
#pragma unroll
            for (int ms = 0; ms < 4; ++ms) {
                const bf16x8 kf = *(LAS bf16x8*)(Ks + (16 * ms + fr) * 128 + (((4 * kh + fq) ^ swz) << 4));
                if constexpr (a0) z[ms][0] = __builtin_amdgcn_mfma_f32_16x16x32_bf16(kf, qf[0][kh], z[ms][0], 0, 0, 0);
                if constexpr (a1) z[ms][1] = __builtin_amdgcn_mfma_f32_16x16x32_bf16(kf, qf[1][kh], z[ms][1], 0, 0, 0);
            }
        float lsum[2] = {0.f, 0.f};
#pragma unroll
        for (int ms = 0; ms < 4; ++ms)
#pragma unroll
            for (int nt = 0; nt < 2; ++nt) {
                if (!(nt ? a1 : a0)) continue;
                const int t = (nt ? trb1 : trb0) + fr;
                float lk[4];
#pragma unroll
                for (int j = 0; j < 4; ++j) {
                    const float zz = z[ms][nt][j];
                    const float sp = fmaxf(zz, 0.f) + __builtin_amdgcn_logf(1.f + __builtin_amdgcn_exp2f(-fabsf(zz)));
                    float l = -sp;
                    if (MASKED) { const int s = s0 + 16 * ms + 4 * fq + j; l = (s < t) ? l : 0.f; }
                    lk[j] = l; lsum[nt] += l;
                    z[ms][nt][j] = zz - sp;
                }
                u32x2 ph; ph[0] = pack2h(lk[0], lk[1]); ph[1] = pack2h(lk[2], lk[3]);
                *(LAS u32x2*)(LK + (16 * nt + fr) * 128 + ((((2 * ms + (fq >> 1)) ^ swz)) << 4) + (fq & 1) * 8) = ph;
            }
        __builtin_amdgcn_wave_barrier();
        asm volatile("s_waitcnt lgkmcnt(0)" ::: "memory");
        f32x4 st[4][2];
#pragma unroll
        for (int i = 0; i < 4; ++i) { st[i][0] = (f32x4){0.f, 0.f, 0.f, 0.f}; st[i][1] = (f32x4){0.f, 0.f, 0.f, 0.f}; }
#pragma unroll
        for (int kh = 0; kh < 2; ++kh) {
            f16x8 bh[2];
#pragma unroll
            for (int nt = 0; nt < 2; ++nt) if (nt ? a1 : a0) bh[nt] = *(LAS f16x8*)(LK + (16 * nt + fr) * 128 + (((4 * kh + fq) ^ swz) << 4));
#pragma unroll
            for (int ms = 0; ms < 4; ++ms) {
                if (32 * kh + 32 <= 16 * ms + 1) continue;
                f16x8 tm;
#pragma unroll
                for (int e = 0; e < 8; ++e) tm[e] = (32 * kh + 8 * fq + e > 16 * ms + fr) ? (_Float16)1.0f : (_Float16)0.0f;
                if constexpr (a0) st[ms][0] = __builtin_amdgcn_mfma_f32_16x16x32_f16(tm, bh[0], st[ms][0], 0, 0, 0);
                if constexpr (a1) st[ms][1] = __builtin_amdgcn_mfma_f32_16x16x32_f16(tm, bh[1], st[ms][1], 0, 0, 0);
            }
        }
#pragma unroll
        for (int ms = 0; ms < 4; ++ms)
#pragma unroll
            for (int nt = 0; nt < 2; ++nt) {
                if (!(nt ? a1 : a0)) continue;
                const int t = (nt ? trb1 : trb0) + fr;
                float wv[4];
#pragma unroll
                for (int j = 0; j < 4; ++j) {
                    float wj = __builtin_amdgcn_exp2f(z[ms][nt][j] + R[nt] + st[ms][nt][j]);
                    if (MASKED) { const int s = s0 + 16 * ms + 4 * fq + j; wj = (s < t) ? wj : 0.f; }
                    wv[j] = wj;
                }
                u32x2 pw; pw[0] = pack2h(wv[0], wv[1]); pw[1] = pack2h(wv[2], wv[3]);
                *(LAS u32x2*)(PS + (16 * nt + fr) * 128 + ((((2 * ms + (fq >> 1)) ^ swz)) << 4) + (fq & 1) * 8) = pw;
            }
#pragma unroll
        for (int nt = 0; nt < 2; ++nt) {
            if (!(nt ? a1 : a0)) continue;
            float tsum = lsum[nt];
            tsum += __shfl_xor(tsum, 16);
            tsum += __shfl_xor(tsum, 32);
            R[nt] += tsum;
        }
        __builtin_amdgcn_wave_barrier();
        asm volatile("s_waitcnt lgkmcnt(0)" ::: "memory");
#pragma unroll
        for (int kh = 0; kh < 2; ++kh) {
            f16x8 pf[2];
#pragma unroll
            for (int nt = 0; nt < 2; ++nt) if (nt ? a1 : a0) pf[nt] = *(LAS f16x8*)(PS + (16 * nt + fr) * 128 + (((4 * kh + fq) ^ swz) << 4));
#pragma unroll
            for (int md = 0; md < 4; ++md) {
                const f16x8 vf = *(LAS f16x8*)(Vs + (16 * md + fr) * 128 + (((4 * kh + fq) ^ swz) << 4));
                if constexpr (a0) oT[md][0] = __builtin_amdgcn_mfma_f32_16x16x32_f16(vf, pf[0], oT[md][0], 0, 0, 0);
                if constexpr (a1) oT[md][1] = __builtin_amdgcn_mfma_f32_16x16x32_f16(vf, pf[1], oT[md][1], 0, 0, 0);
            }
        }
    };
    bool done0 = false, done1 = false;
    for (; kt >= 0; --kt) {
        *(LAS u32x4*)(Ks + tid * 16) = kv;
        *(LAS u32x4*)(Vs + tid * 16) = vv;
        __syncthreads();
        if (kt > 0) {
            kv = *(const u32x4*)(Kh + (size_t)((kt - 1) * 64 + prow) * DH + pc * 8);
            vv = *(const u32x4*)(Vth + (size_t)(kt - 1) * 4096 + prow * 64 + pc * 8);
        }
        {
            const int s0 = kt * 64;
            const bool a0 = !done0 && s0 <= trb0, a1 = !done1 && s0 <= trb1;
            if (a0 || a1) {
                const bool mk = (a0 && s0 + 63 >= trb0) || (a1 && s0 + 63 >= trb1);
                if (a0 && a1) { if (mk) tile(std::true_type{}, std::true_type{}, std::true_type{}, s0); else tile(std::false_type{}, std::true_type{}, std::true_type{}, s0); }
                else if (a0) { if (mk) tile(std::true_type{}, std::true_type{}, std::false_type{}, s0); else tile(std::false_type{}, std::true_type{}, std::false_type{}, s0); }
                else { if (mk) tile(std::true_type{}, std::false_type{}, std::true_type{}, s0); else tile(std::false_type{}, std::false_type{}, std::true_type{}, s0); }
                if (a0) done0 = __int_as_float(__builtin_amdgcn_readfirstlane(__float_as_int(wave_max(R[0])))) < -127.f;
                if (a1) done1 = __int_as_float(__builtin_amdgcn_readfirstlane(__float_as_int(wave_max(R[1])))) < -127.f;
            }
        }
        const float wm = wave_max(fmaxf(R[0], R[1]));
        if (lane == 0) flags[(kt & 1) * 8 + w] = wm;
        __syncthreads();
        float m8 = flags[(kt & 1) * 8];
#pragma unroll
        for (int i = 1; i < 8; ++i) m8 = fmaxf(m8, flags[(kt & 1) * 8 + i]);
        if (m8 < -127.f) break;
    }
#pragma unroll
    for (int md = 0; md < 4; ++md)
#pragma unroll
        for (int nt = 0; nt < 2; ++nt) {
            const int t = (nt ? trb1 : trb0) + fr;
            u32x2 o; o[0] = pack2bf(oT[md][nt][0], oT[md][nt][1]); o[1] = pack2bf(oT[md][nt][2], oT[md][nt][3]);
            *(u32x2*)(og + (size_t)t * D + head * 64 + 16 * md + 4 * fq) = o;
        }
    __syncthreads();
}

__device__ void phase_mixers(const Params& p, LAS char* sm) {
    constexpr int NQB = LP2 / 256, NATT = NH * NQB, NCONV = (LTOK + 31) / 32;
    unsigned* ctr = (unsigned*)p.ws + CTR_MIX;
    LAS int* slot = (LAS int*)(sm + LDS_MAIN + 128);
    if (threadIdx.x == 0) *slot = (int)atomicAdd(ctr, 1u);
    __syncthreads();
    for (;;) {
        const int it = *slot;
        __syncthreads();
        if (it >= NATT + NCONV) break;
        unsigned nx = 0u;
        if (threadIdx.x == 0) nx = atomicAdd(ctr, 1u);
        if (it < NATT) { const int qb = NQB - 1 - it / NH, head = it % NH; attn_item(p, sm, head, qb); }
        else conv_item(p, sm, it - NATT);
        if (threadIdx.x == 0) *slot = (int)nx;
        __syncthreads();
    }
}

struct OrderMN : pg8::LinearOrder {
    __device__ __forceinline__ bool next(int i, pg8::Unit& u) const {
        const int L = unit_id(i);
        if (L >= 64 * n) return false;
        u.pm = L / n; u.pn = L % n; return true;
    }
};
struct EpiP3 {
    static constexpr bool HAS_MID = true;
    const bf16_t* gate; bf16_t* mixed;
    __device__ __forceinline__ void scale(f32x4 (&acc)[2][2][4][2], const pg8::Unit& u, int wr, int wc, int fr_, int fq_, int goff, bool store) const {
        int fr = fr_, fq = fq_; asm volatile("" : "+v"(fr), "+v"(fq));
        const int row0 = NMETA + 256 * u.pm + 64 * wr + fr, col0 = 256 * u.pn + 32 * wc + 8 * fq;
        u32x4 gv[2][4][2];
#pragma unroll
        for (int ai = 0; ai < 2; ++ai)
#pragma unroll
            for (int m = 0; m < 4; ++m)
#pragma unroll
                for (int bj = 0; bj < 2; ++bj) gv[ai][m][bj] = *(const u32x4*)(gate + (size_t)(row0 + 128 * ai + 16 * m) * 2048 + goff + col0 + 128 * bj);
        asm volatile("s_waitcnt vmcnt(0)" ::: "memory");
#pragma unroll
        for (int ai = 0; ai < 2; ++ai)
#pragma unroll
            for (int m = 0; m < 4; ++m)
#pragma unroll
                for (int bj = 0; bj < 2; ++bj) {
                    const u32x4 g = gv[ai][m][bj];
                    u32x4 o;
#pragma unroll
                    for (int n = 0; n < 2; ++n) {
                        f32x4 y = acc[ai][bj][m][n];
                        y[0] *= bflo(g[2 * n]); y[1] *= bfhi(g[2 * n]); y[2] *= bflo(g[2 * n + 1]); y[3] *= bfhi(g[2 * n + 1]);
                        if (store) { o[2 * n] = pack2bf(y[0], y[1]); o[2 * n + 1] = pack2bf(y[2], y[3]); }
                        else acc[ai][bj][m][n] = y;
                    }
                    if (store) *(u32x4*)(mixed + (size_t)(row0 + 128 * ai + 16 * m) * D + col0 + 128 * bj) = o;
                }
    }
    __device__ __forceinline__ void mid(f32x4 (&acc)[2][2][4][2], const pg8::Unit& u, int wr, int wc, int fr, int fq) const { scale(acc, u, wr, wc, fr, fq, 0, false); }
    __device__ __forceinline__ void operator()(const f32x4 (&acc)[2][2][4][2], const pg8::Unit& u, int wr, int wc, int fr, int fq) const {
        scale(const_cast<f32x4 (&)[2][2][4][2]>(acc), u, wr, wc, fr, fq, 1024, true);
    }
};
__device__ void phase_gemm2(const Params& p, LAS char* sm) {
    OrderMN S; S.c = blockIdx.x; S.G = gridDim.x; S.n = 4;
    EpiP3 E{(const bf16_t*)(p.ws + WS_GATE), (bf16_t*)(p.ws + WS_MIXED)};
    pg8::Gemm g{(const bf16_t*)(p.ws + WS_CO) + (size_t)NMETA * D, (const bf16_t*)(p.ws + WS_W2), D};
    pg8::gemm_phase((LAS unsigned char*)sm, g, S, E);
}

struct EpiP4 {
    static constexpr bool HAS_MID = false;
    const bf16_t* hb; bf16_t* h2b; float* ssp;
    __device__ __forceinline__ void operator()(const f32x4 (&acc)[2][2][4][2], const pg8::Unit& u, int wr, int wc, int fr_, int fq_) const {
        int fr = fr_, fq = fq_; asm volatile("" : "+v"(fr), "+v"(fq));
        const int col0 = 256 * u.pn + 32 * wc + 8 * fq;
        const int tok0 = 256 * u.pm + 64 * wr + fr;
#pragma unroll
        for (int ai = 0; ai < 2; ++ai) {
            u32x4 hv[4][2];
#pragma unroll
            for (int m = 0; m < 4; ++m)
#pragma unroll
                for (int bj = 0; bj < 2; ++bj) hv[m][bj] = *(const u32x4*)(hb + (size_t)(NMETA + tok0 + 128 * ai + 16 * m) * D + col0 + 128 * bj);
            asm volatile("s_waitcnt vmcnt(0)" ::: "memory");
#pragma unroll
            for (int m = 0; m < 4; ++m) {
                const int tok = tok0 + 128 * ai + 16 * m;
                float ssq = 0.f;
#pragma unroll
                for (int bj = 0; bj < 2; ++bj) {
                    const u32x4 h = hv[m][bj];
                    u32x4 o;
#pragma unroll
                    for (int n = 0; n < 2; ++n) {
                        const f32x4 a = acc[ai][bj][m][n];
                        o[2 * n] = pack2bf(bflo(h[2 * n]) + a[0], bfhi(h[2 * n]) + a[1]); o[2 * n + 1] = pack2bf(bflo(h[2 * n + 1]) + a[2], bfhi(h[2 * n + 1]) + a[3]);
                    }
                    *(u32x4*)(h2b + (size_t)tok * D + col0 + 128 * bj) = o;
#pragma unroll
                    for (int e = 0; e < 4; ++e) { const float r0 = bflo(o[e]), r1 = bfhi(o[e]); ssq += r0 * r0 + r1 * r1; }
                }
                ssq += __shfl_xor(ssq, 16); ssq += __shfl_xor(ssq, 32);
                if (fq == 0) ssp[(size_t)tok * 16 + u.pn * 4 + wc] = ssq;
            }
        }
    }
};
__device__ void phase_gemm3(const Params& p, LAS char* sm) {
    OrderMN S; S.c = blockIdx.x; S.G = gridDim.x; S.n = 4;
    EpiP4 E{(const bf16_t*)(p.ws + WS_HB), (bf16_t*)(p.ws + WS_H2B), (float*)(p.ws + WS_SSP)};
    pg8::Gemm g{(const bf16_t*)(p.ws + WS_MIXED) + (size_t)NMETA * D, (const bf16_t*)(p.ws + WS_WO), D};
    pg8::gemm_phase((LAS unsigned char*)sm, g, S, E);
}

__device__ __forceinline__ float vmaxf(float a, float b) { float r; asm("v_max_f32 %0, %1, %2" : "=v"(r) : "v"(a), "v"(b)); return r; }
__device__ __forceinline__ float vminf(float a, float b) { float r; asm("v_min_f32 %0, %1, %2" : "=v"(r) : "v"(a), "v"(b)); return r; }
__device__ __forceinline__ void bitonic_sort16_desc(float (&a)[16]) {
#pragma unroll
    for (int k = 2; k <= 16; k <<= 1)
#pragma unroll
        for (int j = k >> 1; j > 0; j >>= 1)
#pragma unroll
            for (int i = 0; i < 16; ++i) {
                const int l = i ^ j;
                if (l > i) {
                    const bool desc = ((i & k) == 0);
                    const float x = vmaxf(a[i], a[l]), y = vminf(a[i], a[l]);
                    a[i] = desc ? x : y; a[l] = desc ? y : x;
                }
            }
}
__device__ __forceinline__ void merge_top16_desc(float (&r)[16], const float (&g)[16]) {
#pragma unroll
    for (int i = 0; i < 16; ++i) r[i] = vmaxf(r[i], g[15 - i]);
#pragma unroll
    for (int j = 8; j > 0; j >>= 1)
#pragma unroll
        for (int i = 0; i < 16; ++i) {
            const int l = i ^ j;
            if (l > i) { const float x = vmaxf(r[i], r[l]), y = vminf(r[i], r[l]); r[i] = x; r[l] = y; }
        }
}
__device__ __forceinline__ float mkkey(float f, int low, int mask) { return __int_as_float((__float_as_int(f) & ~mask) | low); }
__device__ __forceinline__ int keylow(float k, int mask) { return __float_as_int(k) & mask; }
__device__ __forceinline__ float keyval(float k, int mask) { return __int_as_float(__float_as_int(k) & ~mask); }

struct EpiP5 {
    static constexpr bool HAS_MID = false;
    bf16_t* qp;
    __device__ __forceinline__ void operator()(const f32x4 (&acc)[2][2][4][2], const pg8::Unit& u, int wr, int wc, int fr_, int fq_) const {
        int fr = fr_, fq = fq_; asm volatile("" : "+v"(fr), "+v"(fq));
#pragma unroll
        for (int ai = 0; ai < 2; ++ai)
#pragma unroll
            for (int m = 0; m < 4; ++m) {
                const int tok = 256 * u.pm + 128 * ai + 64 * wr + 16 * m + fr;
#pragma unroll
                for (int bj = 0; bj < 2; ++bj) {
                    const f32x4 v0 = acc[ai][bj][m][0], v1 = acc[ai][bj][m][1];
                    u32x4 o; o[0] = pack2h(v0[0], v0[1]); o[1] = pack2h(v0[2], v0[3]); o[2] = pack2h(v1[0], v1[1]); o[3] = pack2h(v1[2], v1[3]);
                    *(u32x4*)(qp + (size_t)tok * 2048 + 256 * u.pn + 128 * bj + 32 * wc + 8 * fq) = o;
                }
            }
    }
};

__device__ void route_unit(const Params& p, LAS char* sm, int pm, int head) {
    const int tid = tid_opaque();
    const bf16_t* sc = (const bf16_t*)(p.ws + WS_QP);
    int* pidx = (int*)(p.ws + WS_PIDX);
    float* pgate = (float*)(p.ws + WS_PGATE);
    const int row = tid & 255, part = tid >> 8;
    u32x4 sv[2][8];
#pragma unroll
    for (int half = 0; half < 2; ++half)
#pragma unroll
        for (int q = 0; q < 8; ++q) sv[half][q] = *(const u32x4*)(sc + (size_t)(256 * pm + row) * 2048 + head * 256 + half * 128 + part * 64 + 8 * q);
    f32x4 ssv[4];
    { const float* sp = (const float*)(p.ws + WS_SSP) + (size_t)(256 * pm + row) * 16;
#pragma unroll
      for (int q = 0; q < 4; ++q) ssv[q] = *(const f32x4*)(sp + 4 * q); }
    float keep0[16];
#pragma unroll
    for (int half = 0; half < 2; ++half) {
        float run[16];
#pragma unroll
        for (int g = 0; g < 4; ++g) {
            float grp[16];
#pragma unroll
            for (int q = 0; q < 2; ++q)
#pragma unroll
                for (int e = 0; e < 4; ++e) {
                    const unsigned w = sv[half][2 * g + q][e];
                    const int c0 = part * 64 + 16 * g + 8 * q + 2 * e;
                    grp[8 * q + 2 * e] = mkkey((float)__builtin_bit_cast(_Float16, (unsigned short)(w & 0xFFFFu)), c0, 127);
                    grp[8 * q + 2 * e + 1] = mkkey((float)__builtin_bit_cast(_Float16, (unsigned short)(w >> 16)), c0 + 1, 127);
                }
            bitonic_sort16_desc(grp);
            if (g == 0) {
#pragma unroll
                for (int i = 0; i < 16; ++i) run[i] = grp[i];
            } else merge_top16_desc(run, grp);
        }
        LAS float* myrow = (LAS float*)(sm + row * 512);
        if (part == 1) {
#pragma unroll
            for (int i = 0; i < 16; ++i) myrow[i] = run[i];
        }
        __syncthreads();
        if (part == 0) {
            float oth[16];
#pragma unroll
            for (int i = 0; i < 16; ++i) oth[i] = myrow[i];
            merge_top16_desc(run, oth);
            if (half == 0) {
#pragma unroll
                for (int i = 0; i < 16; ++i) keep0[i] = run[i];
            } else {
#pragma unroll
                for (int i = 0; i < 16; ++i) { myrow[32 + i] = keep0[i]; myrow[48 + i] = run[i]; }
            }
        }
        if (half == 1) {
            __syncthreads();
            float v1[16], v2[16];
#pragma unroll
            for (int i = 0; i < 16; ++i) { v1[i] = keyval(myrow[32 + i], 127); v2[i] = keyval(myrow[48 + i], 127); }
#define CKEY(I, J) mkkey(v1[I] + v2[J], 16 * (I) + (J), 255)
            float res[16];
            if (part == 0) {
#pragma unroll
                for (int j = 0; j < 16; ++j) res[j] = CKEY(0, j);
                float g1[16];
#pragma unroll
                for (int j = 0; j < 8; ++j) g1[j] = CKEY(1, j);
#pragma unroll
                for (int j = 0; j < 5; ++j) g1[8 + j] = CKEY(2, j);
#pragma unroll
                for (int j = 0; j < 3; ++j) g1[13 + j] = CKEY(3, j);
                bitonic_sort16_desc(g1);
                merge_top16_desc(res, g1);
            } else {
                res[0] = CKEY(3, 3);
#pragma unroll
                for (int j = 0; j < 3; ++j) res[1 + j] = CKEY(4, j);
#pragma unroll
                for (int i = 5; i < 8; ++i) { res[4 + 2 * (i - 5)] = CKEY(i, 0); res[5 + 2 * (i - 5)] = CKEY(i, 1); }
#pragma unroll
                for (int i = 8; i < 14; ++i) res[10 + (i - 8)] = CKEY(i, 0);
                bitonic_sort16_desc(res);
                float g2[16];
                const float c14 = CKEY(14, 0), c15 = CKEY(15, 0);
                g2[0] = vmaxf(c14, c15); g2[1] = vminf(c14, c15);
#pragma unroll
                for (int i = 2; i < 16; ++i) g2[i] = -3.0e38f;
                merge_top16_desc(res, g2);
#pragma unroll
                for (int i = 0; i < 16; ++i) myrow[16 + i] = res[i];
            }
#undef CKEY
            __syncthreads();
            if (part == 0) {
                float oth2[16];
#pragma unroll
                for (int i = 0; i < 16; ++i) oth2[i] = myrow[16 + i];
                merge_top16_desc(res, oth2);
                float sc2;
                {
                    const f32x4 st = (ssv[0] + ssv[1]) + (ssv[2] + ssv[3]);
                    sc2 = rsqrtf((st[0] + st[1] + st[2] + st[3]) * (1.f / D) + EPS);
                    if (head == 0) ((float*)(p.ws + WS_RSTD2))[256 * pm + row] = sc2;
                }
                float bv[16]; float mx = -3.0e38f;
#pragma unroll
                for (int k = 0; k < 16; ++k) { bv[k] = keyval(res[k], 255) * sc2; mx = fmaxf(mx, bv[k]); }
                float se = 0.f;
#pragma unroll
                for (int k = 0; k < 16; ++k) { bv[k] = __expf(bv[k] - mx); se += bv[k]; }
                const float inv = 1.f / se;
                const size_t ob = ((size_t)(256 * pm + row)) * 128 + head * 16;
#pragma unroll
                for (int k4 = 0; k4 < 4; ++k4) {
                    i32x4 id; f32x4 gv;
#pragma unroll
                    for (int e = 0; e < 4; ++e) {
                        const int code = keylow(res[k4 * 4 + e], 255);
                        id[e] = keylow(myrow[32 + (code >> 4)], 127) * NKEYS + keylow(myrow[48 + (code & 15)], 127);
                        gv[e] = bv[k4 * 4 + e] * inv;
                    }
                    *(i32x4*)(pidx + ob + k4 * 4) = id;
                    *(f32x4*)(pgate + ob + k4 * 4) = gv;
                }
            }
        }
        __syncthreads();
    }
}
__device__ void phase_route(const Params& p, LAS char* sm) {
    OrderMN S; S.c = blockIdx.x; S.G = gridDim.x; S.n = 8;
    EpiP5 E{(bf16_t*)(p.ws + WS_QP)};
    pg8::Gemm g{(const bf16_t*)(p.ws + WS_H2B), (const bf16_t*)(p.ws + WS_WQ), D};
    pg8::gemm_phase((LAS unsigned char*)sm, g, S, E);
    asm volatile("s_waitcnt vmcnt(0)" ::: "memory");
    __syncthreads();
    pg8::Unit u;
    for (int i = 0; S.next(i, u); ++i) route_unit(p, sm, u.pm, u.pn);
}

__device__ __forceinline__ float gelu_exact(float x) { return 0.5f * x * (1.f + erff(x * 0.70710678118654752f)); }

template <int CTRL> __device__ __forceinline__ float dpp_maxf(float v) { return fmaxf(v, __int_as_float(__builtin_amdgcn_update_dpp(0, __float_as_int(v), CTRL, 0xF, 0xF, true))); }
template <int CTRL> __device__ __forceinline__ int dpp_i(int v) { return __builtin_amdgcn_update_dpp(0, v, CTRL, 0xF, 0xF, true); }
__device__ void phase_peer_u(const Params& p, LAS char* sm) {
    const int tid = tid_opaque(), lane = tid & 63, wid = tid >> 6, g = lane >> 3, l7 = lane & 7;
    const int sl = blockIdx.x & 7, gw = (blockIdx.x >> 3) * NWV + wid, nw = (gridDim.x >> 3) * NWV;
    const int* pidx = (const int*)(p.ws + WS_PIDX);
    const unsigned char* ubase = p.ws + WS_UB + (size_t)sl * 16384 * 128;
    const bf16_t* h2b = (const bf16_t*)(p.ws + WS_H2B);
    float* part = (float*)(p.ws + WS_PART);
    const unsigned cofs = 16 * l7;
    const bool b4 = l7 & 4, b2 = l7 & 2, b1 = l7 & 1;
    const int K = SEQ / nw;
#define PU_LOAD_IDS(T) { idsN2 = *(const i32x2*)(pidx + (size_t)(T) * 128 + 2 * lane); xN = *(const unsigned*)(h2b + (size_t)(T) * D + 128 * sl + 2 * lane); }
#define PU_GATHER(UR, XQ, ISX, T) { i32x4 idsN[4]; \
        const float x0 = bflo(xN), x1 = bfhi(xN); \
        float am = fmaxf(fabsf(x0), fabsf(x1)); \
        am = dpp_maxf<0xB1>(am); am = dpp_maxf<0x4E>(am); am = dpp_maxf<0x124>(am); am = dpp_maxf<0x128>(am); \
        { const int ai = __float_as_int(am); am = fmaxf(fmaxf(__int_as_float(__builtin_amdgcn_readlane(ai, 0)), __int_as_float(__builtin_amdgcn_readlane(ai, 16))), fmaxf(__int_as_float(__builtin_amdgcn_readlane(ai, 32)), __int_as_float(__builtin_amdgcn_readlane(ai, 48)))); } \
        const float sx = am > 0.f ? 127.f * __builtin_amdgcn_rcpf(am) : 0.f; ISX = am * (1.f / 127.f); \
        const int q0 = __float2int_rn(x0 * sx), q1 = __float2int_rn(x1 * sx); \
        *(LAS i32x2*)(wslot + 8 * lane) = idsN2; *(LAS unsigned short*)(wslot + 512 + 2 * lane) = (unsigned short)((q0 & 255) | ((q1 & 255) << 8)); \
        __builtin_amdgcn_wave_barrier(); asm volatile("s_waitcnt lgkmcnt(0)" ::: "memory"); \
        _Pragma("unroll") for (int q = 0; q < 4; ++q) idsN[q] = *(LAS i32x4*)(wslot + 64 * g + 16 * q); \
        XQ = *(LAS u32x4*)(wslot + 512 + 16 * l7); \
        asm volatile("s_waitcnt lgkmcnt(0)" ::: "memory"); __builtin_amdgcn_wave_barrier(); \
        _Pragma("unroll") for (int i = 0; i < 16; ++i) UR[i] = *(const u32x4*)(ubase + (size_t)(((unsigned)idsN[i >> 2][i & 3] << 7) + cofs)); \
        }
#define PU_COMPUTE(UR, XQ, ISX, T) { \
        int a[16]; \
        _Pragma("unroll") for (int i = 0; i < 16; ++i) { int s4 = 0; \
            _Pragma("unroll") for (int c = 0; c < 4; ++c) s4 = __builtin_amdgcn_sdot4((int)UR[i][c], (int)XQ[c], s4, false); \
            a[i] = s4; } \
        int r8[8], r4[4], r2[2]; \
        _Pragma("unroll") for (int q = 0; q < 8; ++q) { const int keep = b4 ? a[q + 8] : a[q], send = b4 ? a[q] : a[q + 8]; r8[q] = keep + dpp_i<0x141>(send); }     \
        _Pragma("unroll") for (int q = 0; q < 4; ++q) { const int keep = b2 ? r8[q + 4] : r8[q], send = b2 ? r8[q] : r8[q + 4]; r4[q] = keep + dpp_i<0x4E>(send); }     \
        _Pragma("unroll") for (int q = 0; q < 2; ++q) { const int keep = b1 ? r4[q + 2] : r4[q], send = b1 ? r4[q] : r4[q + 2]; r2[q] = keep + dpp_i<0xB1>(send); }     \
        f32x2 o; o[0] = (float)r2[0] * ISX; o[1] = (float)r2[1] * ISX; \
        *(f32x2*)(part + ((size_t)sl * SEQ + (T)) * 128 + 2 * lane) = o; }
    i32x2 idsN2; unsigned xN; u32x4 urA[16], urB[16]; u32x4 xqA, xqB; float isA, isB;
    LAS char* wslot = sm + wid * 1024;
    PU_LOAD_IDS(gw);
    PU_GATHER(urA, xqA, isA, gw);
    PU_LOAD_IDS(gw + nw);
#pragma unroll 1
    for (int k = 0; k < K; k += 2) {
        const int t0 = gw + k * nw, t1 = t0 + nw, t2 = t1 + nw, t3 = t2 + nw;
        PU_GATHER(urB, xqB, isB, t1);
        if (k + 2 < K) PU_LOAD_IDS(t2);
        PU_COMPUTE(urA, xqA, isA, t0);
        if (k + 2 < K) { PU_GATHER(urA, xqA, isA, t2); PU_LOAD_IDS(t3); }
        PU_COMPUTE(urB, xqB, isB, t1);
    }
#undef PU_LOAD_IDS
#undef PU_GATHER
#undef PU_COMPUTE
}

__device__ void phase_peer_coef(const Params& p) {
    const int tid = tid_opaque();
    const int* pidx = (const int*)(p.ws + WS_PIDX);
    const float* pgate = (const float*)(p.ws + WS_PGATE);
    const float* scu = (const float*)(p.ws + WS_SCU);
    const float* scv = (const float*)(p.ws + WS_SCV);
    const float* part = (const float*)(p.ws + WS_PART);
    const float* rstd2 = (const float*)(p.ws + WS_RSTD2);
    float* coef = (float*)(p.ws + WS_COEF);
    const size_t stride = (size_t)gridDim.x * NT, total = (size_t)SEQ * 64;
    for (size_t i0 = (size_t)blockIdx.x * NT + tid; i0 < total; i0 += 4 * stride) {
        i32x2 id2[4]; f32x2 gt[4], s[4]; float rs[4], su[4][2], sv[4][2];
#pragma unroll
        for (int j = 0; j < 4; ++j) {
            const size_t i = i0 + j * stride;
            if (i < total) {
                id2[j] = *(const i32x2*)(pidx + i * 2); gt[j] = *(const f32x2*)(pgate + i * 2); rs[j] = rstd2[i >> 6];
                f32x2 acc = (f32x2){0.f, 0.f};
#pragma unroll
                for (int q = 0; q < 8; ++q) acc += *(const f32x2*)(part + (size_t)q * SEQ * 128 + i * 2);
                s[j] = acc;
            } else { id2[j] = (i32x2){0, 0}; gt[j] = (f32x2){0.f, 0.f}; s[j] = (f32x2){0.f, 0.f}; rs[j] = 0.f; }
        }
#pragma unroll
        for (int j = 0; j < 4; ++j) { su[j][0] = scu[id2[j][0]]; su[j][1] = scu[id2[j][1]]; sv[j][0] = scv[id2[j][0]]; sv[j][1] = scv[id2[j][1]]; }
#pragma unroll
        for (int j = 0; j < 4; ++j) {
            const size_t i = i0 + j * stride;
            if (i < total) {
                f32x2 c2; c2[0] = gt[j][0] * sv[j][0] * gelu_exact(s[j][0] * su[j][0] * rs[j]); c2[1] = gt[j][1] * sv[j][1] * gelu_exact(s[j][1] * su[j][1] * rs[j]);
                *(f32x2*)(coef + i * 2) = c2;
            }
        }
    }
}

__device__ void phase_peer_v(const Params& p, LAS char* sm) {
    const int tid = tid_opaque(), lane = tid & 63, wid = tid >> 6, g = lane >> 3, l7 = lane & 7;
    const int sl = blockIdx.x & 7, gw = (blockIdx.x >> 3) * NWV + wid, nw = (gridDim.x >> 3) * NWV;
    const int* pidx = (const int*)(p.ws + WS_PIDX);
    const float* coef = (const float*)(p.ws + WS_COEF);
    const unsigned char* vb = p.ws + WS_VB;
    const bf16_t* h2b = (const bf16_t*)(p.ws + WS_H2B);
    const int colbase = 128 * sl + 16 * l7;
    const unsigned char* vbase = vb + (size_t)sl * 16384 * 128;
    const unsigned cofs = 16 * l7;
    const bool h8 = lane & 8;
    const int K = SEQ / nw;
#define PV_LOAD_IDS(T) { idsN2 = *(const i32x2*)(pidx + (size_t)(T) * 128 + 2 * lane); cfN2 = *(const f32x2*)(coef + (size_t)(T) * 128 + 2 * lane); }
#define PV_GATHER(VR, HV, CF, T) { i32x4 idsN[4]; *(LAS i32x2*)(wslot + 8 * lane) = idsN2; *(LAS f32x2*)(wslot + 512 + 8 * lane) = cfN2; __builtin_amdgcn_wave_barrier(); asm volatile("s_waitcnt lgkmcnt(0)" ::: "memory"); \
        _Pragma("unroll") for (int q = 0; q < 4; ++q) { idsN[q] = *(LAS i32x4*)(wslot + 64 * g + 16 * q); CF[q] = *(LAS f32x4*)(wslot + 512 + 64 * g + 16 * q); } \
        asm volatile("s_waitcnt lgkmcnt(0)" ::: "memory"); __builtin_amdgcn_wave_barrier(); \
        _Pragma("unroll") for (int i = 0; i < 16; ++i) VR[i] = *(const u32x4*)(vbase + (size_t)(((unsigned)idsN[i >> 2][i & 3] << 7) + cofs)); \
        HV = *(const unsigned*)(h2b + (size_t)(T) * D + colbase + 2 * g); }
#define PV_COMPUTE(VR, HV, CF, T) { \
        f32x2 o2[8]; _Pragma("unroll") for (int c = 0; c < 8; ++c) o2[c] = (f32x2){0.f, 0.f}; \
        _Pragma("unroll") for (int i = 0; i < 16; ++i) { const f32x2 cv = (f32x2){CF[i >> 2][i & 3], CF[i >> 2][i & 3]}; \
            _Pragma("unroll") for (int c = 0; c < 4; ++c) { const f32x2 lo = __builtin_amdgcn_cvt_pk_f32_fp8((int)VR[i][c], false), hi = __builtin_amdgcn_cvt_pk_f32_fp8((int)VR[i][c], true); \
                o2[2 * c] += cv * lo; o2[2 * c + 1] += cv * hi; } } \
        float a[16]; _Pragma("unroll") for (int c = 0; c < 8; ++c) { a[2 * c] = o2[c][0]; a[2 * c + 1] = o2[c][1]; } \
        float r8[8], r4[4], r2[2]; \
          \
        _Pragma("unroll") for (int q = 0; q < 8; ++q) { const u32x2 sw = __builtin_amdgcn_permlane32_swap(__float_as_uint(a[q]), __float_as_uint(a[q + 8]), false, false); r8[q] = __uint_as_float(sw[0]) + __uint_as_float(sw[1]); } \
        _Pragma("unroll") for (int q = 0; q < 4; ++q) { const u32x2 sw = __builtin_amdgcn_permlane16_swap(__float_as_uint(r8[q]), __float_as_uint(r8[q + 4]), false, false); r4[q] = __uint_as_float(sw[0]) + __uint_as_float(sw[1]); } \
        _Pragma("unroll") for (int q = 0; q < 2; ++q) { const float keep = h8 ? r4[q + 2] : r4[q], send = h8 ? r4[q] : r4[q + 2]; r2[q] = keep + __int_as_float(__builtin_amdgcn_update_dpp(0, __float_as_int(send), 0x128, 0xF, 0xF, true)); } \
        f32x2 hv; hv[0] = bflo(HV) + r2[0]; hv[1] = bfhi(HV) + r2[1]; \
        *(f32x2*)(p.out + (size_t)(T) * D + colbase + 2 * g) = hv; }
    i32x2 idsN2; f32x2 cfN2; f32x4 cfA[4], cfB[4]; u32x4 vrA[16], vrB[16]; unsigned hA, hB;
    LAS char* wslot = sm + wid * 1024;
    PV_LOAD_IDS(gw);
    PV_GATHER(vrA, hA, cfA, gw);
    PV_LOAD_IDS(gw + nw);
#pragma unroll 1
    for (int k = 0; k < K; k += 2) {
        const int t0 = gw + k * nw, t1 = t0 + nw, t2 = t1 + nw, t3 = t2 + nw;
        PV_GATHER(vrB, hB, cfB, t1);
        if (k + 2 < K) PV_LOAD_IDS(t2);
        PV_COMPUTE(vrA, hA, cfA, t0);
        if (k + 2 < K) { PV_GATHER(vrA, hA, cfA, t2); PV_LOAD_IDS(t3); }
        PV_COMPUTE(vrB, hB, cfB, t1);
    }
#undef PV_LOAD_IDS
#undef PV_GATHER
#undef PV_COMPUTE
}

__global__ void __launch_bounds__(NT, 2) fwd_kernel(Params p) {
    __shared__ __attribute__((aligned(16))) char smem[LDS_BYTES + 16];
    LAS char* sm = (LAS char*)smem;
    volatile LAS unsigned* st = (volatile LAS unsigned*)(sm + LDS_BYTES);
    if (threadIdx.x == 0) { st[0] = 0u; st[1] = 0u; st[2] = 0u; st[3] = 0u; }
    __syncthreads();
    const XcdBarrier xb = xcd_barrier_post((unsigned*)p.ws, st);
#ifndef PROBE_DOUBLE
#define PROBE_DOUBLE 0
#endif
#define RUN_PHASE(K, CALL) \
    if (p.ph_lo <= (K) && (K) < p.ph_hi) { \
        const int nrep = 1 + ((PROBE_DOUBLE >> (K)) & 1); \
        _Pragma("unroll 1") for (int rep = 0; rep < nrep; ++rep) { \
            if (rep > 0) { xcd_barrier(xb); if (blockIdx.x == 0 && threadIdx.x == 0) __hip_atomic_store((unsigned*)p.ws + CTR_MIX, 0u, __ATOMIC_RELAXED, __HIP_MEMORY_SCOPE_AGENT); xcd_barrier(xb); } \
            CALL; \
        } \
        if ((K) + 1 < p.ph_hi) { xcd_barrier(xb); } \
    }
    RUN_PHASE(0, phase_prep(p, sm))
    RUN_PHASE(1, phase_gemm1(p, sm))
    RUN_PHASE(2, phase_mixers(p, sm))
    RUN_PHASE(3, phase_gemm2(p, sm))
    RUN_PHASE(4, phase_gemm3(p, sm))
    RUN_PHASE(5, phase_route(p, sm))
    RUN_PHASE(6, phase_peer_u(p, sm))
    RUN_PHASE(7, phase_peer_coef(p))
    RUN_PHASE(8, phase_peer_v(p, sm))
#undef RUN_PHASE
}

extern "C" void kernel_launch(void* const* d_in, const int* in_sizes, int n_in, void* d_out, int out_size, void* d_ws, size_t ws_size, hipStream_t stream) {
    static int grid = 0;
    if (grid == 0) {
        int dev = 0, cus = 0, per_cu = 0;
        (void)hipGetDevice(&dev);
        (void)hipDeviceGetAttribute(&cus, hipDeviceAttributeMultiprocessorCount, dev);
        (void)hipOccupancyMaxActiveBlocksPerMultiprocessor(&per_cu, (const void*)fwd_kernel, NT, 0);
        grid = (per_cu >= 1) ? (cus / 8) * 8 : -1;
        if (grid <= 0) fprintf(stderr, "kernel_launch: occupancy query says the kernel does not fit (%d)\n", per_cu);
        if (ws_size < WS_END) { fprintf(stderr, "kernel_launch: workspace too small: %zu < %zu\n", ws_size, (size_t)WS_END); grid = -1; }
    }
    if (grid < 0) return;
    Params p{};
    const float* const* in = (const float* const*)d_in;
    p.x = in[0]; p.meta = in[1]; p.norm1_g = in[2]; p.w_in = in[3]; p.conv_w = in[4]; p.conv_b = in[5]; p.conv_ln_g = in[6]; p.conv_ln_b = in[7];
    p.w_conv_out = in[8]; p.q_norm_g = in[9]; p.k_norm_g = in[10]; p.w_sb_out = in[11]; p.w_gate = in[12]; p.b_gate = in[13]; p.w_o = in[14];
    p.norm2_g = in[15]; p.peer_wq = in[16]; p.peer_k1 = in[17]; p.peer_k2 = in[18]; p.peer_u = in[19]; p.peer_v = in[20];
    p.out = (float*)d_out; p.ws = (unsigned char*)d_ws;
    (void)hipMemsetAsync(d_ws, 0, 16384, stream);
#if MULTI_LAUNCH
    for (int ph = 0; ph < 9; ++ph) {
        p.ph_lo = ph; p.ph_hi = ph + 1;
        hipLaunchKernelGGL(fwd_kernel, dim3(grid), dim3(NT), 0, stream, p);
    }
#else
    p.ph_lo = 0; p.ph_hi = 9;
    void* args[] = {&p};
    hipError_t e = hipLaunchCooperativeKernel((const void*)fwd_kernel, dim3(grid), dim3(NT), args, 0, stream);
    if (e != hipSuccess) fprintf(stderr, "cooperative launch failed: %s (grid %d)\n", hipGetErrorString(e), grid);
#endif
}
```

```cpp
#include <hip/hip_runtime.h>
#include <hip/hip_cooperative_groups.h>
#include <cstdio>
#include <cstdint>
#include <type_traits>
namespace cg = cooperative_groups;

#ifndef MULTI_LAUNCH
#define MULTI_LAUNCH 0
#endif

#define LAS __attribute__((address_space(3)))
#define GAS __attribute__((address_space(1)))
typedef unsigned short bf16_t;
typedef short bf16x8 __attribute__((ext_vector_type(8)));
typedef _Float16 f16x8 __attribute__((ext_vector_type(8)));
typedef float f32x4 __attribute__((ext_vector_type(4)));
typedef float f32x2 __attribute__((ext_vector_type(2)));
typedef unsigned u32x4 __attribute__((ext_vector_type(4)));
typedef unsigned u32x2 __attribute__((ext_vector_type(2)));
typedef int i32x4 __attribute__((ext_vector_type(4)));
typedef int i32x2 __attribute__((ext_vector_type(2)));

constexpr int D = 1024, SEQ = 16384, NMETA = 16, LTOK = SEQ + NMETA, LP2 = 16640;
constexpr int CONVC = 512, CONVW = 31, NH = 8, DH = 64, INC = 2560;
constexpr int PH = 8, NKEYS = 128;
constexpr float EPS = 1e-6f;
constexpr int NT = 512, NWV = 8;
constexpr int LDS_MAIN = 131072, LDS_BYTES = LDS_MAIN + 4096;

constexpr size_t TS = 524288;
constexpr size_t WS_RSTD1 = 16384;
constexpr size_t WS_RSTD2 = WS_RSTD1 + 131072;
constexpr size_t WS_SCU   = WS_RSTD2 + 65536;
constexpr size_t WS_SCV   = WS_SCU + 65536;
constexpr size_t WS_K1    = WS_SCV + 65536;
constexpr size_t WS_K2    = WS_K1 + 262144;
constexpr size_t WS_SSP   = WS_K2 + 262144;
constexpr size_t WS_WCAT  = 4 * TS;
constexpr size_t WS_WVT   = WS_WCAT + 16 * TS;
constexpr size_t WS_W2    = WS_WVT + 2 * TS;
constexpr size_t WS_WO    = WS_W2 + 4 * TS;
constexpr size_t WS_WQ    = WS_WO + 4 * TS;
constexpr size_t WS_HB    = WS_WQ + 8 * TS;
constexpr size_t WS_GATE  = WS_HB + 65 * TS;
constexpr size_t WS_GLU   = WS_GATE + 130 * TS;
constexpr size_t WS_Q     = WS_GLU + (size_t)LP2 * 512 * 2;
constexpr size_t WS_K     = WS_Q + (size_t)LP2 * 512 * 2;
constexpr size_t WS_VT    = WS_K + (size_t)LP2 * 512 * 2;
constexpr size_t WS_CO    = WS_VT + (size_t)LP2 * 512 * 2;
constexpr size_t WS_MIXED = WS_K;
constexpr size_t WS_H2B   = WS_GLU;
constexpr size_t WS_QP    = WS_K;
constexpr size_t WS_PART  = WS_K;
constexpr size_t WS_COEF  = WS_HB;
constexpr size_t WS_PIDX  = WS_GATE;
constexpr size_t WS_PGATE = WS_PIDX + (size_t)SEQ * 128 * 4;
constexpr size_t WS_UB    = WS_CO + (size_t)LP2 * 1024 * 2;
constexpr size_t WS_VB    = WS_UB + (size_t)16384 * 1024;
constexpr size_t WS_END   = WS_VB + (size_t)16384 * 1024;
static_assert(WS_SSP + (size_t)SEQ * 16 * 4 <= WS_WCAT, "small region overflow");
static_assert((size_t)SEQ * 2048 * 2 <= (size_t)LP2 * 512 * 2 * 2 + (size_t)LP2 * 1024 * 2, "qp does not fit");
static_assert((size_t)8 * SEQ * 128 * 4 <= (size_t)LP2 * 512 * 2 * 4, "part does not fit");
constexpr int TILE_WCAT = (int)(WS_WCAT / TS), TILE_WVT = (int)(WS_WVT / TS), TILE_HB = (int)(WS_HB / TS);
constexpr int CTR_MIX = 8, CTR_CONV = 9;

struct Params {
    const float* x; const float* meta; const float* norm1_g; const float* w_in; const float* conv_w; const float* conv_b;
    const float* conv_ln_g; const float* conv_ln_b; const float* w_conv_out; const float* q_norm_g; const float* k_norm_g;
    const float* w_sb_out; const float* w_gate; const float* b_gate; const float* w_o; const float* norm2_g;
    const float* peer_wq; const float* peer_k1; const float* peer_k2; const float* peer_u; const float* peer_v;
    float* out; unsigned char* ws;
    int ph_lo, ph_hi;
};

typedef float pk_f32x2 __attribute__((ext_vector_type(2)));
typedef __bf16 pk_bf16x2 __attribute__((ext_vector_type(2)));
typedef _Float16 pk_f16x2 __attribute__((ext_vector_type(2)));
__device__ __forceinline__ unsigned pack2bf(float lo, float hi) { pk_f32x2 v = {lo, hi}; return __builtin_bit_cast(unsigned, __builtin_convertvector(v, pk_bf16x2)); }
__device__ __forceinline__ unsigned pack2h(float lo, float hi) { pk_f32x2 v = {lo, hi}; return __builtin_bit_cast(unsigned, __builtin_convertvector(v, pk_f16x2)); }
__device__ __forceinline__ float bflo(unsigned u) { return __uint_as_float(u << 16); }
__device__ __forceinline__ float bfhi(unsigned u) { return __uint_as_float(u & 0xFFFF0000u); }
__device__ __forceinline__ float wave_sum(float v) {
#pragma unroll
    for (int o = 32; o > 0; o >>= 1) v += __shfl_xor(v, o);
    return v;
}
__device__ __forceinline__ float wave_max(float v) {
#pragma unroll
    for (int o = 32; o > 0; o >>= 1) v = fmaxf(v, __shfl_xor(v, o));
    return v;
}
__device__ __forceinline__ float sigmoidf_(float x) { return 1.f / (1.f + __expf(-x)); }
__device__ __forceinline__ int tid_opaque() { int t = threadIdx.x; asm volatile("" : "+v"(t)); return t; }
__device__ __forceinline__ int tswz(int r, int c) { return r * 512 + ((((c >> 2) ^ r) & 31) << 4) + ((c & 3) << 2); }

#define XB_TMO      128
#define XB_XCNT(j)  (256  + 64 * (j))
#define XB_XSUB(j)  (1280 + 64 * (j))
#define XB_XGEN(j)  (2304 + 64 * (j))
#define XB_TOP      3328
#define XB_TOPGEN   3392
#define XCD_BAR_WORDS 3456
#define XB_SPIN_CAP (1u << 20)
__device__ __forceinline__ unsigned xb_ld(unsigned* p)              { return __hip_atomic_load(p, __ATOMIC_RELAXED, __HIP_MEMORY_SCOPE_AGENT); }
__device__ __forceinline__ unsigned xb_add(unsigned* p, unsigned v) { return __hip_atomic_fetch_add(p, v, __ATOMIC_RELAXED, __HIP_MEMORY_SCOPE_AGENT); }
__device__ __forceinline__ unsigned xb_xcc_id() { return (unsigned)__builtin_amdgcn_s_getreg((3 << 11) | 20) & 0xFu; }
#define XB_SPIN(cond, bar) do { unsigned _sp = 0; while (cond) { __builtin_amdgcn_s_sleep(1); \
    if ((++_sp & 255u) == 0u) { if (xb_ld(&(bar)[XB_TMO])) break; if (_sp > XB_SPIN_CAP) { atomicAdd(&(bar)[XB_TMO], 1u); break; } } } } while (0)
struct XcdBarrier { unsigned* bar; unsigned x; volatile LAS unsigned* st; };
__device__ __forceinline__ XcdBarrier xcd_barrier_post(unsigned* bar, volatile LAS unsigned* st) {
    XcdBarrier b; b.bar = bar; b.x = xb_xcc_id(); b.st = st;
    if (threadIdx.x == 0) (void)xb_add(&bar[XB_XCNT(b.x)], 1u);
    return b;
}
__device__ __forceinline__ void xcd_barrier_complete(unsigned* bar, unsigned x, unsigned& nloc, unsigned& nx) {
    const unsigned G = gridDim.x * gridDim.y * gridDim.z;
    unsigned sum, cnt, mine, sp = 0u;
    for (;;) {
        sum = 0u; cnt = 0u; mine = 0u;
#pragma unroll
        for (unsigned j = 0; j < 16; ++j) { const unsigned c = xb_ld(&bar[XB_XCNT(j)]); sum += c; cnt += (c > 0u) ? 1u : 0u; mine = (j == x) ? c : mine; }
        if (sum == G) break;
        __builtin_amdgcn_s_sleep(1);
        if ((++sp & 255u) == 0u) { if (xb_ld(&bar[XB_TMO])) break; if (sp > XB_SPIN_CAP) { atomicAdd(&bar[XB_TMO], 1u); break; } }
    }
    nloc = mine > 0u ? mine : 1u; nx = cnt > 0u ? cnt : 1u;
}
__device__ __forceinline__ void xcd_barrier(const XcdBarrier& b) {
    asm volatile("s_waitcnt vmcnt(0)" ::: "memory");
    __syncthreads();
    if (threadIdx.x == 0) {
        unsigned* bar = b.bar;
        __builtin_amdgcn_s_waitcnt(0);
        unsigned nloc = b.st[0], nx = b.st[1];
        if (nloc == 0u) { xcd_barrier_complete(bar, b.x, nloc, nx); b.st[0] = nloc; b.st[1] = nx; }
        const unsigned old = xb_add(&bar[XB_XSUB(b.x)], 1u);
        const unsigned gen = old / nloc;
        if (old + 1u == (gen + 1u) * nloc) {
            __builtin_amdgcn_fence(__ATOMIC_RELEASE, "agent");
            asm volatile("s_waitcnt vmcnt(0)" ::: "memory");
            const unsigned og = xb_add(&bar[XB_TOP], 1u);
            const unsigned tg = og / nx;
            if (og + 1u == (tg + 1u) * nx) xb_add(&bar[XB_TOPGEN], 1u);
            else XB_SPIN(xb_ld(&bar[XB_TOPGEN]) == tg, bar);
            __builtin_amdgcn_fence(__ATOMIC_ACQUIRE, "agent");
            xb_add(&bar[XB_XGEN(b.x)], 1u);
            asm volatile("s_waitcnt vmcnt(0)" ::: "memory");
        } else {
            XB_SPIN(xb_ld(&bar[XB_XGEN(b.x)]) == gen, bar);
            __builtin_amdgcn_fence(__ATOMIC_ACQUIRE, "agent");
            asm volatile("s_waitcnt vmcnt(0)" ::: "memory");
        }
    }
    __syncthreads();
}

namespace pg8 {
constexpr int BM = 256, BK = 64, HALF = 128, HTB = HALF * BK * 2, STAGE_BYTES = 8 * HTB;
__host__ __device__ __forceinline__ int lds_byte(int r, int c) { const int st = (r >> 4) * 2 + (c >> 5), rr = r & 15, cc = c & 31, ob = rr * 64 + cc * 2; return st * 1024 + (ob ^ (((ob >> 9) & 1) << 5)); }
__host__ __device__ __forceinline__ void stage_rc(int b, int& R, int& C) { const int st = b / 1024, sb = b % 1024, swz = sb ^ (((sb >> 9) & 1) << 5); R = (st >> 1) * 16 + swz / 64; C = (st & 1) * 32 + (swz % 64) / 2; }
__host__ __device__ __forceinline__ int perm32(int rho) { const int n = rho >> 4, i = rho & 15; return 8 * (i >> 2) + 4 * n + (i & 3); }
struct Unit { int pm, pn; };
struct Gemm { const bf16_t* A; const bf16_t* Bt; int K; };

template <class Epi, class Sched>
__device__ __forceinline__ void gemm_phase(LAS unsigned char* lds, const Gemm g, const Sched& S, const Epi& E) {
    const int tid = threadIdx.x, wid = __builtin_amdgcn_readfirstlane(tid >> 6), lane = tid & 63, wr = wid >> 2, wc = wid & 3, fr = lane & 15, fq = lane >> 4;
    const int K = g.K, nt = K / BK;
    unsigned voffA[2], voffB[2];
#pragma unroll
    for (int i = 0; i < 2; ++i) { int R, C; stage_rc(tid * 16 + i * 8192, R, C); const int Rb = (R & ~31) + perm32(R & 31);
        voffA[i] = (unsigned)(R * K + C) * 2u; voffB[i] = (unsigned)(Rb * K + C) * 2u; }
    const size_t kstep = (size_t)(BK * 2);
    const size_t hstep = (size_t)HALF * K * 2;
    const size_t tstep = 2 * hstep;
    const unsigned ldsw = (unsigned)wid * 1024u;
    const int aoff = lds_byte(wr * 64 + fr, fq * 8), boff = lds_byte(wc * 32 + fr, fq * 8);
#define PG8_SA(b, h) (((b) * 2 + (h)) * HTB)
#define PG8_SB(b, h) ((4 + (b) * 2 + (h)) * HTB)
#define PG8_STAGE(bufoff, gbase, voff) do { _Pragma("unroll") for (int _i = 0; _i < 2; ++_i) \
        __builtin_amdgcn_global_load_lds((const GAS unsigned*)((const char*)(gbase) + (voff)[_i]), (LAS unsigned*)(lds + (bufoff) + ldsw + _i * 8192), 16, 0, 0); } while (0)
#define PG8_LDA(dst, b, h) do { _Pragma("unroll") for (int m = 0; m < 4; ++m) _Pragma("unroll") for (int k = 0; k < 2; ++k) dst[m][k] = *(const LAS bf16x8*)(lds + PG8_SA(b, h) + aoff + m * 2048 + k * 1024); } while (0)
#define PG8_LDB(dst, b, h) do { _Pragma("unroll") for (int n = 0; n < 2; ++n) _Pragma("unroll") for (int k = 0; k < 2; ++k) dst[n][k] = *(const LAS bf16x8*)(lds + PG8_SB(b, h) + boff + n * 2048 + k * 1024); } while (0)
#define PG8_MMA(ai, bj, At, Bt) do { __builtin_amdgcn_s_setprio(1); _Pragma("unroll") for (int m = 0; m < 4; ++m) _Pragma("unroll") for (int n = 0; n < 2; ++n) _Pragma("unroll") for (int k = 0; k < 2; ++k) \
        acc[ai][bj][m][n] = __builtin_amdgcn_mfma_f32_16x16x32_bf16(Bt[n][k], At[m][k], acc[ai][bj][m][n], 0, 0, 0); __builtin_amdgcn_s_setprio(0); } while (0)
#define PG8_WAIT_V(n) asm volatile("s_waitcnt vmcnt(" #n ")" ::: "memory")
#define PG8_WAIT_L(n) asm volatile("s_waitcnt lgkmcnt(" #n ")" ::: "memory")
#define PG8_BAR __builtin_amdgcn_s_barrier()
#define PG8_SCHED __builtin_amdgcn_sched_barrier(0)
    Unit cur, nxt; int ui = 0;
    if (!S.next(0, cur)) return;
    f32x4 acc[2][2][4][2];
#pragma unroll
    for (int a = 0; a < 2; ++a)
#pragma unroll
        for (int b = 0; b < 2; ++b)
#pragma unroll
            for (int m = 0; m < 4; ++m)
#pragma unroll
                for (int n = 0; n < 2; ++n) acc[a][b][m][n] = (f32x4){0.f, 0.f, 0.f, 0.f};
    bf16x8 At[4][2], B0[2][2], B1[2][2];
    const char* cA = (const char*)g.A + (size_t)cur.pm * tstep; const char* cB = (const char*)g.Bt + (size_t)cur.pn * tstep;
    PG8_STAGE(PG8_SB(0, 0), cB, voffB); PG8_STAGE(PG8_SA(0, 0), cA, voffA); PG8_STAGE(PG8_SB(0, 1), cB + hstep, voffB); PG8_STAGE(PG8_SA(0, 1), cA + hstep, voffA);
    if (wr == 1) PG8_BAR;
    PG8_WAIT_V(4); PG8_BAR;
    PG8_STAGE(PG8_SB(1, 0), cB + kstep, voffB); PG8_STAGE(PG8_SA(1, 0), cA + kstep, voffA); PG8_STAGE(PG8_SB(1, 1), cB + hstep + kstep, voffB);
    PG8_WAIT_V(6); PG8_BAR;
    for (;;) {
        const bool has_next = S.next(ui + 1, nxt);
        const char* nA = has_next ? (const char*)g.A + (size_t)nxt.pm * tstep : cA; const char* nB = has_next ? (const char*)g.Bt + (size_t)nxt.pn * tstep : cB;
        for (int t = 0; t < nt; t += 2) {
            const bool last = (t == nt - 2);
            const char* a1 = cA + (size_t)(t + 1) * kstep;
            const char* a2 = last ? nA : cA + (size_t)(t + 2) * kstep; const char* b2 = last ? nB : cB + (size_t)(t + 2) * kstep;
            const char* a3 = a2 + kstep; const char* b3 = b2 + kstep;
            if constexpr (Epi::HAS_MID) { if (t == nt / 2) E.mid(acc, cur, wr, wc, fr, fq); }
            PG8_LDB(B0, 0, 0); PG8_SCHED; PG8_LDA(At, 0, 0); PG8_STAGE(PG8_SA(1, 1), a1 + hstep, voffA);
            PG8_WAIT_L(8); PG8_BAR; PG8_WAIT_L(0); PG8_MMA(0, 0, At, B0); PG8_BAR; PG8_SCHED;
            PG8_LDB(B1, 0, 1); PG8_STAGE(PG8_SB(0, 0), b2, voffB);
            PG8_BAR; PG8_WAIT_L(0); PG8_MMA(0, 1, At, B1); PG8_BAR;
            PG8_LDA(At, 0, 1); PG8_STAGE(PG8_SA(0, 0), a2, voffA);
            PG8_BAR; PG8_WAIT_L(0); PG8_MMA(1, 0, At, B0); PG8_BAR; PG8_SCHED;
            PG8_STAGE(PG8_SB(0, 1), b2 + hstep, voffB);
            PG8_WAIT_V(6); PG8_BAR; PG8_MMA(1, 1, At, B1); PG8_BAR;
            PG8_LDB(B0, 1, 0); PG8_SCHED; PG8_LDA(At, 1, 0); PG8_STAGE(PG8_SA(0, 1), a2 + hstep, voffA);
            PG8_WAIT_L(8); PG8_BAR; PG8_WAIT_L(0); PG8_MMA(0, 0, At, B0); PG8_BAR; PG8_SCHED;
            PG8_LDB(B1, 1, 1); PG8_STAGE(PG8_SB(1, 0), b3, voffB);
            PG8_BAR; PG8_WAIT_L(0); PG8_MMA(0, 1, At, B1); PG8_BAR;
            PG8_LDA(At, 1, 1); PG8_STAGE(PG8_SA(1, 0), a3, voffA);
            PG8_BAR; PG8_WAIT_L(0); PG8_MMA(1, 0, At, B0); PG8_BAR; PG8_SCHED;
            PG8_STAGE(PG8_SB(1, 1), b3 + hstep, voffB);
            PG8_WAIT_V(6); PG8_BAR; PG8_MMA(1, 1, At, B1); PG8_BAR;
        }
        E(acc, cur, wr, wc, fr, fq);
        if (!has_next) break;
#pragma unroll
        for (int a = 0; a < 2; ++a)
#pragma unroll
            for (int b = 0; b < 2; ++b)
#pragma unroll
                for (int m = 0; m < 4; ++m)
#pragma unroll
                    for (int n = 0; n < 2; ++n) acc[a][b][m][n] = (f32x4){0.f, 0.f, 0.f, 0.f};
        cur = nxt; cA = nA; cB = nB; ++ui;
    }
    PG8_WAIT_V(0);
    if (wr == 0) PG8_BAR;
    PG8_BAR;
#undef PG8_SA
#undef PG8_SB
#undef PG8_STAGE
#undef PG8_LDA
#undef PG8_LDB
#undef PG8_MMA
#undef PG8_WAIT_V
#undef PG8_WAIT_L
#undef PG8_BAR
#undef PG8_SCHED
}
struct LinearOrder {
    int c, G, n;
    __device__ __forceinline__ int unit_id(int i) const { return ((i * 8 + (c & 7)) * (G >> 3)) + (c >> 3); }
};
}

__device__ void convert_tables(const Params& p, LAS char* sm) {
    const int tid = tid_opaque(), lane = tid & 63, wid = tid >> 6;
    unsigned char* ub = p.ws + WS_UB; unsigned char* vb = p.ws + WS_VB;
    float* scu = (float*)(p.ws + WS_SCU); float* scv = (float*)(p.ws + WS_SCV);
    unsigned* ctr = (unsigned*)p.ws + CTR_CONV;
    LAS int* slot = (LAS int*)(sm + LDS_MAIN + 128);
    for (;;) {
        if (threadIdx.x == 0) *slot = (int)atomicAdd(ctr, 1u);
        __syncthreads();
        const int chunk = *slot;
        __syncthreads();
        if (chunk >= 2 * 16384 / 64) break;
        const int r8 = chunk * 8 + wid;
        const int row0 = r8 * 8;
        const bool isv = row0 >= 16384; const int e0 = isv ? row0 - 16384 : row0;
        const float* src = (isv ? p.peer_v : p.peer_u) + (size_t)e0 * D + 16 * lane;
        f32x4 a[8][4];
#pragma unroll
        for (int r = 0; r < 8; ++r)
#pragma unroll
            for (int i = 0; i < 4; ++i) a[r][i] = *(const f32x4*)(src + (size_t)r * D + 4 * i);
        if (!isv) {
#pragma unroll
            for (int i = 0; i < 4; ++i) { const f32x4 gg = *(const f32x4*)(p.norm2_g + 16 * lane + 4 * i);
#pragma unroll
                for (int r = 0; r < 8; ++r) a[r][i] = a[r][i] * gg; }
        }
#pragma unroll
        for (int r = 0; r < 8; ++r) {
            float am = 0.f;
#pragma unroll
            for (int i = 0; i < 4; ++i) am = fmaxf(am, fmaxf(fmaxf(fabsf(a[r][i][0]), fabsf(a[r][i][1])), fmaxf(fabsf(a[r][i][2]), fabsf(a[r][i][3]))));
            am = wave_max(am);
            u32x4 o;
            if (isv) {
                const float sc = am > 0.f ? 448.f / am : 1.f;
#pragma unroll
                for (int i = 0; i < 4; ++i) {
                    int w = 0;
                    w = __builtin_amdgcn_cvt_pk_fp8_f32(a[r][i][0] * sc, a[r][i][1] * sc, w, false);
                    w = __builtin_amdgcn_cvt_pk_fp8_f32(a[r][i][2] * sc, a[r][i][3] * sc, w, true);
                    o[i] = (unsigned)w;
                }
                *(u32x4*)(vb + ((size_t)(lane >> 3) * 16384 + (e0 + r)) * 128 + 16 * (lane & 7)) = o;
                if (lane == 0) scv[e0 + r] = am > 0.f ? am * (1.f / 448.f) : 1.f;
            } else {
                const float sc = am > 0.f ? 127.f / am : 0.f;
#pragma unroll
                for (int i = 0; i < 4; ++i) {
                    const int q0 = __float2int_rn(a[r][i][0] * sc), q1 = __float2int_rn(a[r][i][1] * sc), q2 = __float2int_rn(a[r][i][2] * sc), q3 = __float2int_rn(a[r][i][3] * sc);
                    o[i] = (unsigned)(q0 & 255) | ((unsigned)(q1 & 255) << 8) | ((unsigned)(q2 & 255) << 16) | ((unsigned)q3 << 24);
                }
                *(u32x4*)(ub + ((size_t)(lane >> 3) * 16384 + (e0 + r)) * 128 + 16 * (lane & 7)) = o;
                if (lane == 0) scu[e0 + r] = am * (1.f / 127.f);
            }
        }
    }
}
__device__ void phase_prep(const Params& p, LAS char* sm) {
    const int tid = tid_opaque(), lane = tid & 63, wid = tid >> 6;
    const int G = gridDim.x, b = blockIdx.x;
    const int gwv = b * NWV + wid, nwv = G * NWV;
    bf16_t* hb = (bf16_t*)(p.ws + WS_HB);
    float* rstd1 = (float*)(p.ws + WS_RSTD1);
    constexpr int J0 = 64 * 16, J1 = J0 + 8 * 16, J2 = J1 + 16 * 16, J3 = J2 + 16 * 16, J4 = J3;
    LAS float* T = (LAS float*)(sm + wid * 16640);
    for (int it = gwv; it < J4; it += nwv) {
        const float* src; int N, col, kt, rt, koff = 0; bf16_t* dst; const float* g = nullptr;
        if (it < J0) {
            kt = it >> 6; rt = it & 63; g = p.norm1_g; dst = (bf16_t*)(p.ws + WS_WCAT);
            const int R = rt * 64 + lane, u = R >> 8, t = R & 255;
            if (u < 4) { src = p.w_in; N = INC; col = t < 128 ? (128 * u + t) : (512 + 128 * u + t - 128); }
            else if (u < 8) { src = p.w_in; N = INC; const int head = 4 * ((u - 4) & 1) + ((t >> 5) & 3), d = 32 * (t >> 7) + 16 * ((t >> 4) & 1) + (t & 15); col = (u < 6 ? 1024 : 1536) + 64 * head + d; }
            else { src = p.w_gate; N = 2048; col = t < 128 ? (128 * (u - 8) + t) : (1024 + 128 * (u - 8) + t - 128); }
        } else if (it < J1) { const int q = it - J0; kt = q >> 3; rt = q & 7; g = p.norm1_g; dst = (bf16_t*)(p.ws + WS_WVT); src = p.w_in; N = INC; col = 2048 + rt * 64 + lane; }
        else if (it < J2) {
            const int q = it - J1; kt = q >> 4; rt = q & 15; dst = (bf16_t*)(p.ws + WS_W2); N = 1024; col = rt * 64 + lane;
            if (kt < 8) src = p.w_conv_out; else { src = p.w_sb_out; koff = -512; }
        } else if (it < J3) { const int q = it - J2; kt = q >> 4; rt = q & 15; dst = (bf16_t*)(p.ws + WS_WO); src = p.w_o; N = 1024; col = rt * 64 + lane; }
        else break;
        const int k0 = kt * 64;
        {
            float v[64];
#pragma unroll
            for (int k = 0; k < 64; ++k) v[k] = src[(size_t)(k0 + k + koff) * N + col];
#pragma unroll
            for (int k = 0; k < 64; ++k) T[k * 65 + lane] = v[k];
            __builtin_amdgcn_wave_barrier();
            asm volatile("s_waitcnt lgkmcnt(0)" ::: "memory");
            const int ko = lane & 7, nl = lane >> 3;
            f32x4 g0 = (f32x4){1.f, 1.f, 1.f, 1.f}, g1 = g0;
            if (g) { g0 = *(const f32x4*)(g + k0 + 8 * ko); g1 = *(const f32x4*)(g + k0 + 8 * ko + 4); }
#pragma unroll
            for (int nb = 0; nb < 8; ++nb) {
                const int n = nb * 8 + nl;
                float t[8];
#pragma unroll
                for (int j = 0; j < 8; ++j) t[j] = T[(8 * ko + j) * 65 + n];
                u32x4 o; o[0] = pack2bf(t[0] * g0[0], t[1] * g0[1]); o[1] = pack2bf(t[2] * g0[2], t[3] * g0[3]); o[2] = pack2bf(t[4] * g1[0], t[5] * g1[1]); o[3] = pack2bf(t[6] * g1[2], t[7] * g1[3]);
                *(u32x4*)(dst + (size_t)(rt * 64 + n) * D + k0 + 8 * ko) = o;
            }
            __builtin_amdgcn_wave_barrier();
            asm volatile("s_waitcnt lgkmcnt(0)" ::: "memory");
        }
    }
    {
        bf16_t* wf = (bf16_t*)(p.ws + WS_WQ);
        const int fr = lane & 15, fq = lane >> 4;
        for (int it = gwv; it < 128 * 64; it += nwv) {
            const int nt16 = it >> 6, kt16 = it & 63;
            const int hh = nt16 >> 3, key0 = (nt16 & 7) * 16, k0 = kt16 * 16;
            const float* ka = ((hh & 1) ? p.peer_k2 : p.peer_k1) + ((size_t)(hh >> 1) * 128 + key0 + fr) * 128 + 32 * fq;
            const float* wb = p.peer_wq + (size_t)(k0 + fr) * 2048 + hh * 128 + 32 * fq;
            f32x4 av[8], bv[8];
#pragma unroll
            for (int c = 0; c < 8; ++c) { av[c] = *(const f32x4*)(ka + 4 * c); bv[c] = *(const f32x4*)(wb + 4 * c); }
            f32x4 acc = (f32x4){0.f, 0.f, 0.f, 0.f};
#pragma unroll
            for (int st = 0; st < 32; ++st) acc = __builtin_amdgcn_mfma_f32_16x16x4f32(bv[st >> 2][st & 3], av[st >> 2][st & 3], acc, 0, 0, 0);
            const f32x4 gk = *(const f32x4*)(p.norm2_g + k0 + 4 * fq);
            u32x2 o; o[0] = pack2bf(acc[0] * gk[0], acc[1] * gk[1]); o[1] = pack2bf(acc[2] * gk[2], acc[3] * gk[3]);
            *(u32x2*)(wf + (size_t)(hh * 128 + key0 + fr) * D + k0 + 4 * fq) = o;
        }
    }
    for (int r0 = gwv; r0 < LP2; r0 += 4 * nwv) {
        f32x4 v[4][4];
#pragma unroll
        for (int r = 0; r < 4; ++r) {
            const int row = r0 + r * nwv;
            const float* src = row < NMETA ? p.meta + (size_t)row * D : (row < LTOK ? p.x + (size_t)(row - NMETA) * D : nullptr);
#pragma unroll
            for (int i = 0; i < 4; ++i) { v[r][i] = (f32x4){0.f, 0.f, 0.f, 0.f}; if (src) v[r][i] = *(const f32x4*)(src + lane * 4 + 256 * i); }
        }
#pragma unroll
        for (int r = 0; r < 4; ++r) {
            const int row = r0 + r * nwv;
            if (row < LP2) {
                float ss = 0.f;
#pragma unroll
                for (int i = 0; i < 4; ++i) {
                    ss += v[r][i][0] * v[r][i][0] + v[r][i][1] * v[r][i][1] + v[r][i][2] * v[r][i][2] + v[r][i][3] * v[r][i][3];
                    u32x2 o; o[0] = pack2bf(v[r][i][0], v[r][i][1]); o[1] = pack2bf(v[r][i][2], v[r][i][3]);
                    *(u32x2*)(hb + (size_t)row * D + lane * 4 + 256 * i) = o;
                }
                ss = wave_sum(ss);
                if (lane == 0) rstd1[row] = rsqrtf(ss * (1.f / D) + EPS);
            }
        }
    }
}

struct OrderP1 : pg8::LinearOrder {
    __device__ __forceinline__ bool next(int i, pg8::Unit& u) const {
        const int L = unit_id(i);
        if (L >= 1040 + 130) return false;
        if (L < 1040) { u.pm = TILE_HB + (L >> 4); u.pn = TILE_WCAT + (L & 15); }
        else { const int q = L - 1040; u.pm = TILE_WVT + (q & 1); u.pn = TILE_HB + (q >> 1); }
        return true;
    }
};
struct EpiP1 {
    static constexpr bool HAS_MID = false;
    const float* rstd1; bf16_t* glu; bf16_t* qo; bf16_t* ko; bf16_t* vt; bf16_t* gate; const float* qg; const float* kg; const float* bgate;
    __device__ __forceinline__ void operator()(const f32x4 (&acc)[2][2][4][2], const pg8::Unit& u, int wr, int wc, int fr_, int fq_) const {
        int fr = fr_, fq = fq_; asm volatile("" : "+v"(fr), "+v"(fq));
        if (u.pm >= TILE_WVT && u.pm < TILE_WVT + 2) {
            const int s0 = 256 * (u.pn - TILE_HB);
            f32x4 rs[2][2];
#pragma unroll
            for (int bj = 0; bj < 2; ++bj)
#pragma unroll
                for (int n = 0; n < 2; ++n) rs[bj][n] = *(const f32x4*)(rstd1 + s0 + 128 * bj + 32 * wc + 8 * fq + 4 * n);
            asm volatile("s_waitcnt vmcnt(0)" ::: "memory");
#pragma unroll
            for (int bj = 0; bj < 2; ++bj) {
                const int s = s0 + 128 * bj + 32 * wc + 8 * fq;
#pragma unroll
                for (int ai = 0; ai < 2; ++ai)
#pragma unroll
                    for (int m = 0; m < 4; ++m) {
                        const int rv = 256 * (u.pm - TILE_WVT) + 128 * ai + 64 * wr + 16 * m + fr, head = rv >> 6, d = rv & 63;
                        const f32x4 v0 = acc[ai][bj][m][0] * rs[bj][0], v1 = acc[ai][bj][m][1] * rs[bj][1];
                        u32x4 o; o[0] = pack2h(v0[0], v0[1]); o[1] = pack2h(v0[2], v0[3]); o[2] = pack2h(v1[0], v1[1]); o[3] = pack2h(v1[2], v1[3]);
                        *(u32x4*)(vt + (((size_t)head * (LP2 / 64) + (s >> 6)) * 64 + d) * 64 + (s & 63)) = o;
                    }
            }
            return;
        }
        const int pmr = u.pm - TILE_HB, un = u.pn - TILE_WCAT;
        const int row0 = 256 * pmr + 64 * wr + fr;
        float scv[2][4];
#pragma unroll
        for (int ai = 0; ai < 2; ++ai)
#pragma unroll
            for (int m = 0; m < 4; ++m) scv[ai][m] = rstd1[row0 + 128 * ai + 16 * m];
        f32x4 aux[2][2];
        if (un >= 4) {
            const bool isq = un < 6;
            const float* ap = un < 8 ? (isq ? qg : kg) : (bgate + 128 * (un - 8) + 32 * wc);
#pragma unroll
            for (int bj = 0; bj < 2; ++bj)
#pragma unroll
                for (int n = 0; n < 2; ++n) aux[bj][n] = *(const f32x4*)(ap + (un < 8 ? 32 : 1024) * bj + 8 * fq + 4 * n);
        }
        asm volatile("s_waitcnt vmcnt(0)" ::: "memory");
#pragma unroll
        for (int ai = 0; ai < 2; ++ai)
#pragma unroll
            for (int m = 0; m < 4; ++m) {
                const int row = row0 + 128 * ai + 16 * m;
                const float sc = scv[ai][m];
                if (un < 4) {
                    u32x4 o;
#pragma unroll
                    for (int n = 0; n < 2; ++n) {
                        const f32x4 a = acc[ai][0][m][n] * sc, gt = acc[ai][1][m][n] * sc;
                        o[2 * n] = pack2bf(a[0] * sigmoidf_(gt[0]), a[1] * sigmoidf_(gt[1])); o[2 * n + 1] = pack2bf(a[2] * sigmoidf_(gt[2]), a[3] * sigmoidf_(gt[3]));
                    }
                    *(u32x4*)(glu + (size_t)row * CONVC + 128 * un + 32 * wc + 8 * fq) = o;
                } else if (un < 8) {
                    const bool isq = un < 6;
                    const int head = 4 * ((un - 4) & 1) + wc;
                    float ss = 0.f;
#pragma unroll
                    for (int bj = 0; bj < 2; ++bj)
#pragma unroll
                        for (int n = 0; n < 2; ++n) { const f32x4 v = acc[ai][bj][m][n]; ss += v[0] * v[0] + v[1] * v[1] + v[2] * v[2] + v[3] * v[3]; }
                    ss += __shfl_xor(ss, 16); ss += __shfl_xor(ss, 32);
                    const float r2 = rsqrtf(ss * sc * sc * (1.f / 64.f) + EPS) * (isq ? 0.125f * 1.44269504088896341f : 1.f) * sc;
                    bf16_t* dst = (isq ? qo : ko) + ((size_t)head * LP2 + row) * DH;
#pragma unroll
                    for (int bj = 0; bj < 2; ++bj) {
                        const f32x4 v0 = acc[ai][bj][m][0] * aux[bj][0] * r2, v1 = acc[ai][bj][m][1] * aux[bj][1] * r2;
                        u32x4 o; o[0] = pack2bf(v0[0], v0[1]); o[1] = pack2bf(v0[2], v0[3]); o[2] = pack2bf(v1[0], v1[1]); o[3] = pack2bf(v1[2], v1[3]);
                        *(u32x4*)(dst + 32 * bj + 8 * fq) = o;
                    }
                } else {
                    const int col = 128 * (un - 8) + 32 * wc + 8 * fq;
                    u32x4 orat, ogs;
#pragma unroll
                    for (int n = 0; n < 2; ++n) {
                        const f32x4 vc = acc[ai][0][m][n] * sc + aux[0][n], vs = acc[ai][1][m][n] * sc + aux[1][n];
                        float rt_[4], gs_[4];
#pragma unroll
                        for (int e = 0; e < 4; ++e) { const float ec = __expf(-vc[e]), es = __expf(-vs[e]); gs_[e] = 1.f / (1.f + es); rt_[e] = (1.f + es) / (1.f + ec); }
                        orat[2 * n] = pack2bf(rt_[0], rt_[1]); orat[2 * n + 1] = pack2bf(rt_[2], rt_[3]);
                        ogs[2 * n] = pack2bf(gs_[0], gs_[1]); ogs[2 * n + 1] = pack2bf(gs_[2], gs_[3]);
                    }
                    *(u32x4*)(gate + (size_t)row * 2048 + col) = orat;
                    *(u32x4*)(gate + (size_t)row * 2048 + 1024 + col) = ogs;
                }
            }
    }
};
__device__ void phase_gemm1(const Params& p, LAS char* sm) {
    OrderP1 S; S.c = blockIdx.x; S.G = gridDim.x; S.n = 0;
    EpiP1 E{(const float*)(p.ws + WS_RSTD1), (bf16_t*)(p.ws + WS_GLU), (bf16_t*)(p.ws + WS_Q), (bf16_t*)(p.ws + WS_K), (bf16_t*)(p.ws + WS_VT), (bf16_t*)(p.ws + WS_GATE),
            p.q_norm_g, p.k_norm_g, p.b_gate};
    pg8::Gemm g{(const bf16_t*)p.ws, (const bf16_t*)p.ws, D};
    pg8::gemm_phase((LAS unsigned char*)sm, g, S, E);
    convert_tables(p, sm);
}

__device__ void conv_item(const Params& p, LAS char* sm, int item) {
    const int tid = tid_opaque(), lane = tid & 63, wid = tid >> 6;
    const bf16_t* glu = (const bf16_t*)(p.ws + WS_GLU);
    bf16_t* co = (bf16_t*)(p.ws + WS_CO);
    const int t0 = item * 32;
    {
        u32x4 v[8];
#pragma unroll
        for (int i = 0; i < 8; ++i) {
            const int c = tid + i * NT, row = c >> 6, ch = c & 63, g = t0 - 30 + row;
            v[i] = (u32x4){0u, 0u, 0u, 0u};
            if (c < 62 * 64 && g >= 0) v[i] = *(const u32x4*)(glu + (size_t)g * CONVC + ch * 8);
        }
#pragma unroll
        for (int i = 0; i < 8; ++i) {
            const int c = tid + i * NT, row = c >> 6, ch = c & 63;
            if (c < 62 * 64) *(LAS u32x4*)(sm + row * 1024 + ch * 16) = v[i];
        }
    }
    float wa[CONVW];
#pragma unroll
    for (int j = 0; j < CONVW; ++j) wa[j] = p.conv_w[j * CONVC + tid];
    const float bias = p.conv_b[tid];
    float aa[32];
#pragma unroll
    for (int r = 0; r < 32; ++r) aa[r] = bias;
    __syncthreads();
#pragma unroll
    for (int i = 0; i < 62; ++i) {
        const float xa = __uint_as_float((unsigned)(*(LAS unsigned short*)(sm + i * 1024 + tid * 2)) << 16);
#pragma unroll
        for (int r = 0; r < 32; ++r) {
            const int j = i - r;
            if (j >= 0 && j < CONVW) aa[r] += wa[j] * xa;
        }
    }
    __syncthreads();
#pragma unroll
    for (int r = 0; r < 32; ++r) *(LAS float*)(sm + (r * 516 + tid) * 4) = aa[r];
    __syncthreads();
    const f32x4 g0 = *(const f32x4*)(p.conv_ln_g + lane * 4), g1 = *(const f32x4*)(p.conv_ln_g + 256 + lane * 4);
    const f32x4 b0 = *(const f32x4*)(p.conv_ln_b + lane * 4), b1 = *(const f32x4*)(p.conv_ln_b + 256 + lane * 4);
#pragma unroll 1
    for (int rr = 0; rr < 4; ++rr) {
        const int r = wid * 4 + rr;
        f32x4 v0 = *(LAS f32x4*)(sm + (r * 516 + lane * 4) * 4), v1 = *(LAS f32x4*)(sm + (r * 516 + 256 + lane * 4) * 4);
        float s = v0[0] + v0[1] + v0[2] + v0[3] + v1[0] + v1[1] + v1[2] + v1[3];
        s = wave_sum(s);
        const float mu = s * (1.f / CONVC);
        float q = 0.f;
#pragma unroll
        for (int e = 0; e < 4; ++e) { v0[e] -= mu; v1[e] -= mu; q += v0[e] * v0[e] + v1[e] * v1[e]; }
        q = wave_sum(q);
        const float rstd = rsqrtf(q * (1.f / CONVC) + EPS);
        float y0[4], y1[4];
#pragma unroll
        for (int e = 0; e < 4; ++e) {
            float a = v0[e] * rstd * g0[e] + b0[e]; y0[e] = a * sigmoidf_(a);
            float c = v1[e] * rstd * g1[e] + b1[e]; y1[e] = c * sigmoidf_(c);
        }
        const int t = t0 + r;
        u32x2 o; o[0] = pack2bf(y0[0], y0[1]); o[1] = pack2bf(y0[2], y0[3]);
        *(u32x2*)(co + (size_t)t * D + lane * 4) = o;
        o[0] = pack2bf(y1[0], y1[1]); o[1] = pack2bf(y1[2], y1[3]);
        *(u32x2*)(co + (size_t)t * D + 256 + lane * 4) = o;
    }
    __syncthreads();
}

__device__ void attn_item(const Params& p, LAS char* sm, int head, int qb) {
    const int tid = tid_opaque(), lane = tid & 63, w = __builtin_amdgcn_readfirstlane(tid >> 6), fr = lane & 15, fq = lane >> 4;
    const bf16_t* Qh = (const bf16_t*)(p.ws + WS_Q) + (size_t)head * LP2 * DH;
    const bf16_t* Kh = (const bf16_t*)(p.ws + WS_K) + (size_t)head * LP2 * DH;
    const bf16_t* Vth = (const bf16_t*)(p.ws + WS_VT) + (size_t)head * (LP2 / 64) * 4096;
    bf16_t* og = (bf16_t*)(p.ws + WS_CO) + 512;
    LAS char* Ks = sm;
    LAS char* Vs = sm + 8192;
    LAS char* LK = sm + 16384 + w * 8192;
    LAS char* PS = LK + 4096;
    LAS float* flags = (LAS float*)(sm + LDS_MAIN);
    const int trb0 = qb * 256 + 16 * w, trb1 = trb0 + 128;
    bf16x8 qf[2][2];
#pragma unroll
    for (int nt = 0; nt < 2; ++nt)
#pragma unroll
        for (int kh = 0; kh < 2; ++kh) qf[nt][kh] = *(const bf16x8*)(Qh + (size_t)((nt ? trb1 : trb0) + fr) * DH + 32 * kh + 8 * fq);
    f32x4 oT[4][2];
#pragma unroll
    for (int i = 0; i < 4; ++i) { oT[i][0] = (f32x4){0.f, 0.f, 0.f, 0.f}; oT[i][1] = (f32x4){0.f, 0.f, 0.f, 0.f}; }
    float R[2] = {0.f, 0.f};
    const int swz = fr & 7;
    const int prow = tid >> 3, pc = (tid & 7) ^ (prow & 7);
    int kt = 4 * qb + 3;
    u32x4 kv = *(const u32x4*)(Kh + (size_t)(kt * 64 + prow) * DH + pc * 8);
    u32x4 vv = *(const u32x4*)(Vth + (size_t)kt * 4096 + prow * 64 + pc * 8);
    auto tile = [&](auto MASKED_T, auto A0_T, auto A1_T, int s0) {
        constexpr bool MASKED = decltype(MASKED_T)::value, a0 = decltype(A0_T)::value, a1 = decltype(A1_T)::value;
        f32x4 z[4][2];
#pragma unroll
        for (int i = 0; i < 4; ++i) { z[i][0] = (f32x4){0.f, 0.f, 0.f, 0.f}; z[i][1] = (f32x4){0.f, 0.f, 0.f, 0.f}; }
#pragma unroll
        for (int kh = 0; kh < 2; ++kh)
#pragma unroll
            for (int ms = 0; ms < 4; ++ms) {
                const bf16x8 kf = *(LAS bf16x8*)(Ks + (16 * ms + fr) * 128 + (((4 * kh + fq) ^ swz) << 4));
                if constexpr (a0) z[ms][0] = __builtin_amdgcn_mfma_f32_16x16x32_bf16(kf, qf[0][kh], z[ms][0], 0, 0, 0);
                if constexpr (a1) z[ms][1] = __builtin_amdgcn_mfma_f32_16x16x32_bf16(kf, qf[1][kh], z[ms][1], 0, 0, 0);
            }
        float lsum[2] = {0.f, 0.f};
#pragma unroll
        for (int ms = 0; ms < 4; ++ms)
#pragma unroll
            for (int nt = 0; nt < 2; ++nt) {
                if (!(nt ? a1 : a0)) continue;
                const int t = (nt ? trb1 : trb0) + fr;
                float lk[4];
#pragma unroll
                for (int j = 0; j < 4; ++j) {
                    const float zz = z[ms][nt][j];
                    const float sp = fmaxf(zz, 0.f) + __builtin_amdgcn_logf(1.f + __builtin_amdgcn_exp2f(-fabsf(zz)));
                    float l = -sp;
                    if (MASKED) { const int s = s0 + 16 * ms + 4 * fq + j; l = (s < t) ? l : 0.f; }
                    lk[j] = l; lsum[nt] += l;
                    z[ms][nt][j] = zz - sp;
                }
                u32x2 ph; ph[0] = pack2h(lk[0], lk[1]); ph[1] = pack2h(lk[2], lk[3]);
                *(LAS u32x2*)(LK + (16 * nt + fr) * 128 + ((((2 * ms + (fq >> 1)) ^ swz)) << 4) + (fq & 1) * 8) = ph;
            }
        __builtin_amdgcn_wave_barrier();
        asm volatile("s_waitcnt lgkmcnt(0)" ::: "memory");
        f32x4 st[4][2];
#pragma unroll
        for (int i = 0; i < 4; ++i) { st[i][0] = (f32x4){0.f, 0.f, 0.f, 0.f}; st[i][1] = (f32x4){0.f, 0.f, 0.f, 0.f}; }
#pragma unroll
        for (int kh = 0; kh < 2; ++kh) {
            f16x8 bh[2];
#pragma unroll
            for (int nt = 0; nt < 2; ++nt) if (nt ? a1 : a0) bh[nt] = *(LAS f16x8*)(LK + (16 * nt + fr) * 128 + (((4 * kh + fq) ^ swz) << 4));
#pragma unroll
            for (int ms = 0; ms < 4; ++ms) {
                if (32 * kh + 32 <= 16 * ms + 1) continue;
                f16x8 tm;
#pragma unroll
                for (int e = 0; e < 8; ++e) tm[e] = (32 * kh + 8 * fq + e > 16 * ms + fr) ? (_Float16)1.0f : (_Float16)0.0f;
                if constexpr (a0) st[ms][0] = __builtin_amdgcn_mfma_f32_16x16x32_f16(tm, bh[0], st[ms][0], 0, 0, 0);
                if constexpr (a1) st[ms][1] = __builtin_amdgcn_mfma_f32_16x16x32_f16(tm, bh[1], st[ms][1], 0, 0, 0);
            }
        }
#pragma unroll
        for (int ms = 0; ms < 4; ++ms)
#pragma unroll
            for (int nt = 0; nt < 2; ++nt) {
                if (!(nt ? a1 : a0)) continue;
                const int t = (nt ? trb1 : trb0) + fr;
                float wv[4];
#pragma unroll
                for (int j = 0; j < 4; ++j) {
                    float wj = __builtin_amdgcn_exp2f(z[ms][nt][j] + R[nt] + st[ms][nt][j]);
                    if (MASKED) { const int s = s0 + 16 * ms + 4 * fq + j; wj = (s < t) ? wj : 0.f; }
                    wv[j] = wj;
                }
                u32x2 pw; pw[0] = pack2h(wv[0], wv[1]); pw[1] = pack2h(wv[2], wv[3]);
                *(LAS u32x2*)(PS + (16 * nt + fr) * 128 + ((((2 * ms + (fq >> 1)) ^ swz)) << 4) + (fq & 1) * 8) = pw;
            }
#pragma unroll
        for (int nt = 0; nt < 2; ++nt) {
            if (!(nt ? a1 : a0)) continue;
            float tsum = lsum[nt];
            tsum += __shfl_xor(tsum, 16);
            tsum += __shfl_xor(tsum, 32);
            R[nt] += tsum;
        }
        __builtin_amdgcn_wave_barrier();
        asm volatile("s_waitcnt lgkmcnt(0)" ::: "memory");
#pragma unroll
        for (int kh = 0; kh < 2; ++kh) {
            f16x8 pf[2];
#pragma unroll
            for (int nt = 0; nt < 2; ++nt) if (nt ? a1 : a0) pf[nt] = *(LAS f16x8*)(PS + (16 * nt + fr) * 128 + (((4 * kh + fq) ^ swz) << 4));
#pragma unroll
            for (int md = 0; md < 4; ++md) {
                const f16x8 vf = *(LAS f16x8*)(Vs + (16 * md + fr) * 128 + (((4 * kh + fq) ^ swz) << 4));
                if constexpr (a0) oT[md][0] = __builtin_amdgcn_mfma_f32_16x16x32_f16(vf, pf[0], oT[md][0], 0, 0, 0);
                if constexpr (a1) oT[md][1] = __builtin_amdgcn_mfma_f32_16x16x32_f16(vf, pf[1], oT[md][1], 0, 0, 0);
            }
        }
    };
    bool done0 = false, done1 = false;
    for (; kt >= 0; --kt) {
        *(LAS u32x4*)(Ks + tid * 16) = kv;
        *(LAS u32x4*)(Vs + tid * 16) = vv;
        __syncthreads();
        if (kt > 0) {
            kv = *(const u32x4*)(Kh + (size_t)((kt - 1) * 64 + prow) * DH + pc * 8);
            vv = *(const u32x4*)(Vth + (size_t)(kt - 1) * 4096 + prow * 64 + pc * 8);
        }
        {
            const int s0 = kt * 64;
            const bool a0 = !done0 && s0 <= trb0, a1 = !done1 && s0 <= trb1;
            if (a0 || a1) {
                const bool mk = (a0 && s0 + 63 >= trb0) || (a1 && s0 + 63 >= trb1);
                if (a0 && a1) { if (mk) tile(std::true_type{}, std::true_type{}, std::true_type{}, s0); else tile(std::false_type{}, std::true_type{}, std::true_type{}, s0); }
                else if (a0) { if (mk) tile(std::true_type{}, std::true_type{}, std::false_type{}, s0); else tile(std::false_type{}, std::true_type{}, std::false_type{}, s0); }
                else { if (mk) tile(std::true_type{}, std::false_type{}, std::true_type{}, s0); else tile(std::false_type{}, std::false_type{}, std::true_type{}, s0); }
                if (a0) done0 = __int_as_float(__builtin_amdgcn_readfirstlane(__float_as_int(wave_max(R[0])))) < -127.f;
                if (a1) done1 = __int_as_float(__builtin_amdgcn_readfirstlane(__float_as_int(wave_max(R[1])))) < -127.f;
            }
        }
        const float wm = wave_max(fmaxf(R[0], R[1]));
        if (lane == 0) flags[(kt & 1) * 8 + w] = wm;
        __syncthreads();
        float m8 = flags[(kt & 1) * 8];
#pragma unroll
        for (int i = 1; i < 8; ++i) m8 = fmaxf(m8, flags[(kt & 1) * 8 + i]);
        if (m8 < -127.f) break;
    }
#pragma unroll
    for (int md = 0; md < 4; ++md)
#pragma unroll
        for (int nt = 0; nt < 2; ++nt) {
            const int t = (nt ? trb1 : trb0) + fr;
            u32x2 o; o[0] = pack2bf(oT[md][nt][0], oT[md][nt][1]); o[1] = pack2bf(oT[md][nt][2], oT[md][nt][3]);
            *(u32x2*)(og + (size_t)t * D + head * 64 + 16 * md + 4 * fq) = o;
        }
    __syncthreads();
}

__device__ void phase_mixers(const Params& p, LAS char* sm) {
    constexpr int NQB = LP2 / 256, NATT = NH * NQB, NCONV = (LTOK + 31) / 32;
    unsigned* ctr = (unsigned*)p.ws + CTR_MIX;
    LAS int* slot = (LAS int*)(sm + LDS_MAIN + 128);
    if (threadIdx.x == 0) *slot = (int)atomicAdd(ctr, 1u);
    __syncthreads();
    for (;;) {
        const int it = *slot;
        __syncthreads();
        if (it >= NATT + NCONV) break;
        unsigned nx = 0u;
        if (threadIdx.x == 0) nx = atomicAdd(ctr, 1u);
        if (it < NATT) { const int qb = NQB - 1 - it / NH, head = it % NH; attn_item(p, sm, head, qb); }
        else conv_item(p, sm, it - NATT);
        if (threadIdx.x == 0) *slot = (int)nx;
        __syncthreads();
    }
}

struct OrderMN : pg8::LinearOrder {
    __device__ __forceinline__ bool next(int i, pg8::Unit& u) const {
        const int L = unit_id(i);
        if (L >= 64 * n) return false;
        u.pm = L / n; u.pn = L % n; return true;
    }
};
struct EpiP3 {
    static constexpr bool HAS_MID = true;
    const bf16_t* gate; bf16_t* mixed;
    __device__ __forceinline__ void scale(f32x4 (&acc)[2][2][4][2], const pg8::Unit& u, int wr, int wc, int fr_, int fq_, int goff, bool store) const {
        int fr = fr_, fq = fq_; asm volatile("" : "+v"(fr), "+v"(fq));
        const int row0 = NMETA + 256 * u.pm + 64 * wr + fr, col0 = 256 * u.pn + 32 * wc + 8 * fq;
        u32x4 gv[2][4][2];
#pragma unroll
        for (int ai = 0; ai < 2; ++ai)
#pragma unroll
            for (int m = 0; m < 4; ++m)
#pragma unroll
                for (int bj = 0; bj < 2; ++bj) gv[ai][m][bj] = *(const u32x4*)(gate + (size_t)(row0 + 128 * ai + 16 * m) * 2048 + goff + col0 + 128 * bj);
        asm volatile("s_waitcnt vmcnt(0)" ::: "memory");
#pragma unroll
        for (int ai = 0; ai < 2; ++ai)
#pragma unroll
            for (int m = 0; m < 4; ++m)
#pragma unroll
                for (int bj = 0; bj < 2; ++bj) {
                    const u32x4 g = gv[ai][m][bj];
                    u32x4 o;
#pragma unroll
                    for (int n = 0; n < 2; ++n) {
                        f32x4 y = acc[ai][bj][m][n];
                        y[0] *= bflo(g[2 * n]); y[1] *= bfhi(g[2 * n]); y[2] *= bflo(g[2 * n + 1]); y[3] *= bfhi(g[2 * n + 1]);
                        if (store) { o[2 * n] = pack2bf(y[0], y[1]); o[2 * n + 1] = pack2bf(y[2], y[3]); }
                        else acc[ai][bj][m][n] = y;
                    }
                    if (store) *(u32x4*)(mixed + (size_t)(row0 + 128 * ai + 16 * m) * D + col0 + 128 * bj) = o;
                }
    }
    __device__ __forceinline__ void mid(f32x4 (&acc)[2][2][4][2], const pg8::Unit& u, int wr, int wc, int fr, int fq) const { scale(acc, u, wr, wc, fr, fq, 0, false); }
    __device__ __forceinline__ void operator()(const f32x4 (&acc)[2][2][4][2], const pg8::Unit& u, int wr, int wc, int fr, int fq) const {
        scale(const_cast<f32x4 (&)[2][2][4][2]>(acc), u, wr, wc, fr, fq, 1024, true);
    }
};
__device__ void phase_gemm2(const Params& p, LAS char* sm) {
    OrderMN S; S.c = blockIdx.x; S.G = gridDim.x; S.n = 4;
    EpiP3 E{(const bf16_t*)(p.ws + WS_GATE), (bf16_t*)(p.ws + WS_MIXED)};
    pg8::Gemm g{(const bf16_t*)(p.ws + WS_CO) + (size_t)NMETA * D, (const bf16_t*)(p.ws + WS_W2), D};
    pg8::gemm_phase((LAS unsigned char*)sm, g, S, E);
}

struct EpiP4 {
    static constexpr bool HAS_MID = false;
    const bf16_t* hb; bf16_t* h2b; float* ssp;
    __device__ __forceinline__ void operator()(const f32x4 (&acc)[2][2][4][2], const pg8::Unit& u, int wr, int wc, int fr_, int fq_) const {
        int fr = fr_, fq = fq_; asm volatile("" : "+v"(fr), "+v"(fq));
        const int col0 = 256 * u.pn + 32 * wc + 8 * fq;
        const int tok0 = 256 * u.pm + 64 * wr + fr;
#pragma unroll
        for (int ai = 0; ai < 2; ++ai) {
            u32x4 hv[4][2];
#pragma unroll
            for (int m = 0; m < 4; ++m)
#pragma unroll
                for (int bj = 0; bj < 2; ++bj) hv[m][bj] = *(const u32x4*)(hb + (size_t)(NMETA + tok0 + 128 * ai + 16 * m) * D + col0 + 128 * bj);
            asm volatile("s_waitcnt vmcnt(0)" ::: "memory");
#pragma unroll
            for (int m = 0; m < 4; ++m) {
                const int tok = tok0 + 128 * ai + 16 * m;
                float ssq = 0.f;
#pragma unroll
                for (int bj = 0; bj < 2; ++bj) {
                    const u32x4 h = hv[m][bj];
                    u32x4 o;
#pragma unroll
                    for (int n = 0; n < 2; ++n) {
                        const f32x4 a = acc[ai][bj][m][n];
                        o[2 * n] = pack2bf(bflo(h[2 * n]) + a[0], bfhi(h[2 * n]) + a[1]); o[2 * n + 1] = pack2bf(bflo(h[2 * n + 1]) + a[2], bfhi(h[2 * n + 1]) + a[3]);
                    }
                    *(u32x4*)(h2b + (size_t)tok * D + col0 + 128 * bj) = o;
#pragma unroll
                    for (int e = 0; e < 4; ++e) { const float r0 = bflo(o[e]), r1 = bfhi(o[e]); ssq += r0 * r0 + r1 * r1; }
                }
                ssq += __shfl_xor(ssq, 16); ssq += __shfl_xor(ssq, 32);
                if (fq == 0) ssp[(size_t)tok * 16 + u.pn * 4 + wc] = ssq;
            }
        }
    }
};
__device__ void phase_gemm3(const Params& p, LAS char* sm) {
    OrderMN S; S.c = blockIdx.x; S.G = gridDim.x; S.n = 4;
    EpiP4 E{(const bf16_t*)(p.ws + WS_HB), (bf16_t*)(p.ws + WS_H2B), (float*)(p.ws + WS_SSP)};
    pg8::Gemm g{(const bf16_t*)(p.ws + WS_MIXED) + (size_t)NMETA * D, (const bf16_t*)(p.ws + WS_WO), D};
    pg8::gemm_phase((LAS unsigned char*)sm, g, S, E);
}

__device__ __forceinline__ float vmaxf(float a, float b) { float r; asm("v_max_f32 %0, %1, %2" : "=v"(r) : "v"(a), "v"(b)); return r; }
__device__ __forceinline__ float vminf(float a, float b) { float r; asm("v_min_f32 %0, %1, %2" : "=v"(r) : "v"(a), "v"(b)); return r; }
__device__ __forceinline__ void bitonic_sort16_desc(float (&a)[16]) {
#pragma unroll
    for (int k = 2; k <= 16; k <<= 1)
#pragma unroll
        for (int j = k >> 1; j > 0; j >>= 1)
#pragma unroll
            for (int i = 0; i < 16; ++i) {
                const int l = i ^ j;
                if (l > i) {
                    const bool desc = ((i & k) == 0);
                    const float x = vmaxf(a[i], a[l]), y = vminf(a[i], a[l]);
                    a[i] = desc ? x : y; a[l] = desc ? y : x;
                }
            }
}
__device__ __forceinline__ void merge_top16_desc(float (&r)[16], const float (&g)[16]) {
#pragma unroll
    for (int i = 0; i < 16; ++i) r[i] = vmaxf(r[i], g[15 - i]);
#pragma unroll
    for (int j = 8; j > 0; j >>= 1)
#pragma unroll
        for (int i = 0; i < 16; ++i) {
            const int l = i ^ j;
            if (l > i) { const float x = vmaxf(r[i], r[l]), y = vminf(r[i], r[l]); r[i] = x; r[l] = y; }
        }
}
__device__ __forceinline__ float mkkey(float f, int low, int mask) { return __int_as_float((__float_as_int(f) & ~mask) | low); }
__device__ __forceinline__ int keylow(float k, int mask) { return __float_as_int(k) & mask; }
__device__ __forceinline__ float keyval(float k, int mask) { return __int_as_float(__float_as_int(k) & ~mask); }

struct EpiP5 {
    static constexpr bool HAS_MID = false;
    bf16_t* qp;
    __device__ __forceinline__ void operator()(const f32x4 (&acc)[2][2][4][2], const pg8::Unit& u, int wr, int wc, int fr_, int fq_) const {
        int fr = fr_, fq = fq_; asm volatile("" : "+v"(fr), "+v"(fq));
#pragma unroll
        for (int ai = 0; ai < 2; ++ai)
#pragma unroll
            for (int m = 0; m < 4; ++m) {
                const int tok = 256 * u.pm + 128 * ai + 64 * wr + 16 * m + fr;
#pragma unroll
                for (int bj = 0; bj < 2; ++bj) {
                    const f32x4 v0 = acc[ai][bj][m][0], v1 = acc[ai][bj][m][1];
                    u32x4 o; o[0] = pack2h(v0[0], v0[1]); o[1] = pack2h(v0[2], v0[3]); o[2] = pack2h(v1[0], v1[1]); o[3] = pack2h(v1[2], v1[3]);
                    *(u32x4*)(qp + (size_t)tok * 2048 + 256 * u.pn + 128 * bj + 32 * wc + 8 * fq) = o;
                }
            }
    }
};

__device__ void route_unit(const Params& p, LAS char* sm, int pm, int head) {
    const int tid = tid_opaque();
    const bf16_t* sc = (const bf16_t*)(p.ws + WS_QP);
    int* pidx = (int*)(p.ws + WS_PIDX);
    float* pgate = (float*)(p.ws + WS_PGATE);
    const int row = tid & 255, part = tid >> 8;
    u32x4 sv[2][8];
#pragma unroll
    for (int half = 0; half < 2; ++half)
#pragma unroll
        for (int q = 0; q < 8; ++q) sv[half][q] = *(const u32x4*)(sc + (size_t)(256 * pm + row) * 2048 + head * 256 + half * 128 + part * 64 + 8 * q);
    f32x4 ssv[4];
    { const float* sp = (const float*)(p.ws + WS_SSP) + (size_t)(256 * pm + row) * 16;
#pragma unroll
      for (int q = 0; q < 4; ++q) ssv[q] = *(const f32x4*)(sp + 4 * q); }
    float keep0[16];
#pragma unroll
    for (int half = 0; half < 2; ++half) {
        float run[16];
#pragma unroll
        for (int g = 0; g < 4; ++g) {
            float grp[16];
#pragma unroll
            for (int q = 0; q < 2; ++q)
#pragma unroll
                for (int e = 0; e < 4; ++e) {
                    const unsigned w = sv[half][2 * g + q][e];
                    const int c0 = part * 64 + 16 * g + 8 * q + 2 * e;
                    grp[8 * q + 2 * e] = mkkey((float)__builtin_bit_cast(_Float16, (unsigned short)(w & 0xFFFFu)), c0, 127);
                    grp[8 * q + 2 * e + 1] = mkkey((float)__builtin_bit_cast(_Float16, (unsigned short)(w >> 16)), c0 + 1, 127);
                }
            bitonic_sort16_desc(grp);
            if (g == 0) {
#pragma unroll
                for (int i = 0; i < 16; ++i) run[i] = grp[i];
            } else merge_top16_desc(run, grp);
        }
        LAS float* myrow = (LAS float*)(sm + row * 512);
        if (part == 1) {
#pragma unroll
            for (int i = 0; i < 16; ++i) myrow[i] = run[i];
        }
        __syncthreads();
        if (part == 0) {
            float oth[16];
#pragma unroll
            for (int i = 0; i < 16; ++i) oth[i] = myrow[i];
            merge_top16_desc(run, oth);
            if (half == 0) {
#pragma unroll
                for (int i = 0; i < 16; ++i) keep0[i] = run[i];
            } else {
#pragma unroll
                for (int i = 0; i < 16; ++i) { myrow[32 + i] = keep0[i]; myrow[48 + i] = run[i]; }
            }
        }
        if (half == 1) {
            __syncthreads();
            float v1[16], v2[16];
#pragma unroll
            for (int i = 0; i < 16; ++i) { v1[i] = keyval(myrow[32 + i], 127); v2[i] = keyval(myrow[48 + i], 127); }
#define CKEY(I, J) mkkey(v1[I] + v2[J], 16 * (I) + (J), 255)
            float res[16];
            if (part == 0) {
#pragma unroll
                for (int j = 0; j < 16; ++j) res[j] = CKEY(0, j);
                float g1[16];
#pragma unroll
                for (int j = 0; j < 8; ++j) g1[j] = CKEY(1, j);
#pragma unroll
                for (int j = 0; j < 5; ++j) g1[8 + j] = CKEY(2, j);
#pragma unroll
                for (int j = 0; j < 3; ++j) g1[13 + j] = CKEY(3, j);
                bitonic_sort16_desc(g1);
                merge_top16_desc(res, g1);
            } else {
                res[0] = CKEY(3, 3);
#pragma unroll
                for (int j = 0; j < 3; ++j) res[1 + j] = CKEY(4, j);
#pragma unroll
                for (int i = 5; i < 8; ++i) { res[4 + 2 * (i - 5)] = CKEY(i, 0); res[5 + 2 * (i - 5)] = CKEY(i, 1); }
#pragma unroll
                for (int i = 8; i < 14; ++i) res[10 + (i - 8)] = CKEY(i, 0);
                bitonic_sort16_desc(res);
                float g2[16];
                const float c14 = CKEY(14, 0), c15 = CKEY(15, 0);
                g2[0] = vmaxf(c14, c15); g2[1] = vminf(c14, c15);
#pragma unroll
                for (int i = 2; i < 16; ++i) g2[i] = -3.0e38f;
                merge_top16_desc(res, g2);
#pragma unroll
                for (int i = 0; i < 16; ++i) myrow[16 + i] = res[i];
            }
#undef CKEY
            __syncthreads();
            if (part == 0) {
                float oth2[16];
#pragma unroll
                for (int i = 0; i < 16; ++i) oth2[i] = myrow[16 + i];
                merge_top16_desc(res, oth2);
                float sc2;
                {
                    const f32x4 st = (ssv[0] + ssv[1]) + (ssv[2] + ssv[3]);
                    sc2 = rsqrtf((st[0] + st[1] + st[2] + st[3]) * (1.f / D) + EPS);
                    if (head == 0) ((float*)(p.ws + WS_RSTD2))[256 * pm + row] = sc2;
                }
                float bv[16]; float mx = -3.0e38f;
#pragma unroll
                for (int k = 0; k < 16; ++k) { bv[k] = keyval(res[k], 255) * sc2; mx = fmaxf(mx, bv[k]); }
                float se = 0.f;
#pragma unroll
                for (int k = 0; k < 16; ++k) { bv[k] = __expf(bv[k] - mx); se += bv[k]; }
                const float inv = 1.f / se;
                const size_t ob = ((size_t)(256 * pm + row)) * 128 + head * 16;
#pragma unroll
                for (int k4 = 0; k4 < 4; ++k4) {
                    i32x4 id; f32x4 gv;
#pragma unroll
                    for (int e = 0; e < 4; ++e) {
                        const int code = keylow(res[k4 * 4 + e], 255);
                        id[e] = keylow(myrow[32 + (code >> 4)], 127) * NKEYS + keylow(myrow[48 + (code & 15)], 127);
                        gv[e] = bv[k4 * 4 + e] * inv;
                    }
                    *(i32x4*)(pidx + ob + k4 * 4) = id;
                    *(f32x4*)(pgate + ob + k4 * 4) = gv;
                }
            }
        }
        __syncthreads();
    }
}
__device__ void phase_route(const Params& p, LAS char* sm) {
    OrderMN S; S.c = blockIdx.x; S.G = gridDim.x; S.n = 8;
    EpiP5 E{(bf16_t*)(p.ws + WS_QP)};
    pg8::Gemm g{(const bf16_t*)(p.ws + WS_H2B), (const bf16_t*)(p.ws + WS_WQ), D};
    pg8::gemm_phase((LAS unsigned char*)sm, g, S, E);
    asm volatile("s_waitcnt vmcnt(0)" ::: "memory");
    __syncthreads();
    pg8::Unit u;
    for (int i = 0; S.next(i, u); ++i) route_unit(p, sm, u.pm, u.pn);
}

__device__ __forceinline__ float gelu_exact(float x) { return 0.5f * x * (1.f + erff(x * 0.70710678118654752f)); }

template <int CTRL> __device__ __forceinline__ float dpp_maxf(float v) { return fmaxf(v, __int_as_float(__builtin_amdgcn_update_dpp(0, __float_as_int(v), CTRL, 0xF, 0xF, true))); }
template <int CTRL> __device__ __forceinline__ int dpp_i(int v) { return __builtin_amdgcn_update_dpp(0, v, CTRL, 0xF, 0xF, true); }
__device__ void phase_peer_u(const Params& p, LAS char* sm) {
    const int tid = tid_opaque(), lane = tid & 63, wid = tid >> 6, g = lane >> 3, l7 = lane & 7;
    const int sl = blockIdx.x & 7, gw = (blockIdx.x >> 3) * NWV + wid, nw = (gridDim.x >> 3) * NWV;
    const int* pidx = (const int*)(p.ws + WS_PIDX);
    const unsigned char* ubase = p.ws + WS_UB + (size_t)sl * 16384 * 128;
    const bf16_t* h2b = (const bf16_t*)(p.ws + WS_H2B);
    bf16_t* part = (bf16_t*)(p.ws + WS_PART);
    const unsigned cofs = 16 * l7;
    const bool b4 = l7 & 4, b2 = l7 & 2, b1 = l7 & 1;
    const int K = SEQ / nw;
#define PU_LOAD_IDS(T) { idsN2 = *(const i32x2*)(pidx + (size_t)(T) * 128 + 2 * lane); xN = *(const unsigned*)(h2b + (size_t)(T) * D + 128 * sl + 2 * lane); }
#define PU_GATHER(UR, XQ, ISX, T) { i32x4 idsN[4]; \
        const float x0 = bflo(xN), x1 = bfhi(xN); \
        float am = fmaxf(fabsf(x0), fabsf(x1)); \
        am = dpp_maxf<0xB1>(am); am = dpp_maxf<0x4E>(am); am = dpp_maxf<0x124>(am); am = dpp_maxf<0x128>(am); \
        { const int ai = __float_as_int(am); am = fmaxf(fmaxf(__int_as_float(__builtin_amdgcn_readlane(ai, 0)), __int_as_float(__builtin_amdgcn_readlane(ai, 16))), fmaxf(__int_as_float(__builtin_amdgcn_readlane(ai, 32)), __int_as_float(__builtin_amdgcn_readlane(ai, 48)))); } \
        const float sx = am > 0.f ? 127.f * __builtin_amdgcn_rcpf(am) : 0.f; ISX = am * (1.f / 127.f); \
        const int q0 = __float2int_rn(x0 * sx), q1 = __float2int_rn(x1 * sx); \
        *(LAS i32x2*)(wslot + 8 * lane) = idsN2; *(LAS unsigned short*)(wslot + 512 + 2 * lane) = (unsigned short)((q0 & 255) | ((q1 & 255) << 8)); \
        __builtin_amdgcn_wave_barrier(); asm volatile("s_waitcnt lgkmcnt(0)" ::: "memory"); \
        _Pragma("unroll") for (int q = 0; q < 4; ++q) idsN[q] = *(LAS i32x4*)(wslot + 64 * g + 16 * q); \
        XQ = *(LAS u32x4*)(wslot + 512 + 16 * l7); \
        asm volatile("s_waitcnt lgkmcnt(0)" ::: "memory"); __builtin_amdgcn_wave_barrier(); \
        _Pragma("unroll") for (int i = 0; i < 16; ++i) UR[i] = *(const u32x4*)(ubase + (size_t)(((unsigned)idsN[i >> 2][i & 3] << 7) + cofs)); \
        }
#define PU_COMPUTE(UR, XQ, ISX, T) { \
        int a[16]; \
        _Pragma("unroll") for (int i = 0; i < 16; ++i) { int s4 = 0; \
            _Pragma("unroll") for (int c = 0; c < 4; ++c) s4 = __builtin_amdgcn_sdot4((int)UR[i][c], (int)XQ[c], s4, false); \
            a[i] = s4; } \
        int r8[8], r4[4], r2[2]; \
        _Pragma("unroll") for (int q = 0; q < 8; ++q) { const int keep = b4 ? a[q + 8] : a[q], send = b4 ? a[q] : a[q + 8]; r8[q] = keep + dpp_i<0x141>(send); }     \
        _Pragma("unroll") for (int q = 0; q < 4; ++q) { const int keep = b2 ? r8[q + 4] : r8[q], send = b2 ? r8[q] : r8[q + 4]; r4[q] = keep + dpp_i<0x4E>(send); }     \
        _Pragma("unroll") for (int q = 0; q < 2; ++q) { const int keep = b1 ? r4[q + 2] : r4[q], send = b1 ? r4[q] : r4[q + 2]; r2[q] = keep + dpp_i<0xB1>(send); }     \
        *(unsigned*)(part + ((size_t)sl * SEQ + (T)) * 128 + 2 * lane) = pack2bf((float)r2[0] * ISX, (float)r2[1] * ISX); }
    i32x2 idsN2; unsigned xN; u32x4 urA[16], urB[16]; u32x4 xqA, xqB; float isA, isB;
    LAS char* wslot = sm + wid * 1024;
    PU_LOAD_IDS(gw);
    PU_GATHER(urA, xqA, isA, gw);
    PU_LOAD_IDS(gw + nw);
#pragma unroll 1
    for (int k = 0; k < K; k += 2) {
        const int t0 = gw + k * nw, t1 = t0 + nw, t2 = t1 + nw, t3 = t2 + nw;
        PU_GATHER(urB, xqB, isB, t1);
        if (k + 2 < K) PU_LOAD_IDS(t2);
        PU_COMPUTE(urA, xqA, isA, t0);
        if (k + 2 < K) { PU_GATHER(urA, xqA, isA, t2); PU_LOAD_IDS(t3); }
        PU_COMPUTE(urB, xqB, isB, t1);
    }
#undef PU_LOAD_IDS
#undef PU_GATHER
#undef PU_COMPUTE
}

__device__ void phase_peer_coef(const Params& p) {
    const int tid = tid_opaque();
    const int* pidx = (const int*)(p.ws + WS_PIDX);
    const float* pgate = (const float*)(p.ws + WS_PGATE);
    const float* scu = (const float*)(p.ws + WS_SCU);
    const float* scv = (const float*)(p.ws + WS_SCV);
    const bf16_t* part = (const bf16_t*)(p.ws + WS_PART);
    const float* rstd2 = (const float*)(p.ws + WS_RSTD2);
    float* coef = (float*)(p.ws + WS_COEF);
    const size_t stride = (size_t)gridDim.x * NT, total = (size_t)SEQ * 64;
    for (size_t i0 = (size_t)blockIdx.x * NT + tid; i0 < total; i0 += 4 * stride) {
        i32x2 id2[4]; f32x2 gt[4], s[4]; float rs[4], su[4][2], sv[4][2];
#pragma unroll
        for (int j = 0; j < 4; ++j) {
            const size_t i = i0 + j * stride;
            if (i < total) {
                id2[j] = *(const i32x2*)(pidx + i * 2); gt[j] = *(const f32x2*)(pgate + i * 2); rs[j] = rstd2[i >> 6];
                f32x2 acc = (f32x2){0.f, 0.f};
#pragma unroll
                for (int q = 0; q < 8; ++q) { const unsigned w = *(const unsigned*)(part + (size_t)q * SEQ * 128 + i * 2); acc[0] += bflo(w); acc[1] += bfhi(w); }
                s[j] = acc;
            } else { id2[j] = (i32x2){0, 0}; gt[j] = (f32x2){0.f, 0.f}; s[j] = (f32x2){0.f, 0.f}; rs[j] = 0.f; }
        }
#pragma unroll
        for (int j = 0; j < 4; ++j) { su[j][0] = scu[id2[j][0]]; su[j][1] = scu[id2[j][1]]; sv[j][0] = scv[id2[j][0]]; sv[j][1] = scv[id2[j][1]]; }
#pragma unroll
        for (int j = 0; j < 4; ++j) {
            const size_t i = i0 + j * stride;
            if (i < total) {
                f32x2 c2; c2[0] = gt[j][0] * sv[j][0] * gelu_exact(s[j][0] * su[j][0] * rs[j]); c2[1] = gt[j][1] * sv[j][1] * gelu_exact(s[j][1] * su[j][1] * rs[j]);
                *(f32x2*)(coef + i * 2) = c2;
            }
        }
    }
}

__device__ void phase_peer_v(const Params& p, LAS char* sm) {
    const int tid = tid_opaque(), lane = tid & 63, wid = tid >> 6, g = lane >> 3, l7 = lane & 7;
    const int sl = blockIdx.x & 7, gw = (blockIdx.x >> 3) * NWV + wid, nw = (gridDim.x >> 3) * NWV;
    const int* pidx = (const int*)(p.ws + WS_PIDX);
    const float* coef = (const float*)(p.ws + WS_COEF);
    const unsigned char* vb = p.ws + WS_VB;
    const bf16_t* h2b = (const bf16_t*)(p.ws + WS_H2B);
    const int colbase = 128 * sl + 16 * l7;
    const unsigned char* vbase = vb + (size_t)sl * 16384 * 128;
    const unsigned cofs = 16 * l7;
    const bool h8 = lane & 8;
    const int K = SEQ / nw;
#define PV_LOAD_IDS(T) { idsN2 = *(const i32x2*)(pidx + (size_t)(T) * 128 + 2 * lane); cfN2 = *(const f32x2*)(coef + (size_t)(T) * 128 + 2 * lane); }
#define PV_GATHER(VR, HV, CF, T) { i32x4 idsN[4]; *(LAS i32x2*)(wslot + 8 * lane) = idsN2; *(LAS f32x2*)(wslot + 512 + 8 * lane) = cfN2; __builtin_amdgcn_wave_barrier(); asm volatile("s_waitcnt lgkmcnt(0)" ::: "memory"); \
        _Pragma("unroll") for (int q = 0; q < 4; ++q) { idsN[q] = *(LAS i32x4*)(wslot + 64 * g + 16 * q); CF[q] = *(LAS f32x4*)(wslot + 512 + 64 * g + 16 * q); } \
        asm volatile("s_waitcnt lgkmcnt(0)" ::: "memory"); __builtin_amdgcn_wave_barrier(); \
        _Pragma("unroll") for (int i = 0; i < 16; ++i) VR[i] = *(const u32x4*)(vbase + (size_t)(((unsigned)idsN[i >> 2][i & 3] << 7) + cofs)); \
        HV = *(const unsigned*)(h2b + (size_t)(T) * D + colbase + 2 * g); }
#define PV_COMPUTE(VR, HV, CF, T) { \
        f32x2 o2[8]; _Pragma("unroll") for (int c = 0; c < 8; ++c) o2[c] = (f32x2){0.f, 0.f}; \
        _Pragma("unroll") for (int i = 0; i < 16; ++i) { const f32x2 cv = (f32x2){CF[i >> 2][i & 3], CF[i >> 2][i & 3]}; \
            _Pragma("unroll") for (int c = 0; c < 4; ++c) { const f32x2 lo = __builtin_amdgcn_cvt_pk_f32_fp8((int)VR[i][c], false), hi = __builtin_amdgcn_cvt_pk_f32_fp8((int)VR[i][c], true); \
                o2[2 * c] += cv * lo; o2[2 * c + 1] += cv * hi; } } \
        float a[16]; _Pragma("unroll") for (int c = 0; c < 8; ++c) { a[2 * c] = o2[c][0]; a[2 * c + 1] = o2[c][1]; } \
        float r8[8], r4[4], r2[2]; \
          \
        _Pragma("unroll") for (int q = 0; q < 8; ++q) { const u32x2 sw = __builtin_amdgcn_permlane32_swap(__float_as_uint(a[q]), __float_as_uint(a[q + 8]), false, false); r8[q] = __uint_as_float(sw[0]) + __uint_as_float(sw[1]); } \
        _Pragma("unroll") for (int q = 0; q < 4; ++q) { const u32x2 sw = __builtin_amdgcn_permlane16_swap(__float_as_uint(r8[q]), __float_as_uint(r8[q + 4]), false, false); r4[q] = __uint_as_float(sw[0]) + __uint_as_float(sw[1]); } \
        _Pragma("unroll") for (int q = 0; q < 2; ++q) { const float keep = h8 ? r4[q + 2] : r4[q], send = h8 ? r4[q] : r4[q + 2]; r2[q] = keep + __int_as_float(__builtin_amdgcn_update_dpp(0, __float_as_int(send), 0x128, 0xF, 0xF, true)); } \
        f32x2 hv; hv[0] = bflo(HV) + r2[0]; hv[1] = bfhi(HV) + r2[1]; \
        *(f32x2*)(p.out + (size_t)(T) * D + colbase + 2 * g) = hv; }
    i32x2 idsN2; f32x2 cfN2; f32x4 cfA[4], cfB[4]; u32x4 vrA[16], vrB[16]; unsigned hA, hB;
    LAS char* wslot = sm + wid * 1024;
    PV_LOAD_IDS(gw);
    PV_GATHER(vrA, hA, cfA, gw);
    PV_LOAD_IDS(gw + nw);
#pragma unroll 1
    for (int k = 0; k < K; k += 2) {
        const int t0 = gw + k * nw, t1 = t0 + nw, t2 = t1 + nw, t3 = t2 + nw;
        PV_GATHER(vrB, hB, cfB, t1);
        if (k + 2 < K) PV_LOAD_IDS(t2);
        PV_COMPUTE(vrA, hA, cfA, t0);
        if (k + 2 < K) { PV_GATHER(vrA, hA, cfA, t2); PV_LOAD_IDS(t3); }
        PV_COMPUTE(vrB, hB, cfB, t1);
    }
#undef PV_LOAD_IDS
#undef PV_GATHER
#undef PV_COMPUTE
}

__global__ void __launch_bounds__(NT, 2) fwd_kernel(Params p) {
    __shared__ __attribute__((aligned(16))) char smem[LDS_BYTES + 16];
    LAS char* sm = (LAS char*)smem;
    volatile LAS unsigned* st = (volatile LAS unsigned*)(sm + LDS_BYTES);
    if (threadIdx.x == 0) { st[0] = 0u; st[1] = 0u; st[2] = 0u; st[3] = 0u; }
    __syncthreads();
    const XcdBarrier xb = xcd_barrier_post((unsigned*)p.ws, st);
#ifndef PROBE_DOUBLE
#define PROBE_DOUBLE 0
#endif
#define RUN_PHASE(K, CALL) \
    if (p.ph_lo <= (K) && (K) < p.ph_hi) { \
        const int nrep = 1 + ((PROBE_DOUBLE >> (K)) & 1); \
        _Pragma("unroll 1") for (int rep = 0; rep < nrep; ++rep) { \
            if (rep > 0) { xcd_barrier(xb); if (blockIdx.x == 0 && threadIdx.x == 0) __hip_atomic_store((unsigned*)p.ws + CTR_MIX, 0u, __ATOMIC_RELAXED, __HIP_MEMORY_SCOPE_AGENT); xcd_barrier(xb); } \
            CALL; \
        } \
        if ((K) + 1 < p.ph_hi) { xcd_barrier(xb); } \
    }
    RUN_PHASE(0, phase_prep(p, sm))
    RUN_PHASE(1, phase_gemm1(p, sm))
    RUN_PHASE(2, phase_mixers(p, sm))
    RUN_PHASE(3, phase_gemm2(p, sm))
    RUN_PHASE(4, phase_gemm3(p, sm))
    RUN_PHASE(5, phase_route(p, sm))
    RUN_PHASE(6, phase_peer_u(p, sm))
    RUN_PHASE(7, phase_peer_coef(p))
    RUN_PHASE(8, phase_peer_v(p, sm))
#undef RUN_PHASE
}

extern "C" void kernel_launch(void* const* d_in, const int* in_sizes, int n_in, void* d_out, int out_size, void* d_ws, size_t ws_size, hipStream_t stream) {
    static int grid = 0;
    if (grid == 0) {
        int dev = 0, cus = 0, per_cu = 0;
        (void)hipGetDevice(&dev);
        (void)hipDeviceGetAttribute(&cus, hipDeviceAttributeMultiprocessorCount, dev);
        (void)hipOccupancyMaxActiveBlocksPerMultiprocessor(&per_cu, (const void*)fwd_kernel, NT, 0);
        grid = (per_cu >= 1) ? (cus / 8) * 8 : -1;
        if (grid <= 0) fprintf(stderr, "kernel_launch: occupancy query says the kernel does not fit (%d)\n", per_cu);
        if (ws_size < WS_END) { fprintf(stderr, "kernel_launch: workspace too small: %zu < %zu\n", ws_size, (size_t)WS_END); grid = -1; }
    }
    if (grid < 0) return;
    Params p{};
    const float* const* in = (const float* const*)d_in;
    p.x = in[0]; p.meta = in[1]; p.norm1_g = in[2]; p.w_in = in[3]; p.conv_w = in[4]; p.conv_b = in[5]; p.conv_ln_g = in[6]; p.conv_ln_b = in[7];
    p.w_conv_out = in[8]; p.q_norm_g = in[9]; p.k_norm_g = in[10]; p.w_sb_out = in[11]; p.w_gate = in[12]; p.b_gate = in[13]; p.w_o = in[14];
    p.norm2_g = in[15]; p.peer_wq = in[16]; p.peer_k1 = in[17]; p.peer_k2 = in[18]; p.peer_u = in[19]; p.peer_v = in[20];
    p.out = (float*)d_out; p.ws = (unsigned char*)d_ws;
    (void)hipMemsetAsync(d_ws, 0, 16384, stream);
#if MULTI_LAUNCH
    for (int ph = 0; ph < 9; ++ph) {
        p.ph_lo = ph; p.ph_hi = ph + 1;
        hipLaunchKernelGGL(fwd_kernel, dim3(grid), dim3(NT), 0, stream, p);
    }
#else
    p.ph_lo = 0; p.ph_hi = 9;
    void* args[] = {&p};
    hipError_t e = hipLaunchCooperativeKernel((const void*)fwd_kernel, dim3(grid), dim3(NT), args, 0, stream);
    if (e != hipSuccess) fprintf(stderr, "cooperative launch failed: %s (grid %d)\n", hipGetErrorString(e), grid);
#endif
}
```

```cpp
#include <hip/hip_runtime.h>
#include <hip/hip_cooperative_groups.h>
#include <cstdio>
#include <cstdint>
#include <type_traits>
namespace cg = cooperative_groups;

#ifndef MULTI_LAUNCH
#define MULTI_LAUNCH 0
#endif

#define LAS __attribute__((address_space(3)))
#define GAS __attribute__((address_space(1)))
typedef unsigned short bf16_t;
typedef short bf16x8 __attribute__((ext_vector_type(8)));
typedef _Float16 f16x8 __attribute__((ext_vector_type(8)));
typedef float f32x4 __attribute__((ext_vector_type(4)));
typedef float f32x2 __attribute__((ext_vector_type(2)));
typedef unsigned u32x4 __attribute__((ext_vector_type(4)));
typedef unsigned u32x2 __attribute__((ext_vector_type(2)));
typedef int i32x4 __attribute__((ext_vector_type(4)));
typedef int i32x2 __attribute__((ext_vector_type(2)));

constexpr int D = 1024, SEQ = 16384, NMETA = 16, LTOK = SEQ + NMETA, LP2 = 16640;
constexpr int CONVC = 512, CONVW = 31, NH = 8, DH = 64, INC = 2560;
constexpr int PH = 8, NKEYS = 128;
constexpr float EPS = 1e-6f;
constexpr int NT = 512, NWV = 8;
constexpr int LDS_MAIN = 131072, LDS_BYTES = LDS_MAIN + 4096;

constexpr size_t TS = 524288;
constexpr size_t WS_RSTD1 = 16384;
constexpr size_t WS_RSTD2 = WS_RSTD1 + 131072;
constexpr size_t WS_SCU   = WS_RSTD2 + 65536;
constexpr size_t WS_SCV   = WS_SCU + 65536;
constexpr size_t WS_K1    = WS_SCV + 65536;
constexpr size_t WS_K2    = WS_K1 + 262144;
constexpr size_t WS_SSP   = WS_K2 + 262144;
constexpr size_t WS_WCAT  = 4 * TS;
constexpr size_t WS_WVT   = WS_WCAT + 16 * TS;
constexpr size_t WS_W2    = WS_WVT + 2 * TS;
constexpr size_t WS_WO    = WS_W2 + 4 * TS;
constexpr size_t WS_WQ    = WS_WO + 4 * TS;
constexpr size_t WS_HB    = WS_WQ + 8 * TS;
constexpr size_t WS_GATE  = WS_HB + 65 * TS;
constexpr size_t WS_GLU   = WS_GATE + 130 * TS;
constexpr size_t WS_Q     = WS_GLU + (size_t)LP2 * 512 * 2;
constexpr size_t WS_K     = WS_Q + (size_t)LP2 * 512 * 2;
constexpr size_t WS_VT    = WS_K + (size_t)LP2 * 512 * 2;
constexpr size_t WS_CO    = WS_VT + (size_t)LP2 * 512 * 2;
constexpr size_t WS_MIXED = WS_K;
constexpr size_t WS_H2B   = WS_GLU;
constexpr size_t WS_QP    = WS_K;
constexpr size_t WS_PART  = WS_K;
constexpr size_t WS_COEF  = WS_HB;
constexpr size_t WS_PIDX  = WS_GATE;
constexpr size_t WS_PGATE = WS_PIDX + (size_t)SEQ * 128 * 4;
constexpr size_t WS_UB    = WS_CO + (size_t)LP2 * 1024 * 2;
constexpr size_t WS_VB    = WS_UB + (size_t)16384 * 1024;
constexpr size_t WS_END   = WS_VB + (size_t)16384 * 1024;
static_assert(WS_SSP + (size_t)SEQ * 16 * 4 <= WS_WCAT, "small region overflow");
static_assert((size_t)SEQ * 2048 * 2 <= (size_t)LP2 * 512 * 2 * 2 + (size_t)LP2 * 1024 * 2, "qp does not fit");
static_assert((size_t)8 * SEQ * 128 * 4 <= (size_t)LP2 * 512 * 2 * 4, "part does not fit");
constexpr int TILE_WCAT = (int)(WS_WCAT / TS), TILE_WVT = (int)(WS_WVT / TS), TILE_HB = (int)(WS_HB / TS);
constexpr int CTR_MIX = 8, CTR_CONV = 9;

struct Params {
    const float* x; const float* meta; const float* norm1_g; const float* w_in; const float* conv_w; const float* conv_b;
    const float* conv_ln_g; const float* conv_ln_b; const float* w_conv_out; const float* q_norm_g; const float* k_norm_g;
    const float* w_sb_out; const float* w_gate; const float* b_gate; const float* w_o; const float* norm2_g;
    const float* peer_wq; const float* peer_k1; const float* peer_k2; const float* peer_u; const float* peer_v;
    float* out; unsigned char* ws;
    int ph_lo, ph_hi;
};

typedef float pk_f32x2 __attribute__((ext_vector_type(2)));
typedef __bf16 pk_bf16x2 __attribute__((ext_vector_type(2)));
typedef _Float16 pk_f16x2 __attribute__((ext_vector_type(2)));
__device__ __forceinline__ unsigned pack2bf(float lo, float hi) { pk_f32x2 v = {lo, hi}; return __builtin_bit_cast(unsigned, __builtin_convertvector(v, pk_bf16x2)); }
__device__ __forceinline__ unsigned pack2h(float lo, float hi) { pk_f32x2 v = {lo, hi}; return __builtin_bit_cast(unsigned, __builtin_convertvector(v, pk_f16x2)); }
__device__ __forceinline__ float bflo(unsigned u) { return __uint_as_float(u << 16); }
__device__ __forceinline__ float bfhi(unsigned u) { return __uint_as_float(u & 0xFFFF0000u); }
__device__ __forceinline__ float wave_sum(float v) {
#pragma unroll
    for (int o = 32; o > 0; o >>= 1) v += __shfl_xor(v, o);
    return v;
}
__device__ __forceinline__ float wave_max(float v) {
#pragma unroll
    for (int o = 32; o > 0; o >>= 1) v = fmaxf(v, __shfl_xor(v, o));
    return v;
}
__device__ __forceinline__ float sigmoidf_(float x) { return 1.f / (1.f + __expf(-x)); }
__device__ __forceinline__ int tid_opaque() { int t = threadIdx.x; asm volatile("" : "+v"(t)); return t; }
__device__ __forceinline__ int tswz(int r, int c) { return r * 512 + ((((c >> 2) ^ r) & 31) << 4) + ((c & 3) << 2); }

#define XB_TMO      128
#define XB_XCNT(j)  (256  + 64 * (j))
#define XB_XSUB(j)  (1280 + 64 * (j))
#define XB_XGEN(j)  (2304 + 64 * (j))
#define XB_TOP      3328
#define XB_TOPGEN   3392
#define XCD_BAR_WORDS 3456
#define XB_SPIN_CAP (1u << 20)
__device__ __forceinline__ unsigned xb_ld(unsigned* p)              { return __hip_atomic_load(p, __ATOMIC_RELAXED, __HIP_MEMORY_SCOPE_AGENT); }
__device__ __forceinline__ unsigned xb_add(unsigned* p, unsigned v) { return __hip_atomic_fetch_add(p, v, __ATOMIC_RELAXED, __HIP_MEMORY_SCOPE_AGENT); }
__device__ __forceinline__ unsigned xb_xcc_id() { return (unsigned)__builtin_amdgcn_s_getreg((3 << 11) | 20) & 0xFu; }
#define XB_SPIN(cond, bar) do { unsigned _sp = 0; while (cond) { __builtin_amdgcn_s_sleep(1); \
    if ((++_sp & 255u) == 0u) { if (xb_ld(&(bar)[XB_TMO])) break; if (_sp > XB_SPIN_CAP) { atomicAdd(&(bar)[XB_TMO], 1u); break; } } } } while (0)
struct XcdBarrier { unsigned* bar; unsigned x; volatile LAS unsigned* st; };
__device__ __forceinline__ XcdBarrier xcd_barrier_post(unsigned* bar, volatile LAS unsigned* st) {
    XcdBarrier b; b.bar = bar; b.x = xb_xcc_id(); b.st = st;
    if (threadIdx.x == 0) (void)xb_add(&bar[XB_XCNT(b.x)], 1u);
    return b;
}
__device__ __forceinline__ void xcd_barrier_complete(unsigned* bar, unsigned x, unsigned& nloc, unsigned& nx) {
    const unsigned G = gridDim.x * gridDim.y * gridDim.z;
    unsigned sum, cnt, mine, sp = 0u;
    for (;;) {
        sum = 0u; cnt = 0u; mine = 0u;
#pragma unroll
        for (unsigned j = 0; j < 16; ++j) { const unsigned c = xb_ld(&bar[XB_XCNT(j)]); sum += c; cnt += (c > 0u) ? 1u : 0u; mine = (j == x) ? c : mine; }
        if (sum == G) break;
        __builtin_amdgcn_s_sleep(1);
        if ((++sp & 255u) == 0u) { if (xb_ld(&bar[XB_TMO])) break; if (sp > XB_SPIN_CAP) { atomicAdd(&bar[XB_TMO], 1u); break; } }
    }
    nloc = mine > 0u ? mine : 1u; nx = cnt > 0u ? cnt : 1u;
}
__device__ __forceinline__ void xcd_barrier(const XcdBarrier& b) {
    asm volatile("s_waitcnt vmcnt(0)" ::: "memory");
    __syncthreads();
    if (threadIdx.x == 0) {
        unsigned* bar = b.bar;
        __builtin_amdgcn_s_waitcnt(0);
        unsigned nloc = b.st[0], nx = b.st[1];
        if (nloc == 0u) { xcd_barrier_complete(bar, b.x, nloc, nx); b.st[0] = nloc; b.st[1] = nx; }
        const unsigned old = xb_add(&bar[XB_XSUB(b.x)], 1u);
        const unsigned gen = old / nloc;
        if (old + 1u == (gen + 1u) * nloc) {
            __builtin_amdgcn_fence(__ATOMIC_RELEASE, "agent");
            asm volatile("s_waitcnt vmcnt(0)" ::: "memory");
            const unsigned og = xb_add(&bar[XB_TOP], 1u);
            const unsigned tg = og / nx;
            if (og + 1u == (tg + 1u) * nx) xb_add(&bar[XB_TOPGEN], 1u);
            else XB_SPIN(xb_ld(&bar[XB_TOPGEN]) == tg, bar);
            __builtin_amdgcn_fence(__ATOMIC_ACQUIRE, "agent");
            xb_add(&bar[XB_XGEN(b.x)], 1u);
            asm volatile("s_waitcnt vmcnt(0)" ::: "memory");
        } else {
            XB_SPIN(xb_ld(&bar[XB_XGEN(b.x)]) == gen, bar);
            __builtin_amdgcn_fence(__ATOMIC_ACQUIRE, "agent");
            asm volatile("s_waitcnt vmcnt(0)" ::: "memory");
        }
    }
    __syncthreads();
}

namespace pg8 {
constexpr int BM = 256, BK = 64, HALF = 128, HTB = HALF * BK * 2, STAGE_BYTES = 8 * HTB;
__host__ __device__ __forceinline__ int lds_byte(int r, int c) { const int st = (r >> 4) * 2 + (c >> 5), rr = r & 15, cc = c & 31, ob = rr * 64 + cc * 2; return st * 1024 + (ob ^ (((ob >> 9) & 1) << 5)); }
__host__ __device__ __forceinline__ void stage_rc(int b, int& R, int& C) { const int st = b / 1024, sb = b % 1024, swz = sb ^ (((sb >> 9) & 1) << 5); R = (st >> 1) * 16 + swz / 64; C = (st & 1) * 32 + (swz % 64) / 2; }
__host__ __device__ __forceinline__ int perm32(int rho) { const int n = rho >> 4, i = rho & 15; return 8 * (i >> 2) + 4 * n + (i & 3); }
struct Unit { int pm, pn; };
struct Gemm { const bf16_t* A; const bf16_t* Bt; int K; };

template <class Epi, class Sched>
__device__ __forceinline__ void gemm_phase(LAS unsigned char* lds, const Gemm g, const Sched& S, const Epi& E) {
    const int tid = threadIdx.x, wid = __builtin_amdgcn_readfirstlane(tid >> 6), lane = tid & 63, wr = wid >> 2, wc = wid & 3, fr = lane & 15, fq = lane >> 4;
    const int K = g.K, nt = K / BK;
    unsigned voffA[2], voffB[2];
#pragma unroll
    for (int i = 0; i < 2; ++i) { int R, C; stage_rc(tid * 16 + i * 8192, R, C); const int Rb = (R & ~31) + perm32(R & 31);
        voffA[i] = (unsigned)(R * K + C) * 2u; voffB[i] = (unsigned)(Rb * K + C) * 2u; }
    const size_t kstep = (size_t)(BK * 2);
    const size_t hstep = (size_t)HALF * K * 2;
    const size_t tstep = 2 * hstep;
    const unsigned ldsw = (unsigned)wid * 1024u;
    const int aoff = lds_byte(wr * 64 + fr, fq * 8), boff = lds_byte(wc * 32 + fr, fq * 8);
#define PG8_SA(b, h) (((b) * 2 + (h)) * HTB)
#define PG8_SB(b, h) ((4 + (b) * 2 + (h)) * HTB)
#define PG8_STAGE(bufoff, gbase, voff) do { _Pragma("unroll") for (int _i = 0; _i < 2; ++_i) \
        __builtin_amdgcn_global_load_lds((const GAS unsigned*)((const char*)(gbase) + (voff)[_i]), (LAS unsigned*)(lds + (bufoff) + ldsw + _i * 8192), 16, 0, 0); } while (0)
#define PG8_LDA(dst, b, h) do { _Pragma("unroll") for (int m = 0; m < 4; ++m) _Pragma("unroll") for (int k = 0; k < 2; ++k) dst[m][k] = *(const LAS bf16x8*)(lds + PG8_SA(b, h) + aoff + m * 2048 + k * 1024); } while (0)
#define PG8_LDB(dst, b, h) do { _Pragma("unroll") for (int n = 0; n < 2; ++n) _Pragma("unroll") for (int k = 0; k < 2; ++k) dst[n][k] = *(const LAS bf16x8*)(lds + PG8_SB(b, h) + boff + n * 2048 + k * 1024); } while (0)
#define PG8_MMA(ai, bj, At, Bt) do { __builtin_amdgcn_s_setprio(1); _Pragma("unroll") for (int m = 0; m < 4; ++m) _Pragma("unroll") for (int n = 0; n < 2; ++n) _Pragma("unroll") for (int k = 0; k < 2; ++k) \
        acc[ai][bj][m][n] = __builtin_amdgcn_mfma_f32_16x16x32_bf16(Bt[n][k], At[m][k], acc[ai][bj][m][n], 0, 0, 0); __builtin_amdgcn_s_setprio(0); } while (0)
#define PG8_WAIT_V(n) asm volatile("s_waitcnt vmcnt(" #n ")" ::: "memory")
#define PG8_WAIT_L(n) asm volatile("s_waitcnt lgkmcnt(" #n ")" ::: "memory")
#define PG8_BAR __builtin_amdgcn_s_barrier()
#define PG8_SCHED __builtin_amdgcn_sched_barrier(0)
    Unit cur, nxt; int ui = 0;
    if (!S.next(0, cur)) return;
    f32x4 acc[2][2][4][2];
#pragma unroll
    for (int a = 0; a < 2; ++a)
#pragma unroll
        for (int b = 0; b < 2; ++b)
#pragma unroll
            for (int m = 0; m < 4; ++m)
#pragma unroll
                for (int n = 0; n < 2; ++n) acc[a][b][m][n] = (f32x4){0.f, 0.f, 0.f, 0.f};
    bf16x8 At[4][2], B0[2][2], B1[2][2];
    const char* cA = (const char*)g.A + (size_t)cur.pm * tstep; const char* cB = (const char*)g.Bt + (size_t)cur.pn * tstep;
    PG8_STAGE(PG8_SB(0, 0), cB, voffB); PG8_STAGE(PG8_SA(0, 0), cA, voffA); PG8_STAGE(PG8_SB(0, 1), cB + hstep, voffB); PG8_STAGE(PG8_SA(0, 1), cA + hstep, voffA);
    if (wr == 1) PG8_BAR;
    PG8_WAIT_V(4); PG8_BAR;
    PG8_STAGE(PG8_SB(1, 0), cB + kstep, voffB); PG8_STAGE(PG8_SA(1, 0), cA + kstep, voffA); PG8_STAGE(PG8_SB(1, 1), cB + hstep + kstep, voffB);
    PG8_WAIT_V(6); PG8_BAR;
    for (;;) {
        const bool has_next = S.next(ui + 1, nxt);
        const char* nA = has_next ? (const char*)g.A + (size_t)nxt.pm * tstep : cA; const char* nB = has_next ? (const char*)g.Bt + (size_t)nxt.pn * tstep : cB;
        for (int t = 0; t < nt; t += 2) {
            const bool last = (t == nt - 2);
            const char* a1 = cA + (size_t)(t + 1) * kstep;
            const char* a2 = last ? nA : cA + (size_t)(t + 2) * kstep; const char* b2 = last ? nB : cB + (size_t)(t + 2) * kstep;
            const char* a3 = a2 + kstep; const char* b3 = b2 + kstep;
            if constexpr (Epi::HAS_MID) { if (t == nt / 2) E.mid(acc, cur, wr, wc, fr, fq); }
            PG8_LDB(B0, 0, 0); PG8_SCHED; PG8_LDA(At, 0, 0); PG8_STAGE(PG8_SA(1, 1), a1 + hstep, voffA);
            PG8_WAIT_L(8); PG8_BAR; PG8_WAIT_L(0); PG8_MMA(0, 0, At, B0); PG8_BAR; PG8_SCHED;
            PG8_LDB(B1, 0, 1); PG8_STAGE(PG8_SB(0, 0), b2, voffB);
            PG8_BAR; PG8_WAIT_L(0); PG8_MMA(0, 1, At, B1); PG8_BAR;
            PG8_LDA(At, 0, 1); PG8_STAGE(PG8_SA(0, 0), a2, voffA);
            PG8_BAR; PG8_WAIT_L(0); PG8_MMA(1, 0, At, B0); PG8_BAR; PG8_SCHED;
            PG8_STAGE(PG8_SB(0, 1), b2 + hstep, voffB);
            PG8_WAIT_V(6); PG8_BAR; PG8_MMA(1, 1, At, B1); PG8_BAR;
            PG8_LDB(B0, 1, 0); PG8_SCHED; PG8_LDA(At, 1, 0); PG8_STAGE(PG8_SA(0, 1), a2 + hstep, voffA);
            PG8_WAIT_L(8); PG8_BAR; PG8_WAIT_L(0); PG8_MMA(0, 0, At, B0); PG8_BAR; PG8_SCHED;
            PG8_LDB(B1, 1, 1); PG8_STAGE(PG8_SB(1, 0), b3, voffB);
            PG8_BAR; PG8_WAIT_L(0); PG8_MMA(0, 1, At, B1); PG8_BAR;
            PG8_LDA(At, 1, 1); PG8_STAGE(PG8_SA(1, 0), a3, voffA);
            PG8_BAR; PG8_WAIT_L(0); PG8_MMA(1, 0, At, B0); PG8_BAR; PG8_SCHED;
            PG8_STAGE(PG8_SB(1, 1), b3 + hstep, voffB);
            PG8_WAIT_V(6); PG8_BAR; PG8_MMA(1, 1, At, B1); PG8_BAR;
        }
        E(acc, cur, wr, wc, fr, fq);
        if (!has_next) break;
#pragma unroll
        for (int a = 0; a < 2; ++a)
#pragma unroll
            for (int b = 0; b < 2; ++b)
#pragma unroll
                for (int m = 0; m < 4; ++m)
#pragma unroll
                    for (int n = 0; n < 2; ++n) acc[a][b][m][n] = (f32x4){0.f, 0.f, 0.f, 0.f};
        cur = nxt; cA = nA; cB = nB; ++ui;
    }
    PG8_WAIT_V(0);
    if (wr == 0) PG8_BAR;
    PG8_BAR;
#undef PG8_SA
#undef PG8_SB
#undef PG8_STAGE
#undef PG8_LDA
#undef PG8_LDB
#undef PG8_MMA
#undef PG8_WAIT_V
#undef PG8_WAIT_L
#undef PG8_BAR
#undef PG8_SCHED
}
struct LinearOrder {
    int c, G, n;
    __device__ __forceinline__ int unit_id(int i) const { return ((i * 8 + (c & 7)) * (G >> 3)) + (c >> 3); }
};
}

__device__ void convert_tables(const Params& p, LAS char* sm) {
    const int tid = tid_opaque(), lane = tid & 63, wid = tid >> 6;
    unsigned char* ub = p.ws + WS_UB; unsigned char* vb = p.ws + WS_VB;
    float* scu = (float*)(p.ws + WS_SCU); float* scv = (float*)(p.ws + WS_SCV);
    unsigned* ctr = (unsigned*)p.ws + CTR_CONV;
    LAS int* slot = (LAS int*)(sm + LDS_MAIN + 128);
    for (;;) {
        if (threadIdx.x == 0) *slot = (int)atomicAdd(ctr, 1u);
        __syncthreads();
        const int chunk = *slot;
        __syncthreads();
        if (chunk >= 2 * 16384 / 64) break;
        const int r8 = chunk * 8 + wid;
        const int row0 = r8 * 8;
        const bool isv = row0 >= 16384; const int e0 = isv ? row0 - 16384 : row0;
        const float* src = (isv ? p.peer_v : p.peer_u) + (size_t)e0 * D + 16 * lane;
        f32x4 a[8][4];
#pragma unroll
        for (int r = 0; r < 8; ++r)
#pragma unroll
            for (int i = 0; i < 4; ++i) a[r][i] = *(const f32x4*)(src + (size_t)r * D + 4 * i);
        if (!isv) {
#pragma unroll
            for (int i = 0; i < 4; ++i) { const f32x4 gg = *(const f32x4*)(p.norm2_g + 16 * lane + 4 * i);
#pragma unroll
                for (int r = 0; r < 8; ++r) a[r][i] = a[r][i] * gg; }
        }
#pragma unroll
        for (int r = 0; r < 8; ++r) {
            float am = 0.f;
#pragma unroll
            for (int i = 0; i < 4; ++i) am = fmaxf(am, fmaxf(fmaxf(fabsf(a[r][i][0]), fabsf(a[r][i][1])), fmaxf(fabsf(a[r][i][2]), fabsf(a[r][i][3]))));
            am = wave_max(am);
            u32x4 o;
            if (isv) {
                const float sc = am > 0.f ? 448.f / am : 1.f;
#pragma unroll
                for (int i = 0; i < 4; ++i) {
                    int w = 0;
                    w = __builtin_amdgcn_cvt_pk_fp8_f32(a[r][i][0] * sc, a[r][i][1] * sc, w, false);
                    w = __builtin_amdgcn_cvt_pk_fp8_f32(a[r][i][2] * sc, a[r][i][3] * sc, w, true);
                    o[i] = (unsigned)w;
                }
                *(u32x4*)(vb + ((size_t)(lane >> 3) * 16384 + (e0 + r)) * 128 + 16 * (lane & 7)) = o;
                if (lane == 0) scv[e0 + r] = am > 0.f ? am * (1.f / 448.f) : 1.f;
            } else {
                const float sc = am > 0.f ? 127.f / am : 0.f;
#pragma unroll
                for (int i = 0; i < 4; ++i) {
                    const int q0 = __float2int_rn(a[r][i][0] * sc), q1 = __float2int_rn(a[r][i][1] * sc), q2 = __float2int_rn(a[r][i][2] * sc), q3 = __float2int_rn(a[r][i][3] * sc);
                    o[i] = (unsigned)(q0 & 255) | ((unsigned)(q1 & 255) << 8) | ((unsigned)(q2 & 255) << 16) | ((unsigned)q3 << 24);
                }
                *(u32x4*)(ub + ((size_t)(lane >> 3) * 16384 + (e0 + r)) * 128 + 16 * (lane & 7)) = o;
                if (lane == 0) scu[e0 + r] = am * (1.f / 127.f);
            }
        }
    }
}
__device__ void phase_prep(const Params& p, LAS char* sm) {
    const int tid = tid_opaque(), lane = tid & 63, wid = tid >> 6;
    const int G = gridDim.x, b = blockIdx.x;
    const int gwv = b * NWV + wid, nwv = G * NWV;
    bf16_t* hb = (bf16_t*)(p.ws + WS_HB);
    float* rstd1 = (float*)(p.ws + WS_RSTD1);
    constexpr int J0 = 64 * 16, J1 = J0 + 8 * 16, J2 = J1 + 16 * 16, J3 = J2 + 16 * 16, J4 = J3;
    LAS float* T = (LAS float*)(sm + wid * 16640);
    for (int it = gwv; it < J4; it += nwv) {
        const float* src; int N, col, kt, rt, koff = 0; bf16_t* dst; const float* g = nullptr;
        if (it < J0) {
            kt = it >> 6; rt = it & 63; g = p.norm1_g; dst = (bf16_t*)(p.ws + WS_WCAT);
            const int R = rt * 64 + lane, u = R >> 8, t = R & 255;
            if (u < 4) { src = p.w_in; N = INC; col = t < 128 ? (128 * u + t) : (512 + 128 * u + t - 128); }
            else if (u < 8) { src = p.w_in; N = INC; const int head = 4 * ((u - 4) & 1) + ((t >> 5) & 3), d = 32 * (t >> 7) + 16 * ((t >> 4) & 1) + (t & 15); col = (u < 6 ? 1024 : 1536) + 64 * head + d; }
            else { src = p.w_gate; N = 2048; col = t < 128 ? (128 * (u - 8) + t) : (1024 + 128 * (u - 8) + t - 128); }
        } else if (it < J1) { const int q = it - J0; kt = q >> 3; rt = q & 7; g = p.norm1_g; dst = (bf16_t*)(p.ws + WS_WVT); src = p.w_in; N = INC; col = 2048 + rt * 64 + lane; }
        else if (it < J2) {
            const int q = it - J1; kt = q >> 4; rt = q & 15; dst = (bf16_t*)(p.ws + WS_W2); N = 1024; col = rt * 64 + lane;
            if (kt < 8) src = p.w_conv_out; else { src = p.w_sb_out; koff = -512; }
        } else if (it < J3) { const int q = it - J2; kt = q >> 4; rt = q & 15; dst = (bf16_t*)(p.ws + WS_WO); src = p.w_o; N = 1024; col = rt * 64 + lane; }
        else break;
        const int k0 = kt * 64;
        {
            float v[64];
#pragma unroll
            for (int k = 0; k < 64; ++k) v[k] = src[(size_t)(k0 + k + koff) * N + col];
#pragma unroll
            for (int k = 0; k < 64; ++k) T[k * 65 + lane] = v[k];
            __builtin_amdgcn_wave_barrier();
            asm volatile("s_waitcnt lgkmcnt(0)" ::: "memory");
            const int ko = lane & 7, nl = lane >> 3;
            f32x4 g0 = (f32x4){1.f, 1.f, 1.f, 1.f}, g1 = g0;
            if (g) { g0 = *(const f32x4*)(g + k0 + 8 * ko); g1 = *(const f32x4*)(g + k0 + 8 * ko + 4); }
#pragma unroll
            for (int nb = 0; nb < 8; ++nb) {
                const int n = nb * 8 + nl;
                float t[8];
#pragma unroll
                for (int j = 0; j < 8; ++j) t[j] = T[(8 * ko + j) * 65 + n];
                u32x4 o; o[0] = pack2bf(t[0] * g0[0], t[1] * g0[1]); o[1] = pack2bf(t[2] * g0[2], t[3] * g0[3]); o[2] = pack2bf(t[4] * g1[0], t[5] * g1[1]); o[3] = pack2bf(t[6] * g1[2], t[7] * g1[3]);
                *(u32x4*)(dst + (size_t)(rt * 64 + n) * D + k0 + 8 * ko) = o;
            }
            __builtin_amdgcn_wave_barrier();
            asm volatile("s_waitcnt lgkmcnt(0)" ::: "memory");
        }
    }
    {
        bf16_t* wf = (bf16_t*)(p.ws + WS_WQ);
        const int fr = lane & 15, fq = lane >> 4;
        for (int it = gwv; it < 128 * 64; it += nwv) {
            const int nt16 = it >> 6, kt16 = it & 63;
            const int hh = nt16 >> 3, key0 = (nt16 & 7) * 16, k0 = kt16 * 16;
            const float* ka = ((hh & 1) ? p.peer_k2 : p.peer_k1) + ((size_t)(hh >> 1) * 128 + key0 + fr) * 128 + 32 * fq;
            const float* wb = p.peer_wq + (size_t)(k0 + fr) * 2048 + hh * 128 + 32 * fq;
            f32x4 av[8], bv[8];
#pragma unroll
            for (int c = 0; c < 8; ++c) { av[c] = *(const f32x4*)(ka + 4 * c); bv[c] = *(const f32x4*)(wb + 4 * c); }
            f32x4 acc = (f32x4){0.f, 0.f, 0.f, 0.f};
#pragma unroll
            for (int st = 0; st < 32; ++st) acc = __builtin_amdgcn_mfma_f32_16x16x4f32(bv[st >> 2][st & 3], av[st >> 2][st & 3], acc, 0, 0, 0);
            const f32x4 gk = *(const f32x4*)(p.norm2_g + k0 + 4 * fq);
            u32x2 o; o[0] = pack2bf(acc[0] * gk[0], acc[1] * gk[1]); o[1] = pack2bf(acc[2] * gk[2], acc[3] * gk[3]);
            *(u32x2*)(wf + (size_t)(hh * 128 + key0 + fr) * D + k0 + 4 * fq) = o;
        }
    }
    for (int r0 = gwv; r0 < LP2; r0 += 4 * nwv) {
        f32x4 v[4][4];
#pragma unroll
        for (int r = 0; r < 4; ++r) {
            const int row = r0 + r * nwv;
            const float* src = row < NMETA ? p.meta + (size_t)row * D : (row < LTOK ? p.x + (size_t)(row - NMETA) * D : nullptr);
#pragma unroll
            for (int i = 0; i < 4; ++i) { v[r][i] = (f32x4){0.f, 0.f, 0.f, 0.f}; if (src) v[r][i] = *(const f32x4*)(src + lane * 4 + 256 * i); }
        }
#pragma unroll
        for (int r = 0; r < 4; ++r) {
            const int row = r0 + r * nwv;
            if (row < LP2) {
                float ss = 0.f;
#pragma unroll
                for (int i = 0; i < 4; ++i) {
                    ss += v[r][i][0] * v[r][i][0] + v[r][i][1] * v[r][i][1] + v[r][i][2] * v[r][i][2] + v[r][i][3] * v[r][i][3];
                    u32x2 o; o[0] = pack2bf(v[r][i][0], v[r][i][1]); o[1] = pack2bf(v[r][i][2], v[r][i][3]);
                    *(u32x2*)(hb + (size_t)row * D + lane * 4 + 256 * i) = o;
                }
                ss = wave_sum(ss);
                if (lane == 0) rstd1[row] = rsqrtf(ss * (1.f / D) + EPS);
            }
        }
    }
}

struct OrderP1 : pg8::LinearOrder {
    __device__ __forceinline__ bool next(int i, pg8::Unit& u) const {
        const int L = unit_id(i);
        if (L >= 1040 + 130) return false;
        if (L < 1040) { u.pm = TILE_HB + (L >> 4); u.pn = TILE_WCAT + (L & 15); }
        else { const int q = L - 1040; u.pm = TILE_WVT + (q & 1); u.pn = TILE_HB + (q >> 1); }
        return true;
    }
};
struct EpiP1 {
    static constexpr bool HAS_MID = false;
    const float* rstd1; bf16_t* glu; bf16_t* qo; bf16_t* ko; bf16_t* vt; bf16_t* gate; const float* qg; const float* kg; const float* bgate;
    __device__ __forceinline__ void operator()(const f32x4 (&acc)[2][2][4][2], const pg8::Unit& u, int wr, int wc, int fr_, int fq_) const {
        int fr = fr_, fq = fq_; asm volatile("" : "+v"(fr), "+v"(fq));
        if (u.pm >= TILE_WVT && u.pm < TILE_WVT + 2) {
            const int s0 = 256 * (u.pn - TILE_HB);
            f32x4 rs[2][2];
#pragma unroll
            for (int bj = 0; bj < 2; ++bj)
#pragma unroll
                for (int n = 0; n < 2; ++n) rs[bj][n] = *(const f32x4*)(rstd1 + s0 + 128 * bj + 32 * wc + 8 * fq + 4 * n);
            asm volatile("s_waitcnt vmcnt(0)" ::: "memory");
#pragma unroll
            for (int bj = 0; bj < 2; ++bj) {
                const int s = s0 + 128 * bj + 32 * wc + 8 * fq;
#pragma unroll
                for (int ai = 0; ai < 2; ++ai)
#pragma unroll
                    for (int m = 0; m < 4; ++m) {
                        const int rv = 256 * (u.pm - TILE_WVT) + 128 * ai + 64 * wr + 16 * m + fr, head = rv >> 6, d = rv & 63;
                        const f32x4 v0 = acc[ai][bj][m][0] * rs[bj][0], v1 = acc[ai][bj][m][1] * rs[bj][1];
                        u32x4 o; o[0] = pack2h(v0[0], v0[1]); o[1] = pack2h(v0[2], v0[3]); o[2] = pack2h(v1[0], v1[1]); o[3] = pack2h(v1[2], v1[3]);
                        *(u32x4*)(vt + (((size_t)head * (LP2 / 64) + (s >> 6)) * 64 + d) * 64 + (s & 63)) = o;
                    }
            }
            return;
        }
        const int pmr = u.pm - TILE_HB, un = u.pn - TILE_WCAT;
        const int row0 = 256 * pmr + 64 * wr + fr;
        float scv[2][4];
#pragma unroll
        for (int ai = 0; ai < 2; ++ai)
#pragma unroll
            for (int m = 0; m < 4; ++m) scv[ai][m] = rstd1[row0 + 128 * ai + 16 * m];
        f32x4 aux[2][2];
        if (un >= 4) {
            const bool isq = un < 6;
            const float* ap = un < 8 ? (isq ? qg : kg) : (bgate + 128 * (un - 8) + 32 * wc);
#pragma unroll
            for (int bj = 0; bj < 2; ++bj)
#pragma unroll
                for (int n = 0; n < 2; ++n) aux[bj][n] = *(const f32x4*)(ap + (un < 8 ? 32 : 1024) * bj + 8 * fq + 4 * n);
        }
        asm volatile("s_waitcnt vmcnt(0)" ::: "memory");
#pragma unroll
        for (int ai = 0; ai < 2; ++ai)
#pragma unroll
            for (int m = 0; m < 4; ++m) {
                const int row = row0 + 128 * ai + 16 * m;
                const float sc = scv[ai][m];
                if (un < 4) {
                    u32x4 o;
#pragma unroll
                    for (int n = 0; n < 2; ++n) {
                        const f32x4 a = acc[ai][0][m][n] * sc, gt = acc[ai][1][m][n] * sc;
                        o[2 * n] = pack2bf(a[0] * sigmoidf_(gt[0]), a[1] * sigmoidf_(gt[1])); o[2 * n + 1] = pack2bf(a[2] * sigmoidf_(gt[2]), a[3] * sigmoidf_(gt[3]));
                    }
                    *(u32x4*)(glu + (size_t)row * CONVC + 128 * un + 32 * wc + 8 * fq) = o;
                } else if (un < 8) {
                    const bool isq = un < 6;
                    const int head = 4 * ((un - 4) & 1) + wc;
                    float ss = 0.f;
#pragma unroll
                    for (int bj = 0; bj < 2; ++bj)
#pragma unroll
                        for (int n = 0; n < 2; ++n) { const f32x4 v = acc[ai][bj][m][n]; ss += v[0] * v[0] + v[1] * v[1] + v[2] * v[2] + v[3] * v[3]; }
                    ss += __shfl_xor(ss, 16); ss += __shfl_xor(ss, 32);
                    const float r2 = rsqrtf(ss * sc * sc * (1.f / 64.f) + EPS) * (isq ? 0.125f * 1.44269504088896341f : 1.f) * sc;
                    bf16_t* dst = (isq ? qo : ko) + ((size_t)head * LP2 + row) * DH;
#pragma unroll
                    for (int bj = 0; bj < 2; ++bj) {
                        const f32x4 v0 = acc[ai][bj][m][0] * aux[bj][0] * r2, v1 = acc[ai][bj][m][1] * aux[bj][1] * r2;
                        u32x4 o; o[0] = pack2bf(v0[0], v0[1]); o[1] = pack2bf(v0[2], v0[3]); o[2] = pack2bf(v1[0], v1[1]); o[3] = pack2bf(v1[2], v1[3]);
                        *(u32x4*)(dst + 32 * bj + 8 * fq) = o;
                    }
                } else {
                    const int col = 128 * (un - 8) + 32 * wc + 8 * fq;
                    u32x4 orat, ogs;
#pragma unroll
                    for (int n = 0; n < 2; ++n) {
                        const f32x4 vc = acc[ai][0][m][n] * sc + aux[0][n], vs = acc[ai][1][m][n] * sc + aux[1][n];
                        float rt_[4], gs_[4];
#pragma unroll
                        for (int e = 0; e < 4; ++e) { const float ec = __expf(-vc[e]), es = __expf(-vs[e]); gs_[e] = 1.f / (1.f + es); rt_[e] = (1.f + es) / (1.f + ec); }
                        orat[2 * n] = pack2bf(rt_[0], rt_[1]); orat[2 * n + 1] = pack2bf(rt_[2], rt_[3]);
                        ogs[2 * n] = pack2bf(gs_[0], gs_[1]); ogs[2 * n + 1] = pack2bf(gs_[2], gs_[3]);
                    }
                    *(u32x4*)(gate + (size_t)row * 2048 + col) = orat;
                    *(u32x4*)(gate + (size_t)row * 2048 + 1024 + col) = ogs;
                }
            }
    }
};
__device__ void phase_gemm1(const Params& p, LAS char* sm) {
    OrderP1 S; S.c = blockIdx.x; S.G = gridDim.x; S.n = 0;
    EpiP1 E{(const float*)(p.ws + WS_RSTD1), (bf16_t*)(p.ws + WS_GLU), (bf16_t*)(p.ws + WS_Q), (bf16_t*)(p.ws + WS_K), (bf16_t*)(p.ws + WS_VT), (bf16_t*)(p.ws + WS_GATE),
            p.q_norm_g, p.k_norm_g, p.b_gate};
    pg8::Gemm g{(const bf16_t*)p.ws, (const bf16_t*)p.ws, D};
    pg8::gemm_phase((LAS unsigned char*)sm, g, S, E);
    convert_tables(p, sm);
}

__device__ void conv_item(const Params& p, LAS char* sm, int item) {
    const int tid = tid_opaque(), lane = tid & 63, wid = tid >> 6;
    const bf16_t* glu = (const bf16_t*)(p.ws + WS_GLU);
    bf16_t* co = (bf16_t*)(p.ws + WS_CO);
    const int t0 = item * 32;
    {
        u32x4 v[8];
#pragma unroll
        for (int i = 0; i < 8; ++i) {
            const int c = tid + i * NT, row = c >> 6, ch = c & 63, g = t0 - 30 + row;
            v[i] = (u32x4){0u, 0u, 0u, 0u};
            if (c < 62 * 64 && g >= 0) v[i] = *(const u32x4*)(glu + (size_t)g * CONVC + ch * 8);
        }
#pragma unroll
        for (int i = 0; i < 8; ++i) {
            const int c = tid + i * NT, row = c >> 6, ch = c & 63;
            if (c < 62 * 64) *(LAS u32x4*)(sm + row * 1024 + ch * 16) = v[i];
        }
    }
    float wa[CONVW];
#pragma unroll
    for (int j = 0; j < CONVW; ++j) wa[j] = p.conv_w[j * CONVC + tid];
    const float bias = p.conv_b[tid];
    float aa[32];
#pragma unroll
    for (int r = 0; r < 32; ++r) aa[r] = bias;
    __syncthreads();
#pragma unroll
    for (int i = 0; i < 62; ++i) {
        const float xa = __uint_as_float((unsigned)(*(LAS unsigned short*)(sm + i * 1024 + tid * 2)) << 16);
#pragma unroll
        for (int r = 0; r < 32; ++r) {
            const int j = i - r;
            if (j >= 0 && j < CONVW) aa[r] += wa[j] * xa;
        }
    }
    __syncthreads();
#pragma unroll
    for (int r = 0; r < 32; ++r) *(LAS float*)(sm + (r * 516 + tid) * 4) = aa[r];
    __syncthreads();
    const f32x4 g0 = *(const f32x4*)(p.conv_ln_g + lane * 4), g1 = *(const f32x4*)(p.conv_ln_g + 256 + lane * 4);
    const f32x4 b0 = *(const f32x4*)(p.conv_ln_b + lane * 4), b1 = *(const f32x4*)(p.conv_ln_b + 256 + lane * 4);
#pragma unroll 1
    for (int rr = 0; rr < 4; ++rr) {
        const int r = wid * 4 + rr;
        f32x4 v0 = *(LAS f32x4*)(sm + (r * 516 + lane * 4) * 4), v1 = *(LAS f32x4*)(sm + (r * 516 + 256 + lane * 4) * 4);
        float s = v0[0] + v0[1] + v0[2] + v0[3] + v1[0] + v1[1] + v1[2] + v1[3];
        s = wave_sum(s);
        const float mu = s * (1.f / CONVC);
        float q = 0.f;
#pragma unroll
        for (int e = 0; e < 4; ++e) { v0[e] -= mu; v1[e] -= mu; q += v0[e] * v0[e] + v1[e] * v1[e]; }
        q = wave_sum(q);
        const float rstd = rsqrtf(q * (1.f / CONVC) + EPS);
        float y0[4], y1[4];
#pragma unroll
        for (int e = 0; e < 4; ++e) {
            float a = v0[e] * rstd * g0[e] + b0[e]; y0[e] = a * sigmoidf_(a);
            float c = v1[e] * rstd * g1[e] + b1[e]; y1[e] = c * sigmoidf_(c);
        }
        const int t = t0 + r;
        u32x2 o; o[0] = pack2bf(y0[0], y0[1]); o[1] = pack2bf(y0[2], y0[3]);
        *(u32x2*)(co + (size_t)t * D + lane * 4) = o;
        o[0] = pack2bf(y1[0], y1[1]); o[1] = pack2bf(y1[2], y1[3]);
        *(u32x2*)(co + (size_t)t * D + 256 + lane * 4) = o;
    }
    __syncthreads();
}

__device__ void attn_item(const Params& p, LAS char* sm, int head, int qb) {
    const int tid = tid_opaque(), lane = tid & 63, w = __builtin_amdgcn_readfirstlane(tid >> 6), fr = lane & 15, fq = lane >> 4;
    const bf16_t* Qh = (const bf16_t*)(p.ws + WS_Q) + (size_t)head * LP2 * DH;
    const bf16_t* Kh = (const bf16_t*)(p.ws + WS_K) + (size_t)head * LP2 * DH;
    const bf16_t* Vth = (const bf16_t*)(p.ws + WS_VT) + (size_t)head * (LP2 / 64) * 4096;
    bf16_t* og = (bf16_t*)(p.ws + WS_CO) + 512;
    LAS char* Ks = sm;
    LAS char* Vs = sm + 8192;
    LAS char* LK = sm + 16384 + w * 8192;
    LAS char* PS = LK + 4096;
    LAS float* flags = (LAS float*)(sm + LDS_MAIN);
    const int trb0 = qb * 256 + 16 * w, trb1 = trb0 + 128;
    bf16x8 qf[2][2];
#pragma unroll
    for (int nt = 0; nt < 2; ++nt)
#pragma unroll
        for (int kh = 0; kh < 2; ++kh) qf[nt][kh] = *(const bf16x8*)(Qh + (size_t)((nt ? trb1 : trb0) + fr) * DH + 32 * kh + 8 * fq);
    f32x4 oT[4][2];
#pragma unroll
    for (int i = 0; i < 4; ++i) { oT[i][0] = (f32x4){0.f, 0.f, 0.f, 0.f}; oT[i][1] = (f32x4){0.f, 0.f, 0.f, 0.f}; }
    float R[2] = {0.f, 0.f};
    const int swz = fr & 7;
    const int prow = tid >> 3, pc = (tid & 7) ^ (prow & 7);
    int kt = 4 * qb + 3;
    u32x4 kv = *(const u32x4*)(Kh + (size_t)(kt * 64 + prow) * DH + pc * 8);
    u32x4 vv = *(const u32x4*)(Vth + (size_t)kt * 4096 + prow * 64 + pc * 8);
    auto tile = [&](auto MASKED_T, auto A0_T, auto A1_T, int s0) {
        constexpr bool MASKED = decltype(MASKED_T)::value, a0 = decltype(A0_T)::value, a1 = decltype(A1_T)::value;
        f32x4 z[4][2];
#pragma unroll
        for (int i = 0; i < 4; ++i) { z[i][0] = (f32x4){0.f, 0.f, 0.f, 0.f}; z[i][1] = (f32x4){0.f, 0.f, 0.f, 0.f}; }
#pragma unroll
        for (int kh = 0; kh < 2; ++kh)
#pragma unroll
            for (int ms = 0; ms < 4; ++ms) {
                const bf16x8 kf = *(LAS bf16x8*)(Ks + (16 * ms + fr) * 128 + (((4 * kh + fq) ^ swz) << 4));
                if constexpr (a0) z[ms][0] = __builtin_amdgcn_mfma_f32_16x16x32_bf16(kf, qf[0][kh], z[ms][0], 0, 0, 0);
                if constexpr (a1) z[ms][1] = __builtin_amdgcn_mfma_f32_16x16x32_bf16(kf, qf[1][kh], z[ms][1], 0, 0, 0);
            }
        float lsum[2] = {0.f, 0.f};
#pragma unroll
        for (int ms = 0; ms < 4; ++ms)
#pragma unroll
            for (int nt = 0; nt < 2; ++nt) {
                if (!(nt ? a1 : a0)) continue;
                const int t = (nt ? trb1 : trb0) + fr;
                float lk[4];
#pragma unroll
                for (int j = 0; j < 4; ++j) {
                    const float zz = z[ms][nt][j];
                    const float sp = fmaxf(zz, 0.f) + __builtin_amdgcn_logf(1.f + __builtin_amdgcn_exp2f(-fabsf(zz)));
                    float l = -sp;
                    if (MASKED) { const int s = s0 + 16 * ms + 4 * fq + j; l = (s < t) ? l : 0.f; }
                    lk[j] = l; lsum[nt] += l;
                    z[ms][nt][j] = zz - sp;
                }
                u32x2 ph; ph[0] = pack2h(lk[0], lk[1]); ph[1] = pack2h(lk[2], lk[3]);
                *(LAS u32x2*)(LK + (16 * nt + fr) * 128 + ((((2 * ms + (fq >> 1)) ^ swz)) << 4) + (fq & 1) * 8) = ph;
            }
        __builtin_amdgcn_wave_barrier();
        asm volatile("s_waitcnt lgkmcnt(0)" ::: "memory");
        f32x4 st[4][2];
#pragma unroll
        for (int i = 0; i < 4; ++i) { st[i][0] = (f32x4){0.f, 0.f, 0.f, 0.f}; st[i][1] = (f32x4){0.f, 0.f, 0.f, 0.f}; }
#pragma unroll
        for (int kh = 0; kh < 2; ++kh) {
            f16x8 bh[2];
#pragma unroll
            for (int nt = 0; nt < 2; ++nt) if (nt ? a1 : a0) bh[nt] = *(LAS f16x8*)(LK + (16 * nt + fr) * 128 + (((4 * kh + fq) ^ swz) << 4));
#pragma unroll
            for (int ms = 0; ms < 4; ++ms) {
                if (32 * kh + 32 <= 16 * ms + 1) continue;
                f16x8 tm;
#pragma unroll
                for (int e = 0; e < 8; ++e) tm[e] = (32 * kh + 8 * fq + e > 16 * ms + fr) ? (_Float16)1.0f : (_Float16)0.0f;
                if constexpr (a0) st[ms][0] = __builtin_amdgcn_mfma_f32_16x16x32_f16(tm, bh[0], st[ms][0], 0, 0, 0);
                if constexpr (a1) st[ms][1] = __builtin_amdgcn_mfma_f32_16x16x32_f16(tm, bh[1], st[ms][1], 0, 0, 0);
            }
        }
#pragma unroll
        for (int ms = 0; ms < 4; ++ms)
#pragma unroll
            for (int nt = 0; nt < 2; ++nt) {
                if (!(nt ? a1 : a0)) continue;
                const int t = (nt ? trb1 : trb0) + fr;
                float wv[4];
#pragma unroll
                for (int j = 0; j < 4; ++j) {
                    float wj = __builtin_amdgcn_exp2f(z[ms][nt][j] + R[nt] + st[ms][nt][j]);
                    if (MASKED) { const int s = s0 + 16 * ms + 4 * fq + j; wj = (s < t) ? wj : 0.f; }
                    wv[j] = wj;
                }
                u32x2 pw; pw[0] = pack2h(wv[0], wv[1]); pw[1] = pack2h(wv[2], wv[3]);
                *(LAS u32x2*)(PS + (16 * nt + fr) * 128 + ((((2 * ms + (fq >> 1)) ^ swz)) << 4) + (fq & 1) * 8) = pw;
            }
#pragma unroll
        for (int nt = 0; nt < 2; ++nt) {
            if (!(nt ? a1 : a0)) continue;
            float tsum = lsum[nt];
            tsum += __shfl_xor(tsum, 16);
            tsum += __shfl_xor(tsum, 32);
            R[nt] += tsum;
        }
        __builtin_amdgcn_wave_barrier();
        asm volatile("s_waitcnt lgkmcnt(0)" ::: "memory");
#pragma unroll
        for (int kh = 0; kh < 2; ++kh) {
            f16x8 pf[2];
#pragma unroll
            for (int nt = 0; nt < 2; ++nt) if (nt ? a1 : a0) pf[nt] = *(LAS f16x8*)(PS + (16 * nt + fr) * 128 + (((4 * kh + fq) ^ swz) << 4));
#pragma unroll
            for (int md = 0; md < 4; ++md) {
                const f16x8 vf = *(LAS f16x8*)(Vs + (16 * md + fr) * 128 + (((4 * kh + fq) ^ swz) << 4));
                if constexpr (a0) oT[md][0] = __builtin_amdgcn_mfma_f32_16x16x32_f16(vf, pf[0], oT[md][0], 0, 0, 0);
                if constexpr (a1) oT[md][1] = __builtin_amdgcn_mfma_f32_16x16x32_f16(vf, pf[1], oT[md][1], 0, 0, 0);
            }
        }
    };
    bool done0 = false, done1 = false;
    for (; kt >= 0; --kt) {
        *(LAS u32x4*)(Ks + tid * 16) = kv;
        *(LAS u32x4*)(Vs + tid * 16) = vv;
        __syncthreads();
        if (kt > 0) {
            kv = *(const u32x4*)(Kh + (size_t)((kt - 1) * 64 + prow) * DH + pc * 8);
            vv = *(const u32x4*)(Vth + (size_t)(kt - 1) * 4096 + prow * 64 + pc * 8);
        }
        {
            const int s0 = kt * 64;
            const bool a0 = !done0 && s0 <= trb0, a1 = !done1 && s0 <= trb1;
            if (a0 || a1) {
                const bool mk = (a0 && s0 + 63 >= trb0) || (a1 && s0 + 63 >= trb1);
                if (a0 && a1) { if (mk) tile(std::true_type{}, std::true_type{}, std::true_type{}, s0); else tile(std::false_type{}, std::true_type{}, std::true_type{}, s0); }
                else if (a0) { if (mk) tile(std::true_type{}, std::true_type{}, std::false_type{}, s0); else tile(std::false_type{}, std::true_type{}, std::false_type{}, s0); }
                else { if (mk) tile(std::true_type{}, std::false_type{}, std::true_type{}, s0); else tile(std::false_type{}, std::false_type{}, std::true_type{}, s0); }
                if (a0) done0 = __int_as_float(__builtin_amdgcn_readfirstlane(__float_as_int(wave_max(R[0])))) < -127.f;
                if (a1) done1 = __int_as_float(__builtin_amdgcn_readfirstlane(__float_as_int(wave_max(R[1])))) < -127.f;
            }
        }
        const float wm = wave_max(fmaxf(R[0], R[1]));
        if (lane == 0) flags[(kt & 1) * 8 + w] = wm;
        __syncthreads();
        float m8 = flags[(kt & 1) * 8];
#pragma unroll
        for (int i = 1; i < 8; ++i) m8 = fmaxf(m8, flags[(kt & 1) * 8 + i]);
        if (m8 < -127.f) break;
    }
#pragma unroll
    for (int md = 0; md < 4; ++md)
#pragma unroll
        for (int nt = 0; nt < 2; ++nt) {
            const int t = (nt ? trb1 : trb0) + fr;
            u32x2 o; o[0] = pack2bf(oT[md][nt][0], oT[md][nt][1]); o[1] = pack2bf(oT[md][nt][2], oT[md][nt][3]);
            *(u32x2*)(og + (size_t)t * D + head * 64 + 16 * md + 4 * fq) = o;
        }
    __syncthreads();
}

__device__ void phase_mixers(const Params& p, LAS char* sm) {
    constexpr int NQB = LP2 / 256, NATT = NH * NQB, NCONV = (LTOK + 31) / 32;
    unsigned* ctr = (unsigned*)p.ws + CTR_MIX;
    LAS int* slot = (LAS int*)(sm + LDS_MAIN + 128);
    if (threadIdx.x == 0) *slot = (int)atomicAdd(ctr, 1u);
    __syncthreads();
    for (;;) {
        const int it = *slot;
        __syncthreads();
        if (it >= NATT + NCONV) break;
        unsigned nx = 0u;
        if (threadIdx.x == 0) nx = atomicAdd(ctr, 1u);
        if (it < NATT) { const int qb = NQB - 1 - it / NH, head = it % NH; attn_item(p, sm, head, qb); }
        else conv_item(p, sm, it - NATT);
        if (threadIdx.x == 0) *slot = (int)nx;
        __syncthreads();
    }
}

struct OrderMN : pg8::LinearOrder {
    __device__ __forceinline__ bool next(int i, pg8::Unit& u) const {
        const int L = unit_id(i);
        if (L >= 64 * n) return false;
        u.pm = L / n; u.pn = L % n; return true;
    }
};
struct EpiP3 {
    static constexpr bool HAS_MID = true;
    const bf16_t* gate; bf16_t* mixed;
    __device__ __forceinline__ void scale(f32x4 (&acc)[2][2][4][2], const pg8::Unit& u, int wr, int wc, int fr_, int fq_, int goff, bool store) const {
        int fr = fr_, fq = fq_; asm volatile("" : "+v"(fr), "+v"(fq));
        const int row0 = NMETA + 256 * u.pm + 64 * wr + fr, col0 = 256 * u.pn + 32 * wc + 8 * fq;
        u32x4 gv[2][4][2];
#pragma unroll
        for (int ai = 0; ai < 2; ++ai)
#pragma unroll
            for (int m = 0; m < 4; ++m)
#pragma unroll
                for (int bj = 0; bj < 2; ++bj) gv[ai][m][bj] = *(const u32x4*)(gate + (size_t)(row0 + 128 * ai + 16 * m) * 2048 + goff + col0 + 128 * bj);
        asm volatile("s_waitcnt vmcnt(0)" ::: "memory");
#pragma unroll
        for (int ai = 0; ai < 2; ++ai)
#pragma unroll
            for (int m = 0; m < 4; ++m)
#pragma unroll
                for (int bj = 0; bj < 2; ++bj) {
                    const u32x4 g = gv[ai][m][bj];
                    u32x4 o;
#pragma unroll
                    for (int n = 0; n < 2; ++n) {
                        f32x4 y = acc[ai][bj][m][n];
                        y[0] *= bflo(g[2 * n]); y[1] *= bfhi(g[2 * n]); y[2] *= bflo(g[2 * n + 1]); y[3] *= bfhi(g[2 * n + 1]);
                        if (store) { o[2 * n] = pack2bf(y[0], y[1]); o[2 * n + 1] = pack2bf(y[2], y[3]); }
                        else acc[ai][bj][m][n] = y;
                    }
                    if (store) *(u32x4*)(mixed + (size_t)(row0 + 128 * ai + 16 * m) * D + col0 + 128 * bj) = o;
                }
    }
    __device__ __forceinline__ void mid(f32x4 (&acc)[2][2][4][2], const pg8::Unit& u, int wr, int wc, int fr, int fq) const { scale(acc, u, wr, wc, fr, fq, 0, false); }
    __device__ __forceinline__ void operator()(const f32x4 (&acc)[2][2][4][2], const pg8::Unit& u, int wr, int wc, int fr, int fq) const {
        scale(const_cast<f32x4 (&)[2][2][4][2]>(acc), u, wr, wc, fr, fq, 1024, true);
    }
};
__device__ void phase_gemm2(const Params& p, LAS char* sm) {
    OrderMN S; S.c = blockIdx.x; S.G = gridDim.x; S.n = 4;
    EpiP3 E{(const bf16_t*)(p.ws + WS_GATE), (bf16_t*)(p.ws + WS_MIXED)};
    pg8::Gemm g{(const bf16_t*)(p.ws + WS_CO) + (size_t)NMETA * D, (const bf16_t*)(p.ws + WS_W2), D};
    pg8::gemm_phase((LAS unsigned char*)sm, g, S, E);
}

struct EpiP4 {
    static constexpr bool HAS_MID = false;
    const bf16_t* hb; bf16_t* h2b; float* ssp;
    __device__ __forceinline__ void operator()(const f32x4 (&acc)[2][2][4][2], const pg8::Unit& u, int wr, int wc, int fr_, int fq_) const {
        int fr = fr_, fq = fq_; asm volatile("" : "+v"(fr), "+v"(fq));
        const int col0 = 256 * u.pn + 32 * wc + 8 * fq;
        const int tok0 = 256 * u.pm + 64 * wr + fr;
#pragma unroll
        for (int ai = 0; ai < 2; ++ai) {
            u32x4 hv[4][2];
#pragma unroll
            for (int m = 0; m < 4; ++m)
#pragma unroll
                for (int bj = 0; bj < 2; ++bj) hv[m][bj] = *(const u32x4*)(hb + (size_t)(NMETA + tok0 + 128 * ai + 16 * m) * D + col0 + 128 * bj);
            asm volatile("s_waitcnt vmcnt(0)" ::: "memory");
#pragma unroll
            for (int m = 0; m < 4; ++m) {
                const int tok = tok0 + 128 * ai + 16 * m;
                float ssq = 0.f;
#pragma unroll
                for (int bj = 0; bj < 2; ++bj) {
                    const u32x4 h = hv[m][bj];
                    u32x4 o;
#pragma unroll
                    for (int n = 0; n < 2; ++n) {
                        const f32x4 a = acc[ai][bj][m][n];
                        o[2 * n] = pack2bf(bflo(h[2 * n]) + a[0], bfhi(h[2 * n]) + a[1]); o[2 * n + 1] = pack2bf(bflo(h[2 * n + 1]) + a[2], bfhi(h[2 * n + 1]) + a[3]);
                    }
                    *(u32x4*)(h2b + (size_t)tok * D + col0 + 128 * bj) = o;
#pragma unroll
                    for (int e = 0; e < 4; ++e) { const float r0 = bflo(o[e]), r1 = bfhi(o[e]); ssq += r0 * r0 + r1 * r1; }
                }
                ssq += __shfl_xor(ssq, 16); ssq += __shfl_xor(ssq, 32);
                if (fq == 0) ssp[(size_t)tok * 16 + u.pn * 4 + wc] = ssq;
            }
        }
    }
};
__device__ void phase_gemm3(const Params& p, LAS char* sm) {
    OrderMN S; S.c = blockIdx.x; S.G = gridDim.x; S.n = 4;
    EpiP4 E{(const bf16_t*)(p.ws + WS_HB), (bf16_t*)(p.ws + WS_H2B), (float*)(p.ws + WS_SSP)};
    pg8::Gemm g{(const bf16_t*)(p.ws + WS_MIXED) + (size_t)NMETA * D, (const bf16_t*)(p.ws + WS_WO), D};
    pg8::gemm_phase((LAS unsigned char*)sm, g, S, E);
}

__device__ __forceinline__ float vmaxf(float a, float b) { float r; asm("v_max_f32 %0, %1, %2" : "=v"(r) : "v"(a), "v"(b)); return r; }
__device__ __forceinline__ float vminf(float a, float b) { float r; asm("v_min_f32 %0, %1, %2" : "=v"(r) : "v"(a), "v"(b)); return r; }
__device__ __forceinline__ void bitonic_sort16_desc(float (&a)[16]) {
#pragma unroll
    for (int k = 2; k <= 16; k <<= 1)
#pragma unroll
        for (int j = k >> 1; j > 0; j >>= 1)
#pragma unroll
            for (int i = 0; i < 16; ++i) {
                const int l = i ^ j;
                if (l > i) {
                    const bool desc = ((i & k) == 0);
                    const float x = vmaxf(a[i], a[l]), y = vminf(a[i], a[l]);
                    a[i] = desc ? x : y; a[l] = desc ? y : x;
                }
            }
}
__device__ __forceinline__ void merge_top16_desc(float (&r)[16], const float (&g)[16]) {
#pragma unroll
    for (int i = 0; i < 16; ++i) r[i] = vmaxf(r[i], g[15 - i]);
#pragma unroll
    for (int j = 8; j > 0; j >>= 1)
#pragma unroll
        for (int i = 0; i < 16; ++i) {
            const int l = i ^ j;
            if (l > i) { const float x = vmaxf(r[i], r[l]), y = vminf(r[i], r[l]); r[i] = x; r[l] = y; }
        }
}
__device__ __forceinline__ float mkkey(float f, int low, int mask) { return __int_as_float((__float_as_int(f) & ~mask) | low); }
__device__ __forceinline__ int keylow(float k, int mask) { return __float_as_int(k) & mask; }
__device__ __forceinline__ float keyval(float k, int mask) { return __int_as_float(__float_as_int(k) & ~mask); }

struct EpiP5 {
    static constexpr bool HAS_MID = false;
    bf16_t* qp;
    __device__ __forceinline__ void operator()(const f32x4 (&acc)[2][2][4][2], const pg8::Unit& u, int wr, int wc, int fr_, int fq_) const {
        int fr = fr_, fq = fq_; asm volatile("" : "+v"(fr), "+v"(fq));
#pragma unroll
        for (int ai = 0; ai < 2; ++ai)
#pragma unroll
            for (int m = 0; m < 4; ++m) {
                const int tok = 256 * u.pm + 128 * ai + 64 * wr + 16 * m + fr;
#pragma unroll
                for (int bj = 0; bj < 2; ++bj) {
                    const f32x4 v0 = acc[ai][bj][m][0], v1 = acc[ai][bj][m][1];
                    u32x4 o; o[0] = pack2h(v0[0], v0[1]); o[1] = pack2h(v0[2], v0[3]); o[2] = pack2h(v1[0], v1[1]); o[3] = pack2h(v1[2], v1[3]);
                    *(u32x4*)(qp + (size_t)tok * 2048 + 256 * u.pn + 128 * bj + 32 * wc + 8 * fq) = o;
                }
            }
    }
};

__device__ void route_unit(const Params& p, LAS char* sm, int pm, int head) {
    const int tid = tid_opaque();
    const bf16_t* sc = (const bf16_t*)(p.ws + WS_QP);
    int* pidx = (int*)(p.ws + WS_PIDX);
    float* pgate = (float*)(p.ws + WS_PGATE);
    const int row = tid & 255, part = tid >> 8;
    u32x4 sv[2][8];
#pragma unroll
    for (int half = 0; half < 2; ++half)
#pragma unroll
        for (int q = 0; q < 8; ++q) sv[half][q] = *(const u32x4*)(sc + (size_t)(256 * pm + row) * 2048 + head * 256 + half * 128 + part * 64 + 8 * q);
    f32x4 ssv[4];
    { const float* sp = (const float*)(p.ws + WS_SSP) + (size_t)(256 * pm + row) * 16;
#pragma unroll
      for (int q = 0; q < 4; ++q) ssv[q] = *(const f32x4*)(sp + 4 * q); }
    float keep0[16];
#pragma unroll
    for (int half = 0; half < 2; ++half) {
        float run[16];
#pragma unroll
        for (int g = 0; g < 4; ++g) {
            float grp[16];
#pragma unroll
            for (int q = 0; q < 2; ++q)
#pragma unroll
                for (int e = 0; e < 4; ++e) {
                    const unsigned w = sv[half][2 * g + q][e];
                    const int c0 = part * 64 + 16 * g + 8 * q + 2 * e;
                    grp[8 * q + 2 * e] = mkkey((float)__builtin_bit_cast(_Float16, (unsigned short)(w & 0xFFFFu)), c0, 127);
                    grp[8 * q + 2 * e + 1] = mkkey((float)__builtin_bit_cast(_Float16, (unsigned short)(w >> 16)), c0 + 1, 127);
                }
            bitonic_sort16_desc(grp);
            if (g == 0) {
#pragma unroll
                for (int i = 0; i < 16; ++i) run[i] = grp[i];
            } else merge_top16_desc(run, grp);
        }
        LAS float* myrow = (LAS float*)(sm + row * 512);
        if (part == 1) {
#pragma unroll
            for (int i = 0; i < 16; ++i) myrow[i] = run[i];
        }
        __syncthreads();
        if (part == 0) {
            float oth[16];
#pragma unroll
            for (int i = 0; i < 16; ++i) oth[i] = myrow[i];
            merge_top16_desc(run, oth);
            if (half == 0) {
#pragma unroll
                for (int i = 0; i < 16; ++i) keep0[i] = run[i];
            } else {
#pragma unroll
                for (int i = 0; i < 16; ++i) { myrow[32 + i] = keep0[i]; myrow[48 + i] = run[i]; }
            }
        }
        if (half == 1) {
            __syncthreads();
            float v1[16], v2[16];
#pragma unroll
            for (int i = 0; i < 16; ++i) { v1[i] = keyval(myrow[32 + i], 127); v2[i] = keyval(myrow[48 + i], 127); }
#define CKEY(I, J) mkkey(v1[I] + v2[J], 16 * (I) + (J), 255)
            float res[16];
            if (part == 0) {
#pragma unroll
                for (int j = 0; j < 16; ++j) res[j] = CKEY(0, j);
                float g1[16];
#pragma unroll
                for (int j = 0; j < 8; ++j) g1[j] = CKEY(1, j);
#pragma unroll
                for (int j = 0; j < 5; ++j) g1[8 + j] = CKEY(2, j);
#pragma unroll
                for (int j = 0; j < 3; ++j) g1[13 + j] = CKEY(3, j);
                bitonic_sort16_desc(g1);
                merge_top16_desc(res, g1);
            } else {
                res[0] = CKEY(3, 3);
#pragma unroll
                for (int j = 0; j < 3; ++j) res[1 + j] = CKEY(4, j);
#pragma unroll
                for (int i = 5; i < 8; ++i) { res[4 + 2 * (i - 5)] = CKEY(i, 0); res[5 + 2 * (i - 5)] = CKEY(i, 1); }
#pragma unroll
                for (int i = 8; i < 14; ++i) res[10 + (i - 8)] = CKEY(i, 0);
                bitonic_sort16_desc(res);
                float g2[16];
                const float c14 = CKEY(14, 0), c15 = CKEY(15, 0);
                g2[0] = vmaxf(c14, c15); g2[1] = vminf(c14, c15);
#pragma unroll
                for (int i = 2; i < 16; ++i) g2[i] = -3.0e38f;
                merge_top16_desc(res, g2);
#pragma unroll
                for (int i = 0; i < 16; ++i) myrow[16 + i] = res[i];
            }
#undef CKEY
            __syncthreads();
            if (part == 0) {
                float oth2[16];
#pragma unroll
                for (int i = 0; i < 16; ++i) oth2[i] = myrow[16 + i];
                merge_top16_desc(res, oth2);
                float sc2;
                {
                    const f32x4 st = (ssv[0] + ssv[1]) + (ssv[2] + ssv[3]);
                    sc2 = rsqrtf((st[0] + st[1] + st[2] + st[3]) * (1.f / D) + EPS);
                    if (head == 0) ((float*)(p.ws + WS_RSTD2))[256 * pm + row] = sc2;
                }
                float bv[16]; float mx = -3.0e38f;
#pragma unroll
                for (int k = 0; k < 16; ++k) { bv[k] = keyval(res[k], 255) * sc2; mx = fmaxf(mx, bv[k]); }
                float se = 0.f;
#pragma unroll
                for (int k = 0; k < 16; ++k) { bv[k] = __expf(bv[k] - mx); se += bv[k]; }
                const float inv = 1.f / se;
                const size_t ob = ((size_t)(256 * pm + row)) * 128 + head * 16;
#pragma unroll
                for (int k4 = 0; k4 < 4; ++k4) {
                    i32x4 id; f32x4 gv;
#pragma unroll
                    for (int e = 0; e < 4; ++e) {
                        const int code = keylow(res[k4 * 4 + e], 255);
                        id[e] = keylow(myrow[32 + (code >> 4)], 127) * NKEYS + keylow(myrow[48 + (code & 15)], 127);
                        gv[e] = bv[k4 * 4 + e] * inv;
                    }
                    *(i32x4*)(pidx + ob + k4 * 4) = id;
                    *(f32x4*)(pgate + ob + k4 * 4) = gv;
                }
            }
        }
        __syncthreads();
    }
}
__device__ void phase_route(const Params& p, LAS char* sm) {
    OrderMN S; S.c = blockIdx.x; S.G = gridDim.x; S.n = 8;
    EpiP5 E{(bf16_t*)(p.ws + WS_QP)};
    pg8::Gemm g{(const bf16_t*)(p.ws + WS_H2B), (const bf16_t*)(p.ws + WS_WQ), D};
    pg8::gemm_phase((LAS unsigned char*)sm, g, S, E);
    asm volatile("s_waitcnt vmcnt(0)" ::: "memory");
    __syncthreads();
    pg8::Unit u;
    for (int i = 0; S.next(i, u); ++i) route_unit(p, sm, u.pm, u.pn);
}

__device__ __forceinline__ float gelu_exact(float x) { return 0.5f * x * (1.f + erff(x * 0.70710678118654752f)); }

template <int CTRL> __device__ __forceinline__ float dpp_maxf(float v) { return fmaxf(v, __int_as_float(__builtin_amdgcn_update_dpp(0, __float_as_int(v), CTRL, 0xF, 0xF, true))); }
template <int CTRL> __device__ __forceinline__ int dpp_i(int v) { return __builtin_amdgcn_update_dpp(0, v, CTRL, 0xF, 0xF, true); }
__device__ void phase_peer_u(const Params& p, LAS char* sm) {
    const int tid = tid_opaque(), lane = tid & 63, wid = tid >> 6, g = lane >> 3, l7 = lane & 7;
    const int sl = blockIdx.x & 7, gw = (blockIdx.x >> 3) * NWV + wid, nw = (gridDim.x >> 3) * NWV;
    const int* pidx = (const int*)(p.ws + WS_PIDX);
    const unsigned char* ubase = p.ws + WS_UB + (size_t)sl * 16384 * 128;
    const bf16_t* h2b = (const bf16_t*)(p.ws + WS_H2B);
    bf16_t* part = (bf16_t*)(p.ws + WS_PART);
    const unsigned cofs = 16 * l7;
    const bool b4 = l7 & 4, b2 = l7 & 2, b1 = l7 & 1;
    const int K = SEQ / nw;
#define PU_LOAD_IDS(IDS, XN, T) { IDS = *(const i32x2*)(pidx + (size_t)(T) * 128 + 2 * lane); XN = *(const unsigned*)(h2b + (size_t)(T) * D + 128 * sl + 2 * lane); }
#define PU_GATHER(UR, XQ, ISX, IDS, XN, T) { i32x4 idsN[4]; \
        const float x0 = bflo(XN), x1 = bfhi(XN); \
        float am = fmaxf(fabsf(x0), fabsf(x1)); \
        am = dpp_maxf<0xB1>(am); am = dpp_maxf<0x4E>(am); am = dpp_maxf<0x124>(am); am = dpp_maxf<0x128>(am); \
        { const int ai = __float_as_int(am); am = fmaxf(fmaxf(__int_as_float(__builtin_amdgcn_readlane(ai, 0)), __int_as_float(__builtin_amdgcn_readlane(ai, 16))), fmaxf(__int_as_float(__builtin_amdgcn_readlane(ai, 32)), __int_as_float(__builtin_amdgcn_readlane(ai, 48)))); } \
        const float sx = am > 0.f ? 127.f * __builtin_amdgcn_rcpf(am) : 0.f; ISX = am * (1.f / 127.f); \
        const int q0 = __float2int_rn(x0 * sx), q1 = __float2int_rn(x1 * sx); \
        *(LAS i32x2*)(wslot + 8 * lane) = IDS; *(LAS unsigned short*)(wslot + 512 + 2 * lane) = (unsigned short)((q0 & 255) | ((q1 & 255) << 8)); \
        __builtin_amdgcn_wave_barrier(); asm volatile("s_waitcnt lgkmcnt(0)" ::: "memory"); \
        _Pragma("unroll") for (int q = 0; q < 4; ++q) idsN[q] = *(LAS i32x4*)(wslot + 64 * g + 16 * q); \
        XQ = *(LAS u32x4*)(wslot + 512 + 16 * l7); \
        asm volatile("s_waitcnt lgkmcnt(0)" ::: "memory"); __builtin_amdgcn_wave_barrier(); \
        _Pragma("unroll") for (int i = 0; i < 16; ++i) UR[i] = *(const u32x4*)(ubase + (size_t)(((unsigned)idsN[i >> 2][i & 3] << 7) + cofs)); \
        }
#define PU_COMPUTE(UR, XQ, ISX, T) { \
        int a[16]; \
        _Pragma("unroll") for (int i = 0; i < 16; ++i) { int s4 = 0; \
            _Pragma("unroll") for (int c = 0; c < 4; ++c) s4 = __builtin_amdgcn_sdot4((int)UR[i][c], (int)XQ[c], s4, false); \
            a[i] = s4; } \
        int r8[8], r4[4], r2[2]; \
        _Pragma("unroll") for (int q = 0; q < 8; ++q) { const int keep = b4 ? a[q + 8] : a[q], send = b4 ? a[q] : a[q + 8]; r8[q] = keep + dpp_i<0x141>(send); }     \
        _Pragma("unroll") for (int q = 0; q < 4; ++q) { const int keep = b2 ? r8[q + 4] : r8[q], send = b2 ? r8[q] : r8[q + 4]; r4[q] = keep + dpp_i<0x4E>(send); }     \
        _Pragma("unroll") for (int q = 0; q < 2; ++q) { const int keep = b1 ? r4[q + 2] : r4[q], send = b1 ? r4[q] : r4[q + 2]; r2[q] = keep + dpp_i<0xB1>(send); }     \
        *(unsigned*)(part + ((size_t)sl * SEQ + (T)) * 128 + 2 * lane) = pack2bf((float)r2[0] * ISX, (float)r2[1] * ISX); }
    i32x2 idsE, idsO; unsigned xE, xO; u32x4 urA[16], urB[16]; u32x4 xqA, xqB; float isA, isB;
    LAS char* wslot = sm + wid * 1024;
    PU_LOAD_IDS(idsE, xE, gw);
    PU_LOAD_IDS(idsO, xO, gw + nw);
    PU_GATHER(urA, xqA, isA, idsE, xE, gw);
    PU_LOAD_IDS(idsE, xE, gw + 2 * nw);
#pragma unroll 1
    for (int k = 0; k < K; k += 2) {
        const int t0 = gw + k * nw, t1 = t0 + nw, t2 = t1 + nw, t3 = t2 + nw, t4 = t3 + nw;
        PU_GATHER(urB, xqB, isB, idsO, xO, t1);
        if (k + 3 < K) PU_LOAD_IDS(idsO, xO, t3);
        PU_COMPUTE(urA, xqA, isA, t0);
        if (k + 2 < K) { PU_GATHER(urA, xqA, isA, idsE, xE, t2); if (k + 4 < K) PU_LOAD_IDS(idsE, xE, t4); }
        PU_COMPUTE(urB, xqB, isB, t1);
    }
#undef PU_LOAD_IDS
#undef PU_GATHER
#undef PU_COMPUTE
}

__device__ void phase_peer_coef(const Params& p) {
    const int tid = tid_opaque();
    const int* pidx = (const int*)(p.ws + WS_PIDX);
    const float* pgate = (const float*)(p.ws + WS_PGATE);
    const float* scu = (const float*)(p.ws + WS_SCU);
    const float* scv = (const float*)(p.ws + WS_SCV);
    const bf16_t* part = (const bf16_t*)(p.ws + WS_PART);
    const float* rstd2 = (const float*)(p.ws + WS_RSTD2);
    float* coef = (float*)(p.ws + WS_COEF);
    const size_t stride = (size_t)gridDim.x * NT, total = (size_t)SEQ * 64;
    for (size_t i0 = (size_t)blockIdx.x * NT + tid; i0 < total; i0 += 4 * stride) {
        i32x2 id2[4]; f32x2 gt[4], s[4]; float rs[4], su[4][2], sv[4][2];
#pragma unroll
        for (int j = 0; j < 4; ++j) {
            const size_t i = i0 + j * stride;
            if (i < total) {
                id2[j] = *(const i32x2*)(pidx + i * 2); gt[j] = *(const f32x2*)(pgate + i * 2); rs[j] = rstd2[i >> 6];
                f32x2 acc = (f32x2){0.f, 0.f};
#pragma unroll
                for (int q = 0; q < 8; ++q) { const unsigned w = *(const unsigned*)(part + (size_t)q * SEQ * 128 + i * 2); acc[0] += bflo(w); acc[1] += bfhi(w); }
                s[j] = acc;
            } else { id2[j] = (i32x2){0, 0}; gt[j] = (f32x2){0.f, 0.f}; s[j] = (f32x2){0.f, 0.f}; rs[j] = 0.f; }
        }
#pragma unroll
        for (int j = 0; j < 4; ++j) { su[j][0] = scu[id2[j][0]]; su[j][1] = scu[id2[j][1]]; sv[j][0] = scv[id2[j][0]]; sv[j][1] = scv[id2[j][1]]; }
#pragma unroll
        for (int j = 0; j < 4; ++j) {
            const size_t i = i0 + j * stride;
            if (i < total) {
                f32x2 c2; c2[0] = gt[j][0] * sv[j][0] * gelu_exact(s[j][0] * su[j][0] * rs[j]); c2[1] = gt[j][1] * sv[j][1] * gelu_exact(s[j][1] * su[j][1] * rs[j]);
                *(f32x2*)(coef + i * 2) = c2;
            }
        }
    }
}

__device__ void phase_peer_v(const Params& p, LAS char* sm) {
    const int tid = tid_opaque(), lane = tid & 63, wid = tid >> 6, g = lane >> 3, l7 = lane & 7;
    const int sl = blockIdx.x & 7, gw = (blockIdx.x >> 3) * NWV + wid, nw = (gridDim.x >> 3) * NWV;
    const int* pidx = (const int*)(p.ws + WS_PIDX);
    const float* coef = (const float*)(p.ws + WS_COEF);
    const unsigned char* vb = p.ws + WS_VB;
    const bf16_t* h2b = (const bf16_t*)(p.ws + WS_H2B);
    const int colbase = 128 * sl + 16 * l7;
    const unsigned char* vbase = vb + (size_t)sl * 16384 * 128;
    const unsigned cofs = 16 * l7;
    const bool h8 = lane & 8;
    const int K = SEQ / nw;
#define PV_LOAD_IDS(IDS, CFN, T) { IDS = *(const i32x2*)(pidx + (size_t)(T) * 128 + 2 * lane); CFN = *(const f32x2*)(coef + (size_t)(T) * 128 + 2 * lane); }
#define PV_GATHER(VR, HV, CF, IDS, CFN, T) { i32x4 idsN[4]; *(LAS i32x2*)(wslot + 8 * lane) = IDS; *(LAS f32x2*)(wslot + 512 + 8 * lane) = CFN; __builtin_amdgcn_wave_barrier(); asm volatile("s_waitcnt lgkmcnt(0)" ::: "memory"); \
        _Pragma("unroll") for (int q = 0; q < 4; ++q) { idsN[q] = *(LAS i32x4*)(wslot + 64 * g + 16 * q); CF[q] = *(LAS f32x4*)(wslot + 512 + 64 * g + 16 * q); } \
        asm volatile("s_waitcnt lgkmcnt(0)" ::: "memory"); __builtin_amdgcn_wave_barrier(); \
        _Pragma("unroll") for (int i = 0; i < 16; ++i) VR[i] = *(const u32x4*)(vbase + (size_t)(((unsigned)idsN[i >> 2][i & 3] << 7) + cofs)); \
        HV = *(const unsigned*)(h2b + (size_t)(T) * D + colbase + 2 * g); }
#define PV_COMPUTE(VR, HV, CF, T) { \
        f32x2 o2[8]; _Pragma("unroll") for (int c = 0; c < 8; ++c) o2[c] = (f32x2){0.f, 0.f}; \
        _Pragma("unroll") for (int i = 0; i < 16; ++i) { const f32x2 cv = (f32x2){CF[i >> 2][i & 3], CF[i >> 2][i & 3]}; \
            _Pragma("unroll") for (int c = 0; c < 4; ++c) { const f32x2 lo = __builtin_amdgcn_cvt_pk_f32_fp8((int)VR[i][c], false), hi = __builtin_amdgcn_cvt_pk_f32_fp8((int)VR[i][c], true); \
                o2[2 * c] += cv * lo; o2[2 * c + 1] += cv * hi; } } \
        float a[16]; _Pragma("unroll") for (int c = 0; c < 8; ++c) { a[2 * c] = o2[c][0]; a[2 * c + 1] = o2[c][1]; } \
        float r8[8], r4[4], r2[2]; \
          \
        _Pragma("unroll") for (int q = 0; q < 8; ++q) { const u32x2 sw = __builtin_amdgcn_permlane32_swap(__float_as_uint(a[q]), __float_as_uint(a[q + 8]), false, false); r8[q] = __uint_as_float(sw[0]) + __uint_as_float(sw[1]); } \
        _Pragma("unroll") for (int q = 0; q < 4; ++q) { const u32x2 sw = __builtin_amdgcn_permlane16_swap(__float_as_uint(r8[q]), __float_as_uint(r8[q + 4]), false, false); r4[q] = __uint_as_float(sw[0]) + __uint_as_float(sw[1]); } \
        _Pragma("unroll") for (int q = 0; q < 2; ++q) { const float keep = h8 ? r4[q + 2] : r4[q], send = h8 ? r4[q] : r4[q + 2]; r2[q] = keep + __int_as_float(__builtin_amdgcn_update_dpp(0, __float_as_int(send), 0x128, 0xF, 0xF, true)); } \
        f32x2 hv; hv[0] = bflo(HV) + r2[0]; hv[1] = bfhi(HV) + r2[1]; \
        *(f32x2*)(p.out + (size_t)(T) * D + colbase + 2 * g) = hv; }
    i32x2 idsE, idsO; f32x2 cfE, cfO; f32x4 cfA[4], cfB[4]; u32x4 vrA[16], vrB[16]; unsigned hA, hB;
    LAS char* wslot = sm + wid * 1024;
    PV_LOAD_IDS(idsE, cfE, gw);
    PV_LOAD_IDS(idsO, cfO, gw + nw);
    PV_GATHER(vrA, hA, cfA, idsE, cfE, gw);
    PV_LOAD_IDS(idsE, cfE, gw + 2 * nw);
#pragma unroll 1
    for (int k = 0; k < K; k += 2) {
        const int t0 = gw + k * nw, t1 = t0 + nw, t2 = t1 + nw, t3 = t2 + nw, t4 = t3 + nw;
        PV_GATHER(vrB, hB, cfB, idsO, cfO, t1);
        if (k + 3 < K) PV_LOAD_IDS(idsO, cfO, t3);
        PV_COMPUTE(vrA, hA, cfA, t0);
        if (k + 2 < K) { PV_GATHER(vrA, hA, cfA, idsE, cfE, t2); if (k + 4 < K) PV_LOAD_IDS(idsE, cfE, t4); }
        PV_COMPUTE(vrB, hB, cfB, t1);
    }
#undef PV_LOAD_IDS
#undef PV_GATHER
#undef PV_COMPUTE
}

__global__ void __launch_bounds__(NT, 2) fwd_kernel(Params p) {
    __shared__ __attribute__((aligned(16))) char smem[LDS_BYTES + 16];
    LAS char* sm = (LAS char*)smem;
    volatile LAS unsigned* st = (volatile LAS unsigned*)(sm + LDS_BYTES);
    if (threadIdx.x == 0) { st[0] = 0u; st[1] = 0u; st[2] = 0u; st[3] = 0u; }
    __syncthreads();
    const XcdBarrier xb = xcd_barrier_post((unsigned*)p.ws, st);
#ifndef PROBE_DOUBLE
#define PROBE_DOUBLE 0
#endif
#define RUN_PHASE(K, CALL) \
    if (p.ph_lo <= (K) && (K) < p.ph_hi) { \
        const int nrep = 1 + ((PROBE_DOUBLE >> (K)) & 1); \
        _Pragma("unroll 1") for (int rep = 0; rep < nrep; ++rep) { \
            if (rep > 0) { xcd_barrier(xb); if (blockIdx.x == 0 && threadIdx.x == 0) __hip_atomic_store((unsigned*)p.ws + CTR_MIX, 0u, __ATOMIC_RELAXED, __HIP_MEMORY_SCOPE_AGENT); xcd_barrier(xb); } \
            CALL; \
        } \
        if ((K) + 1 < p.ph_hi) { xcd_barrier(xb); } \
    }
    RUN_PHASE(0, phase_prep(p, sm))
    RUN_PHASE(1, phase_gemm1(p, sm))
    RUN_PHASE(2, phase_mixers(p, sm))
    RUN_PHASE(3, phase_gemm2(p, sm))
    RUN_PHASE(4, phase_gemm3(p, sm))
    RUN_PHASE(5, phase_route(p, sm))
    RUN_PHASE(6, phase_peer_u(p, sm))
    RUN_PHASE(7, phase_peer_coef(p))
    RUN_PHASE(8, phase_peer_v(p, sm))
#undef RUN_PHASE
}

extern "C" void kernel_launch(void* const* d_in, const int* in_sizes, int n_in, void* d_out, int out_size, void* d_ws, size_t ws_size, hipStream_t stream) {
    static int grid = 0;
    if (grid == 0) {
        int dev = 0, cus = 0, per_cu = 0;
        (void)hipGetDevice(&dev);
        (void)hipDeviceGetAttribute(&cus, hipDeviceAttributeMultiprocessorCount, dev);
        (void)hipOccupancyMaxActiveBlocksPerMultiprocessor(&per_cu, (const void*)fwd_kernel, NT, 0);
        grid = (per_cu >= 1) ? (cus / 8) * 8 : -1;
        if (grid <= 0) fprintf(stderr, "kernel_launch: occupancy query says the kernel does not fit (%d)\n", per_cu);
        if (ws_size < WS_END) { fprintf(stderr, "kernel_launch: workspace too small: %zu < %zu\n", ws_size, (size_t)WS_END); grid = -1; }
    }
    if (grid < 0) return;
    Params p{};
    const float* const* in = (const float* const*)d_in;
    p.x = in[0]; p.meta = in[1]; p.norm1_g = in[2]; p.w_in = in[3]; p.conv_w = in[4]; p.conv_b = in[5]; p.conv_ln_g = in[6]; p.conv_ln_b = in[7];
    p.w_conv_out = in[8]; p.q_norm_g = in[9]; p.k_norm_g = in[10]; p.w_sb_out = in[11]; p.w_gate = in[12]; p.b_gate = in[13]; p.w_o = in[14];
    p.norm2_g = in[15]; p.peer_wq = in[16]; p.peer_k1 = in[17]; p.peer_k2 = in[18]; p.peer_u = in[19]; p.peer_v = in[20];
    p.out = (float*)d_out; p.ws = (unsigned char*)d_ws;
    (void)hipMemsetAsync(d_ws, 0, 16384, stream);
#if MULTI_LAUNCH
    for (int ph = 0; ph < 9; ++ph) {
        p.ph_lo = ph; p.ph_hi = ph + 1;
        hipLaunchKernelGGL(fwd_kernel, dim3(grid), dim3(NT), 0, stream, p);
    }
#else
    p.ph_lo = 0; p.ph_hi = 9;
    void* args[] = {&p};
    hipError_t e = hipLaunchCooperativeKernel((const void*)fwd_kernel, dim3(grid), dim3(NT), args, 0, stream);
    if (e != hipSuccess) fprintf(stderr, "cooperative launch failed: %s (grid %d)\n", hipGetErrorString(e), grid);
#endif
}
```
